# Optimizing an MI355X kernel written in HIP

```python
import jax, jax.numpy as jnp
from jax import lax
import numpy as np

D_MODEL = 1024
BATCH = 1
SEQ = 16384
DEPTH = 1

N_META = 16
GRID_W = 64
CHUNK = 128
Q_BLOCK = 128
EPS = 1e-6
HG_HEADS = 4
HG_K = 128
HG_V = 128
HG_KW = HG_HEADS * HG_K
HG_VW = HG_HEADS * HG_V
AT_HEADS = 8
AT_KV_HEADS = 2
AT_HD = 64
AT_GROUP = AT_HEADS // AT_KV_HEADS
AT_W = AT_HEADS * AT_HD
AT_KVW = AT_KV_HEADS * AT_HD
ROPE_THETA = 10000.0
ROPE_AXIS = AT_HD // 2
D_FF = 2816
IN_SIZES = (HG_KW, HG_VW, HG_KW, HG_KW, HG_VW, AT_W, AT_KVW, AT_KVW, D_MODEL, D_MODEL)
D_IN = sum(IN_SIZES)

kernel_name = 'hybrid_hgrn2_axial_gqa_macaron_block'


def rms_norm(x, w):
    xf = x.astype(jnp.float32)
    y = xf * lax.rsqrt(jnp.mean(xf * xf, axis=-1, keepdims=True) + EPS)
    return (y * w.astype(jnp.float32)).astype(x.dtype)


def swiglu(x, w_gate, w_up, w_down):
    return (jax.nn.silu(x @ w_gate) * (x @ w_up)) @ w_down


def split_cols(z, sizes):
    outs = []
    start = 0
    for s in sizes:
        outs.append(z[..., start:start + s])
        start += s
    return outs


def axial_rope_tables(n_real):
    rows = n_real // GRID_W
    row = jnp.repeat(jnp.arange(rows, dtype=jnp.float32), GRID_W)
    col = jnp.tile(jnp.arange(GRID_W, dtype=jnp.float32), rows)
    zeros = jnp.zeros((N_META,), jnp.float32)
    row = jnp.concatenate([zeros, row])
    col = jnp.concatenate([zeros, col])
    inv = ROPE_THETA ** (-jnp.arange(0, ROPE_AXIS, 2, dtype=jnp.float32) / ROPE_AXIS)
    ang = jnp.concatenate([row[:, None] * inv, col[:, None] * inv], axis=-1)
    return jnp.cos(ang), jnp.sin(ang)


def apply_rope(x, cos, sin):
    xf = x.astype(jnp.float32).reshape(x.shape[:-1] + (AT_HD // 2, 2))
    x1, x2 = xf[..., 0], xf[..., 1]
    c = cos[None, :, None, :]
    s = sin[None, :, None, :]
    out = jnp.stack([x1 * c - x2 * s, x1 * s + x2 * c], axis=-1).reshape(x.shape)
    return out.astype(x.dtype)


def attend(qb, k, v):
    s = jnp.einsum('bkgqd,bksd->bkgqs', qb, k, preferred_element_type=jnp.float32) * (AT_HD ** -0.5)
    p = jax.nn.softmax(s, axis=-1)
    return jnp.einsum('bkgqs,bksd->bkgqd', p.astype(v.dtype), v)


def axial_gqa(zq, zk, zv, q_norm_w, k_norm_w, cos, sin):
    B, L, _ = zq.shape
    q = rms_norm(zq.reshape(B, L, AT_HEADS, AT_HD), q_norm_w)
    k = rms_norm(zk.reshape(B, L, AT_KV_HEADS, AT_HD), k_norm_w)
    v = zv.reshape(B, L, AT_KV_HEADS, AT_HD)
    q = apply_rope(q, cos, sin)
    k = apply_rope(k, cos, sin)
    q = q.transpose(0, 2, 1, 3).reshape(B, AT_KV_HEADS, AT_GROUP, L, AT_HD)
    k = k.transpose(0, 2, 1, 3)
    v = v.transpose(0, 2, 1, 3)
    n_real = L - N_META
    n_blk = n_real // Q_BLOCK
    o_meta = attend(q[:, :, :, :N_META], k, v)
    q_real = jnp.moveaxis(q[:, :, :, N_META:].reshape(B, AT_KV_HEADS, AT_GROUP, n_blk, Q_BLOCK, AT_HD), 3, 0)
    o_real = lax.map(lambda qb: attend(qb, k, v), q_real)
    o_real = jnp.moveaxis(o_real, 0, 3).reshape(B, AT_KV_HEADS, AT_GROUP, n_real, AT_HD)
    o = jnp.concatenate([o_meta, o_real], axis=3)
    return o.transpose(0, 3, 1, 2, 4).reshape(B, L, AT_W)


def gla_chunked(q, k, v, logf):
    B, T, H, K = q.shape
    n = T // CHUNK
    def to_chunks(a):
        return a.reshape(B, n, CHUNK, H, a.shape[-1]).transpose(1, 0, 3, 2, 4)
    mask = jnp.tril(jnp.ones((CHUNK, CHUNK), dtype=bool))

    def step(S, xs):
        qc, kc, vc, lc = xs
        b = jnp.cumsum(lc, axis=2)
        o_inter = jnp.einsum('bhck,bhkv->bhcv', qc * jnp.exp(b), S)
        diff = jnp.where(mask[None, None, :, :, None], b[:, :, :, None, :] - b[:, :, None, :, :], -jnp.inf)
        attn = jnp.einsum('bhtk,bhsk,bhtsk->bhts', qc, kc, jnp.exp(diff))
        o_intra = jnp.einsum('bhts,bhsv->bhtv', attn, vc)
        b_last = b[:, :, -1:, :]
        S_new = jnp.exp(b_last[:, :, 0, :])[..., None] * S + jnp.einsum('bhsk,bhsv->bhkv', kc * jnp.exp(b_last - b), vc)
        return S_new, o_inter + o_intra

    S0 = jnp.zeros((B, H, K, v.shape[-1]), jnp.float32)
    _, o = lax.scan(step, S0, (to_chunks(q), to_chunks(k), to_chunks(v), to_chunks(logf)))
    return o.transpose(1, 0, 3, 2, 4).reshape(B, T, H, v.shape[-1])


def hgrn2_bidir(zq, zi, zf_f, zf_b, zg, lb_f, lb_b, out_norm_w):
    B, L, _ = zq.shape
    q = jax.nn.silu(zq.astype(jnp.float32)).reshape(B, L, HG_HEADS, HG_K)
    v = zi.astype(jnp.float32).reshape(B, L, HG_HEADS, HG_V)

    def gates(zf, lb):
        lb = lb.reshape(HG_HEADS, HG_K)
        kk = (1.0 - lb) * jax.nn.sigmoid(-zf.astype(jnp.float32).reshape(B, L, HG_HEADS, HG_K))
        return kk, jnp.log1p(-kk)

    k_f, lf_f = gates(zf_f, lb_f)
    k_b, lf_b = gates(zf_b, lb_b)
    n_pad = CHUNK - N_META
    pad = lambda a: jnp.pad(a, ((0, 0), (n_pad, 0), (0, 0), (0, 0)))
    flip = lambda a: jnp.flip(a, axis=1)
    q_p, v_p = pad(q), pad(v)
    o_fwd = gla_chunked(q_p, pad(k_f), v_p, pad(lf_f))
    o_bwd = flip(gla_chunked(flip(q_p), flip(pad(k_b)), flip(v_p), flip(pad(lf_b))))
    o = (o_fwd + o_bwd)[:, n_pad:]
    o = o * lax.rsqrt(jnp.mean(o * o, axis=-1, keepdims=True) + EPS) * out_norm_w.astype(jnp.float32).reshape(HG_HEADS, HG_V)
    o = o.reshape(B, L, HG_VW) * jax.nn.silu(zg.astype(jnp.float32))
    return o.astype(zq.dtype)


def setup_inputs(seed: int = 0) -> dict:
    key = jax.random.key(seed)
    ks = jax.random.split(key, 24)
    nrm = lambda k, shape, fan_in: jax.random.normal(k, shape, jnp.float32) * (fan_in ** -0.5)
    gain = lambda k, shape: 1.0 + 0.01 * jax.random.normal(k, shape, jnp.float32)
    return {
        'x': jax.random.normal(ks[0], (BATCH, SEQ, D_MODEL), jnp.float32),
        'meta_tokens': jax.random.normal(ks[1], (N_META, D_MODEL), jnp.float32),
        'ffn1_norm': gain(ks[2], (DEPTH, D_MODEL)),
        'ffn1_w_gate': nrm(ks[3], (DEPTH, D_MODEL, D_FF), D_MODEL),
        'ffn1_w_up': nrm(ks[4], (DEPTH, D_MODEL, D_FF), D_MODEL),
        'ffn1_w_down': nrm(ks[5], (DEPTH, D_FF, D_MODEL), D_FF),
        'mix_norm': gain(ks[6], (DEPTH, D_MODEL)),
        'w_in': nrm(ks[7], (DEPTH, D_MODEL, D_IN), D_MODEL),
        'hg_lb_fwd': 0.1 * jax.random.normal(ks[8], (DEPTH + 1, HG_KW), jnp.float32),
        'hg_lb_bwd': 0.1 * jax.random.normal(ks[9], (DEPTH + 1, HG_KW), jnp.float32),
        'hg_out_norm': gain(ks[10], (DEPTH, HG_VW)),
        'q_norm': gain(ks[11], (DEPTH, AT_HD)),
        'k_norm': gain(ks[12], (DEPTH, AT_HD)),
        'w_up_a': nrm(ks[13], (DEPTH, HG_VW, D_MODEL), HG_VW),
        'w_up_b': nrm(ks[14], (DEPTH, AT_W, D_MODEL), AT_W),
        'w_out': nrm(ks[15], (DEPTH, D_MODEL, D_MODEL), D_MODEL),
        'ffn2_norm': gain(ks[16], (DEPTH, D_MODEL)),
        'ffn2_w_gate': nrm(ks[17], (DEPTH, D_MODEL, D_FF), D_MODEL),
        'ffn2_w_up': nrm(ks[18], (DEPTH, D_MODEL, D_FF), D_MODEL),
        'ffn2_w_down': nrm(ks[19], (DEPTH, D_FF, D_MODEL), D_FF),
    }


def reference(x, meta_tokens, ffn1_norm, ffn1_w_gate, ffn1_w_up, ffn1_w_down, mix_norm, w_in, hg_lb_fwd, hg_lb_bwd, hg_out_norm, q_norm, k_norm, w_up_a, w_up_b, w_out, ffn2_norm, ffn2_w_gate, ffn2_w_up, ffn2_w_down):
    B, n_real, _ = x.shape
    meta = jnp.broadcast_to(meta_tokens.astype(x.dtype)[None], (B, N_META, D_MODEL))
    h = jnp.concatenate([meta, x], axis=1)
    cos, sin = axial_rope_tables(n_real)
    lb_fwd_all = jnp.cumsum(jax.nn.softmax(hg_lb_fwd.astype(jnp.float32), axis=0), axis=0)
    lb_bwd_all = jnp.cumsum(jax.nn.softmax(hg_lb_bwd.astype(jnp.float32), axis=0), axis=0)
    for layer in range(DEPTH):
        h = h + 0.5 * swiglu(rms_norm(h, ffn1_norm[layer]), ffn1_w_gate[layer], ffn1_w_up[layer], ffn1_w_down[layer])
        u = rms_norm(h, mix_norm[layer])
        z = u @ w_in[layer]
        zq_a, zi_a, zf_f, zf_b, zg_a, zq_b, zk_b, zv_b, zgate_a, zgate_b = split_cols(z, IN_SIZES)
        y_a = hgrn2_bidir(zq_a, zi_a, zf_f, zf_b, zg_a, lb_fwd_all[layer], lb_bwd_all[layer], hg_out_norm[layer])
        y_b = axial_gqa(zq_b, zk_b, zv_b, q_norm[layer], k_norm[layer], cos, sin)
        mixed = jax.nn.sigmoid(zgate_a) * (y_a @ w_up_a[layer]) + jax.nn.sigmoid(zgate_b) * (y_b @ w_up_b[layer])
        h = h + mixed @ w_out[layer]
        h = h + 0.5 * swiglu(rms_norm(h, ffn2_norm[layer]), ffn2_w_gate[layer], ffn2_w_up[layer], ffn2_w_down[layer])
    return h[:, N_META:]
```

```cpp
#include <hip/hip_runtime.h>
#include <cstdio>
#include <cstdint>
#include <cmath>
namespace pg8 {
#define PG8_LAS __attribute__((address_space(3)))
typedef unsigned short bf16_t;
typedef short bf16x8 __attribute__((ext_vector_type(8)));
typedef float f32x4 __attribute__((ext_vector_type(4)));
typedef unsigned u32x4 __attribute__((ext_vector_type(4)));
constexpr int BM = 256, BK = 64, HALF = 128, HTB = HALF * BK * 2  , STAGE_BYTES = 8 * HTB, NXCD = 8, WGM = 8;

__host__ __device__ __forceinline__ int lds_byte(int r, int c) { const int st = (r >> 4) * 2 + (c >> 5), rr = r & 15, cc = c & 31, ob = rr * 64 + cc * 2; return st * 1024 + (ob ^ (((ob >> 9) & 1) << 5)); }
__host__ __device__ __forceinline__ void stage_rc(int b, int& R, int& C) { const int st = b / 1024, sb = b % 1024, swz = sb ^ (((sb >> 9) & 1) << 5); R = (st >> 1) * 16 + swz / 64; C = (st & 1) * 32 + (swz % 64) / 2; }
__host__ __device__ __forceinline__ int perm32(int rho) { const int n = rho >> 4, i = rho & 15; return 8 * (i >> 2) + 4 * n + (i & 3); }

struct Unit { int pm, pn, idx; };
struct Gemm { const bf16_t* A; const bf16_t* Bt; int M, N, K; };

struct StaticOrder {
    int nM, nN, nwg, G, c;
    __host__ __device__ void init(int M, int N, int G_, int c_) { nM = M / BM; nN = N / BM; nwg = nM * nN; G = G_; c = c_; }
    __host__ __device__ bool next(int i, Unit& u) const {
        const long L = (long)i * G + c; if (L >= nwg) return false;
        int wgid = (int)L; { const int q = nwg / NXCD, r = nwg % NXCD, xcd = wgid % NXCD, off = wgid / NXCD; wgid = (xcd < r ? xcd * (q + 1) : r * (q + 1) + (xcd - r) * q) + off; }
        const int nig = WGM * nN, gid = wgid / nig, fm = gid * WGM, gsz = (nM - fm) < WGM ? (nM - fm) : WGM;
        u.pm = fm + ((wgid % nig) % gsz); u.pn = (wgid % nig) / gsz; u.idx = i; return true;
    }
    __device__ __forceinline__ void a_ready(const Unit&) const {}
    __device__ __forceinline__ void done(const Unit&) const {}
};


constexpr int RS_UNITS = 8;
struct RsOrder : StaticOrder {
    const float* ssqp; PG8_LAS float* tab;
    __device__ __forceinline__ void prefill() const {
        const int tid = threadIdx.x, row = tid >> 1, hf = tid & 1;
        f32x4 a[RS_UNITS], b[RS_UNITS]; bool ok[RS_UNITS]; Unit u0; next(0, u0);
#pragma unroll
        for (int i = 0; i < RS_UNITS; ++i) { Unit u; ok[i] = next(i, u); if (!ok[i]) u = u0;
            const f32x4* p = (const f32x4*)(ssqp + (size_t)(u.pm * BM + row) * 16 + hf * 8); a[i] = p[0]; b[i] = p[1]; }
#pragma unroll
        for (int i = 0; i < RS_UNITS; ++i) {
            float s = ((a[i][0] + a[i][1]) + (a[i][2] + a[i][3])) + ((b[i][0] + b[i][1]) + (b[i][2] + b[i][3]));
            s += __shfl_xor(s, 1);
            if (hf == 0 && ok[i]) tab[i * BM + row] = rsqrtf(s * (1.0f / 1024.0f) + 1e-6f);
        }
        __syncthreads();
    }
    __device__ __forceinline__ void a_ready(const Unit&) const {}
};

typedef float f32x2_cv __attribute__((ext_vector_type(2))); typedef __bf16 bf16x2_cv __attribute__((ext_vector_type(2)));
__device__ __forceinline__ unsigned cvt_pk_bf16(float lo, float hi) { f32x2_cv v = {lo, hi}; bf16x2_cv b = __builtin_convertvector(v, bf16x2_cv); return __builtin_bit_cast(unsigned, b); }
typedef float f32x2 __attribute__((ext_vector_type(2)));
typedef unsigned u32x2 __attribute__((ext_vector_type(2)));
__device__ __forceinline__ float bf_lo(unsigned w) { return __uint_as_float(w << 16); }
__device__ __forceinline__ float bf_hi(unsigned w) { return __uint_as_float(w & 0xffff0000u); }
__device__ __forceinline__ float fast_sigmoid(float v) { return __builtin_amdgcn_rcpf(1.0f + __expf(-v)); }
__device__ __forceinline__ float fast_silu(float v) { return v * __builtin_amdgcn_rcpf(1.0f + __expf(-v)); }
constexpr float RMS_EPS = 1e-6f;
__device__ __forceinline__ float rstd_from(const float* ssqp, int row) {
    const f32x4* p = (const f32x4*)(ssqp + (size_t)row * 16);
    const f32x4 a = p[0], b = p[1], c = p[2], d = p[3];
    const float s = (((a[0] + a[1]) + (a[2] + a[3])) + ((b[0] + b[1]) + (b[2] + b[3]))) + (((c[0] + c[1]) + (c[2] + c[3])) + ((d[0] + d[1]) + (d[2] + d[3])));
    return rsqrtf(s * (1.0f / 1024.0f) + RMS_EPS);
}

struct EpiSwiglu {
    static constexpr bool PERM = true, AFTER_DRAIN = false, KEEP_ACC = false;
    bf16_t* O; const PG8_LAS float* tab; int ldo;
    __device__ __forceinline__ void operator()(const f32x4 (&acc)[2][2][4][2], const Unit& u, int wr, int wc, int fr, int fq) const {
        const int row0 = u.pm * BM + wr * 64 + fr, col0 = u.pn * HALF + wc * 32 + 8 * fq;
#pragma unroll
        for (int ai = 0; ai < 2; ++ai)
#pragma unroll
            for (int m = 0; m < 4; ++m) {
                const int row = row0 + ai * HALF + m * 16; const float rs = tab[u.idx * BM + ai * HALF + wr * 64 + m * 16 + fr];
                float o[8];
#pragma unroll
                for (int n = 0; n < 2; ++n)
#pragma unroll
                    for (int i = 0; i < 4; ++i) { const float g = acc[ai][0][m][n][i] * rs, up = acc[ai][1][m][n][i] * rs; o[4 * n + i] = fast_silu(g) * up; }
                u32x4 w; w.x = cvt_pk_bf16(o[0], o[1]); w.y = cvt_pk_bf16(o[2], o[3]); w.z = cvt_pk_bf16(o[4], o[5]); w.w = cvt_pk_bf16(o[6], o[7]);
                *(u32x4*)(O + (size_t)row * ldo + col0) = w;
            }
    }
};

struct EpiRes {
    static constexpr bool PERM = false, AFTER_DRAIN = false, KEEP_ACC = false;
    const float* base32; const bf16_t* base16; float* out32; bf16_t* hb; float* ssqp; float scale;
    __device__ __forceinline__ void operator()(const f32x4 (&acc)[2][2][4][2], const Unit& u, int wr, int wc, int fr, int fq) const {
        const int row0 = u.pm * BM + wr * 64 + fr, col0 = u.pn * BM + wc * 32 + 4 * fq;
#pragma unroll
        for (int ai = 0; ai < 2; ++ai)
#pragma unroll
            for (int m = 0; m < 4; ++m) {
                const int row = row0 + ai * HALF + m * 16; const size_t off = (size_t)row * 1024 + col0; float ss = 0.f;
                f32x4 b[2][2];
#pragma unroll
                for (int bj = 0; bj < 2; ++bj)
#pragma unroll
                    for (int n = 0; n < 2; ++n) {
                        if (base32) b[bj][n] = *(const f32x4*)(base32 + off + bj * HALF + n * 16);
                        else { const u32x2 w = *(const u32x2*)(base16 + off + bj * HALF + n * 16); b[bj][n] = (f32x4){bf_lo(w.x), bf_hi(w.x), bf_lo(w.y), bf_hi(w.y)}; }
                    }
#pragma unroll
                for (int bj = 0; bj < 2; ++bj)
#pragma unroll
                    for (int n = 0; n < 2; ++n) {
                        const f32x4 v = b[bj][n] + acc[ai][bj][m][n] * scale;
                        if (out32) *(f32x4*)(out32 + off + bj * HALF + n * 16) = v;
                        if (hb) { u32x2 w; w.x = cvt_pk_bf16(v[0], v[1]); w.y = cvt_pk_bf16(v[2], v[3]); *(u32x2*)(hb + off + bj * HALF + n * 16) = w; }
                        ss += (v[0] * v[0] + v[1] * v[1]) + (v[2] * v[2] + v[3] * v[3]);
                    }
                if (ssqp) { ss += __shfl_xor(ss, 16); ss += __shfl_xor(ss, 32); if (fq == 0) ssqp[(size_t)row * 16 + u.pn * 4 + wc] = ss; }
            }
    }
};

template <int CTRL> __device__ __forceinline__ float dpp_addf(float v) { return v + __builtin_bit_cast(float, __builtin_amdgcn_update_dpp(0, __builtin_bit_cast(int, v), CTRL, 0xf, 0xf, false)); }
struct EpiResT {
    static constexpr bool PERM = false, AFTER_DRAIN = true, KEEP_ACC = false;
    static constexpr int TP = 260;
    const bf16_t* base16; float* out32; bf16_t* hb; float* ssqp; float scale;
    __device__ __forceinline__ void operator()(const f32x4 (&)[2][2][4][2], const Unit&, int, int, int, int) const {}
    __device__ __forceinline__ void fused(const f32x4 (&acc)[2][2][4][2], const Unit& u, int wr, int wc, int fr, int fq, PG8_LAS unsigned char* lds, int wid, int lane) const {
        PG8_LAS float* T = (PG8_LAS float*)lds;
        const int tid = wid * 64 + lane, rr = tid >> 5, cc = (tid & 31) * 8;
#pragma unroll
        for (int ai = 0; ai < 2; ++ai) {
            const size_t g0 = (size_t)(u.pm * BM + ai * HALF + rr) * 1024 + u.pn * BM + cc;
            u32x4 bq[8];
#pragma unroll
            for (int i = 0; i < 8; ++i) bq[i] = *(const u32x4*)(base16 + g0 + (size_t)(16 * i) * 1024);
#pragma unroll
            for (int bj = 0; bj < 2; ++bj)
#pragma unroll
                for (int m = 0; m < 4; ++m)
#pragma unroll
                    for (int n = 0; n < 2; ++n) *(PG8_LAS f32x4*)(T + (wr * 64 + 16 * m + fr) * TP + bj * HALF + wc * 32 + 16 * n + 4 * fq) = acc[ai][bj][m][n];
            __syncthreads();
#pragma unroll
            for (int i = 0; i < 8; ++i) {
                const f32x4 a0 = *(const PG8_LAS f32x4*)(T + (rr + 16 * i) * TP + cc), a1 = *(const PG8_LAS f32x4*)(T + (rr + 16 * i) * TP + cc + 4);
                const u32x4 w = bq[i]; const size_t g = g0 + (size_t)(16 * i) * 1024;
                const f32x4 v0 = (f32x4){bf_lo(w.x), bf_hi(w.x), bf_lo(w.y), bf_hi(w.y)} + a0 * scale, v1 = (f32x4){bf_lo(w.z), bf_hi(w.z), bf_lo(w.w), bf_hi(w.w)} + a1 * scale;
                if (out32) { *(f32x4*)(out32 + g) = v0; *(f32x4*)(out32 + g + 4) = v1; }
                if (hb) { u32x4 o; o.x = cvt_pk_bf16(v0[0], v0[1]); o.y = cvt_pk_bf16(v0[2], v0[3]); o.z = cvt_pk_bf16(v1[0], v1[1]); o.w = cvt_pk_bf16(v1[2], v1[3]); *(u32x4*)(hb + g) = o; }
                if (ssqp) {
                    float ss = ((v0[0] * v0[0] + v0[1] * v0[1]) + (v0[2] * v0[2] + v0[3] * v0[3])) + ((v1[0] * v1[0] + v1[1] * v1[1]) + (v1[2] * v1[2] + v1[3] * v1[3]));
                    ss = dpp_addf<0xB1>(ss); ss = dpp_addf<0x4E>(ss); ss = dpp_addf<0x141>(ss);
                    if ((tid & 7) == 0) ssqp[(size_t)(u.pm * BM + ai * HALF + rr + 16 * i) * 16 + u.pn * 4 + ((tid & 31) >> 3)] = ss;
                }
            }
            __syncthreads();
        }
    }
};

struct EpiMix {
    static constexpr bool PERM = true, AFTER_DRAIN = false, KEEP_ACC = false;
    const PG8_LAS float* tab;
    bf16_t *HQ, *HV, *ZFF, *ZFB, *HG;
    bf16_t *QO; bf16_t *KB, *VB;
    bf16_t *GA, *GB;
    const float *qnw, *knw; const f32x2* ropeR; const f32x2* ropeC; float c2; const float *omlf, *omlb;
    template <int ACT>
    __device__ __forceinline__ void ew_store(const f32x4 (&acc)[2][2][4][2], const Unit& u, bf16_t* dst, int pitch, int row0, int col0, int wr, int fr, const float* oml = nullptr) const {
        float om[2][8];
        if (ACT == 3) {
#pragma unroll
            for (int bj = 0; bj < 2; ++bj) { const f32x4 a = *(const f32x4*)(oml + col0 + bj * HALF), b = *(const f32x4*)(oml + col0 + bj * HALF + 4); om[bj][0] = a[0]; om[bj][1] = a[1]; om[bj][2] = a[2]; om[bj][3] = a[3]; om[bj][4] = b[0]; om[bj][5] = b[1]; om[bj][6] = b[2]; om[bj][7] = b[3]; }
        }
#pragma unroll
        for (int ai = 0; ai < 2; ++ai)
#pragma unroll
            for (int m = 0; m < 4; ++m) {
                const int row = row0 + ai * HALF + m * 16; const float rs = tab[u.idx * BM + ai * HALF + wr * 64 + m * 16 + fr];
#pragma unroll
                for (int bj = 0; bj < 2; ++bj) {
                    float o[8];
#pragma unroll
                    for (int n = 0; n < 2; ++n)
#pragma unroll
                        for (int i = 0; i < 4; ++i) { const float v = acc[ai][bj][m][n][i] * rs;
                            if (ACT == 3) o[4 * n + i] = __builtin_amdgcn_logf(1.0f - om[bj][4 * n + i] * __builtin_amdgcn_rcpf(1.0f + __builtin_amdgcn_exp2f(v * 1.4426950408889634f)));
                            else o[4 * n + i] = (ACT == 0) ? v : ((ACT == 1) ? fast_silu(v) : fast_sigmoid(v)); }
                    u32x4 w; w.x = cvt_pk_bf16(o[0], o[1]); w.y = cvt_pk_bf16(o[2], o[3]); w.z = cvt_pk_bf16(o[4], o[5]); w.w = cvt_pk_bf16(o[6], o[7]);
                    *(u32x4*)(dst + (size_t)row * pitch + col0 + bj * HALF) = w;
                }
            }
    }
    __device__ __forceinline__ void operator()(const f32x4 (&acc)[2][2][4][2], const Unit& u, int wr, int wc, int fr, int fq) const {
        const int row0 = u.pm * BM + wr * 64 + fr; const int pn = u.pn;
        if (pn >= 13) {
            const int col0 = (pn - 13) * HALF + wc * 32 + 8 * fq;
#pragma unroll
            for (int ai = 0; ai < 2; ++ai)
#pragma unroll
                for (int m = 0; m < 4; ++m) {
                    const int row = row0 + ai * HALF + m * 16; const float rs = tab[u.idx * BM + ai * HALF + wr * 64 + m * 16 + fr];
                    float sb[8], ra[8];
#pragma unroll
                    for (int n = 0; n < 2; ++n)
#pragma unroll
                        for (int i = 0; i < 4; ++i) sb[4 * n + i] = fmaxf(fast_sigmoid(acc[ai][1][m][n][i] * rs), 1e-30f);
                    u32x4 wb; wb.x = cvt_pk_bf16(sb[0], sb[1]); wb.y = cvt_pk_bf16(sb[2], sb[3]); wb.z = cvt_pk_bf16(sb[4], sb[5]); wb.w = cvt_pk_bf16(sb[6], sb[7]);
                    const float gbr[8] = {bf_lo(wb.x), bf_hi(wb.x), bf_lo(wb.y), bf_hi(wb.y), bf_lo(wb.z), bf_hi(wb.z), bf_lo(wb.w), bf_hi(wb.w)};
#pragma unroll
                    for (int n = 0; n < 2; ++n)
#pragma unroll
                        for (int i = 0; i < 4; ++i) ra[4 * n + i] = fast_sigmoid(acc[ai][0][m][n][i] * rs) * __builtin_amdgcn_rcpf(gbr[4 * n + i]);
                    u32x4 wa; wa.x = cvt_pk_bf16(ra[0], ra[1]); wa.y = cvt_pk_bf16(ra[2], ra[3]); wa.z = cvt_pk_bf16(ra[4], ra[5]); wa.w = cvt_pk_bf16(ra[6], ra[7]);
                    *(u32x4*)(GA + (size_t)row * 1024 + col0) = wa; *(u32x4*)(GB + (size_t)row * 1024 + col0) = wb;
                }
        } else if (pn < 10) {
            bf16_t* dst; int pitch, ct, act; const float* oml = nullptr;
            if (pn < 2) { dst = HQ; pitch = 512; ct = pn; act = 1; }
            else if (pn < 4) { dst = HV; pitch = 512; ct = pn - 2; act = 0; }
            else if (pn < 6) { dst = ZFF; pitch = 512; ct = pn - 4; act = 3; oml = omlf; }
            else if (pn < 8) { dst = ZFB; pitch = 512; ct = pn - 6; act = 3; oml = omlb; }
            else { dst = HG; pitch = 512; ct = pn - 8; act = 1; }
            const int col0 = ct * BM + wc * 32 + 8 * fq;
            if (act == 0) ew_store<0>(acc, u, dst, pitch, row0, col0, wr, fr); else if (act == 1) ew_store<1>(acc, u, dst, pitch, row0, col0, wr, fr); else if (act == 2) ew_store<2>(acc, u, dst, pitch, row0, col0, wr, fr); else ew_store<3>(acc, u, dst, pitch, row0, col0, wr, fr, oml);
        } else {
            const bool isv = (pn == 12) && (wc >= 2);
            const bool isq = (pn < 12);
            bf16_t* dst; int pitch, hcol;
            if (isq) { dst = QO; pitch = 512; hcol = (4 * (pn - 10) + wc) * 64; }
            else if (!isv) { dst = KB; pitch = 128; hcol = wc * 64; }
            else { dst = VB; pitch = 128; hcol = (wc - 2) * 64; }
            const float* nw = isq ? qnw : knw; const float osc = isq ? c2 : 1.0f;
            float wgt[2][8];
#pragma unroll
            for (int bj = 0; bj < 2; ++bj)
#pragma unroll
                for (int j = 0; j < 8; ++j) wgt[bj][j] = nw[32 * bj + 8 * fq + j] * osc;
#pragma unroll
            for (int ai = 0; ai < 2; ++ai)
#pragma unroll
                for (int m = 0; m < 4; ++m) {
                    const int row = row0 + ai * HALF + m * 16; const float rs = tab[u.idx * BM + ai * HALF + wr * 64 + m * 16 + fr];
                    float x[2][8]; float ss = 0.f;
#pragma unroll
                    for (int bj = 0; bj < 2; ++bj)
#pragma unroll
                        for (int n = 0; n < 2; ++n)
#pragma unroll
                            for (int i = 0; i < 4; ++i) { const float v = acc[ai][bj][m][n][i] * rs; x[bj][4 * n + i] = v; ss += v * v; }
                    if (!isv) {
                        ss += __shfl_xor(ss, 16); ss += __shfl_xor(ss, 32);
                        const float rn = rsqrtf(ss * (1.0f / 64.0f) + RMS_EPS);
                        const int rpos = row >> 6, cpos = row & 63;
#pragma unroll
                        for (int bj = 0; bj < 2; ++bj) {
                            const f32x2* tab = (bj == 0 ? ropeR + rpos * 16 : ropeC + cpos * 16) + 4 * fq;
#pragma unroll
                            for (int pr = 0; pr < 4; ++pr) {
                                const f32x2 cs = tab[pr];
                                const float a = x[bj][2 * pr] * rn * wgt[bj][2 * pr], b = x[bj][2 * pr + 1] * rn * wgt[bj][2 * pr + 1];
                                x[bj][2 * pr] = a * cs.x - b * cs.y; x[bj][2 * pr + 1] = a * cs.y + b * cs.x;
                            }
                        }
                    }
#pragma unroll
                    for (int bj = 0; bj < 2; ++bj) {
                        u32x4 w; w.x = cvt_pk_bf16(x[bj][0], x[bj][1]); w.y = cvt_pk_bf16(x[bj][2], x[bj][3]); w.z = cvt_pk_bf16(x[bj][4], x[bj][5]); w.w = cvt_pk_bf16(x[bj][6], x[bj][7]);
                        *(u32x4*)(dst + (size_t)row * pitch + hcol + 32 * bj + 8 * fq) = w;
                    }
                }
        }
    }
};

struct EpiUp {
    static constexpr bool PERM = true, AFTER_DRAIN = false, KEEP_ACC = true;
    const bf16_t *R, *GB; bf16_t* MX;
    __device__ __forceinline__ bool keep(const Unit& u) const { return u.pn < 4; }
    __device__ __forceinline__ void operator()(f32x4 (&acc)[2][2][4][2], const Unit& u, int wr, int wc, int fr, int fq) const {
        const int z = (u.pn >= 4) ? 1 : 0; const int pm = u.pm - 64 * z, pn = u.pn - 4 * z;
        const bf16_t* G = z ? GB : R;
        const int row0 = pm * BM + wr * 64 + fr, col0 = pn * BM + wc * 32 + 8 * fq;
        u32x4 gq[16];
#define UP_OFF(it) ((size_t)(row0 + ((it) >> 3) * HALF + (((it) >> 1) & 3) * 16) * 1024 + col0 + ((it) & 1) * HALF)
#pragma unroll
        for (int it = 0; it < 4; ++it) gq[it] = *(const u32x4*)(G + UP_OFF(it));
#pragma unroll
        for (int it = 0; it < 16; ++it) {
            const int ai = it >> 3, m = (it >> 1) & 3, bj = it & 1;
            const u32x4 g = gq[it];
            if (it + 4 < 16) gq[it + 4] = *(const u32x4*)(G + UP_OFF(it + 4));
            const f32x4 g0 = {bf_lo(g.x), bf_hi(g.x), bf_lo(g.y), bf_hi(g.y)}, g1 = {bf_lo(g.z), bf_hi(g.z), bf_lo(g.w), bf_hi(g.w)};
            const f32x4 o0 = acc[ai][bj][m][0] * g0, o1 = acc[ai][bj][m][1] * g1;
            if (!z) { acc[ai][bj][m][0] = o0; acc[ai][bj][m][1] = o1; }
            else { u32x4 w; w.x = cvt_pk_bf16(o0[0], o0[1]); w.y = cvt_pk_bf16(o0[2], o0[3]); w.z = cvt_pk_bf16(o1[0], o1[1]); w.w = cvt_pk_bf16(o1[2], o1[3]);
                *(u32x4*)(MX + UP_OFF(it)) = w; }
        }
#undef UP_OFF
    }
};
struct UpOrder {
    StaticOrder so;
    __device__ void init(int G_, int c_) { so.init(16384, 1024, G_, c_); }
    __device__ bool next(int i, Unit& u) const {
        const int rounds = (so.nwg + so.G - 1) / so.G; if (i >= 2 * rounds) return false;
        Unit t; if (!so.next(i >> 1, t)) return false;
        const int z = i & 1; u.pm = t.pm + 64 * z; u.pn = t.pn + 4 * z; u.idx = i; return true;
    }
    __device__ __forceinline__ void a_ready(const Unit&) const {}
    __device__ __forceinline__ void done(const Unit&) const {}
};
template <class Epi, class Sched, bool ALIGN_EPI = false, bool SP2 = false>
__device__ __forceinline__ void gemm_phase(PG8_LAS unsigned char* lds, const Gemm g, const Sched& S, const Epi& E) {
    int tid_ = threadIdx.x; asm volatile("" : "+v"(tid_));
    const int tid = tid_, wid = __builtin_amdgcn_readfirstlane(tid >> 6), lane = tid & 63, wr = wid >> 2, wc = wid & 3, fr = lane & 15, fq = lane >> 4;
    const int K = g.K, nt = K / BK;
    unsigned voffA[2], voffB[2];
#pragma unroll
    for (int i = 0; i < 2; ++i) { int R, C; stage_rc(tid * 16 + i * 8192, R, C); const int Rb = Epi::PERM ? ((R & ~31) + perm32(R & 31)) : R;
        voffA[i] = (unsigned)(R * K + C) * 2u; voffB[i] = (unsigned)(Rb * K + C) * 2u; }
    const size_t kstep = (size_t)(BK * 2);
    const size_t hstep = (size_t)HALF * K * 2;
    const size_t tstep = 2 * hstep;
    const unsigned ldsw = (unsigned)wid * 1024u;
    const int aoff = lds_byte(wr * 64 + fr, fq * 8), boff = lds_byte(wc * 32 + fr, fq * 8);
#define PG8_SA(b, h) (((b) * 2 + (h)) * HTB)
#define PG8_SB(b, h) ((4 + (b) * 2 + (h)) * HTB)
#define PG8_STAGE(bufoff, gbase, voff) do { _Pragma("unroll") for (int _i = 0; _i < 2; ++_i) \
        __builtin_amdgcn_global_load_lds((const unsigned*)((const char*)(gbase) + (voff)[_i]), (PG8_LAS unsigned*)(lds + (bufoff) + ldsw + _i * 8192), 16, 0, 0); } while (0)
#define PG8_LDA(dst, b, h) do { _Pragma("unroll") for (int m = 0; m < 4; ++m) _Pragma("unroll") for (int k = 0; k < 2; ++k) dst[m][k] = *(const PG8_LAS bf16x8*)(lds + PG8_SA(b, h) + aoff + m * 2048 + k * 1024); } while (0)
#define PG8_LDB(dst, b, h) do { _Pragma("unroll") for (int n = 0; n < 2; ++n) _Pragma("unroll") for (int k = 0; k < 2; ++k) dst[n][k] = *(const PG8_LAS bf16x8*)(lds + PG8_SB(b, h) + boff + n * 2048 + k * 1024); } while (0)
#define PG8_MMA(ai, bj, At, Bt) do { __builtin_amdgcn_s_setprio(1); _Pragma("unroll") for (int m = 0; m < 4; ++m) _Pragma("unroll") for (int n = 0; n < 2; ++n) _Pragma("unroll") for (int k = 0; k < 2; ++k) \
        acc[ai][bj][m][n] = __builtin_amdgcn_mfma_f32_16x16x32_bf16(Bt[n][k], At[m][k], acc[ai][bj][m][n], 0, 0, 0); __builtin_amdgcn_s_setprio(0); } while (0)
#define PG8_WAIT_V(n) asm volatile("s_waitcnt vmcnt(" #n ")" ::: "memory")
#define PG8_WAIT_L(n) asm volatile("s_waitcnt lgkmcnt(" #n ")" ::: "memory")
#define PG8_BAR __builtin_amdgcn_s_barrier()
#define PG8_SCHED __builtin_amdgcn_sched_barrier(0)
    Unit cur, nxt; int ui = 0;
    if (!S.next(0, cur)) return;
    f32x4 acc[2][2][4][2];
#pragma unroll
    for (int a = 0; a < 2; ++a)
#pragma unroll
        for (int b = 0; b < 2; ++b)
#pragma unroll
            for (int m = 0; m < 4; ++m)
#pragma unroll
                for (int n = 0; n < 2; ++n) acc[a][b][m][n] = (f32x4){0.f, 0.f, 0.f, 0.f};
    bf16x8 At[4][2], B0[2][2], B1[2][2];
    const char* cA = (const char*)g.A + (size_t)cur.pm * tstep; const char* cB = (const char*)g.Bt + (size_t)cur.pn * tstep;
    S.a_ready(cur);
    if constexpr (SP2) {
        PG8_STAGE(PG8_SB(0, 0), cB, voffB); PG8_STAGE(PG8_SB(0, 1), cB + hstep, voffB); PG8_STAGE(PG8_SA(0, 0), cA, voffA); PG8_STAGE(PG8_SA(0, 1), cA + hstep, voffA);
        if (wr == 1) PG8_BAR;
        PG8_WAIT_V(2); PG8_BAR;
        PG8_STAGE(PG8_SB(1, 0), cB + kstep, voffB); PG8_STAGE(PG8_SB(1, 1), cB + hstep + kstep, voffB);
        PG8_WAIT_V(4); PG8_BAR;
    } else {
        PG8_STAGE(PG8_SB(0, 0), cB, voffB); PG8_STAGE(PG8_SA(0, 0), cA, voffA); PG8_STAGE(PG8_SB(0, 1), cB + hstep, voffB); PG8_STAGE(PG8_SA(0, 1), cA + hstep, voffA);
        if (wr == 1) PG8_BAR;
        PG8_WAIT_V(4); PG8_BAR;
        PG8_STAGE(PG8_SB(1, 0), cB + kstep, voffB); PG8_STAGE(PG8_SA(1, 0), cA + kstep, voffA); PG8_STAGE(PG8_SB(1, 1), cB + hstep + kstep, voffB);
        PG8_WAIT_V(6); PG8_BAR;
    }
    for (;;) {
        const bool has_next = S.next(ui + 1, nxt);
        const char* nA = has_next ? (const char*)g.A + (size_t)nxt.pm * tstep : cA; const char* nB = has_next ? (const char*)g.Bt + (size_t)nxt.pn * tstep : cB;
        for (int t = 0; t < nt; t += 2) {
            const bool last = (t == nt - 2);
            const char* a1 = cA + (size_t)(t + 1) * kstep;
            const char* a2 = last ? nA : cA + (size_t)(t + 2) * kstep; const char* b2 = last ? nB : cB + (size_t)(t + 2) * kstep;
            const char* a3 = a2 + kstep; const char* b3 = b2 + kstep;
            if (last && has_next) S.a_ready(nxt);
            const bool fin = SP2 && last && !has_next;
#define PG8_WVF(nn, nf) do { if (fin) { PG8_WAIT_V(nf); } else { PG8_WAIT_V(nn); } } while (0)
            if constexpr (SP2) {
            PG8_LDB(B0, 0, 0); PG8_LDB(B1, 0, 1); PG8_SCHED; PG8_LDA(At, 0, 0); PG8_STAGE(PG8_SA(1, 0), a1, voffA); PG8_STAGE(PG8_SA(1, 1), a1 + hstep, voffA);
            PG8_WAIT_V(8); PG8_WAIT_L(0); PG8_BAR; PG8_MMA(0, 0, At, B0); PG8_MMA(0, 1, At, B1); PG8_BAR; PG8_SCHED;
            PG8_LDA(At, 0, 1); if (!fin) { PG8_STAGE(PG8_SB(0, 0), b2, voffB); PG8_STAGE(PG8_SB(0, 1), b2 + hstep, voffB); }
            PG8_WVF(6, 2); PG8_WAIT_L(0); PG8_BAR; PG8_MMA(1, 0, At, B0); PG8_MMA(1, 1, At, B1); PG8_BAR; PG8_SCHED;
            PG8_LDB(B0, 1, 0); PG8_LDB(B1, 1, 1); PG8_SCHED; PG8_LDA(At, 1, 0); if (!fin) { PG8_STAGE(PG8_SA(0, 0), a2, voffA); PG8_STAGE(PG8_SA(0, 1), a2 + hstep, voffA); }
            PG8_WVF(8, 0); PG8_WAIT_L(0); PG8_BAR; PG8_MMA(0, 0, At, B0); PG8_MMA(0, 1, At, B1); PG8_BAR; PG8_SCHED;
            PG8_LDA(At, 1, 1); if (!fin) { PG8_STAGE(PG8_SB(1, 0), b3, voffB); PG8_STAGE(PG8_SB(1, 1), b3 + hstep, voffB); }
            PG8_WVF(6, 0); PG8_WAIT_L(0); PG8_BAR; PG8_MMA(1, 0, At, B0); PG8_MMA(1, 1, At, B1); PG8_BAR; PG8_SCHED;
            } else {
            PG8_LDB(B0, 0, 0); PG8_SCHED; PG8_LDA(At, 0, 0); PG8_STAGE(PG8_SA(1, 1), a1 + hstep, voffA);
            PG8_WAIT_L(8); PG8_BAR; PG8_WAIT_L(0); PG8_MMA(0, 0, At, B0); PG8_BAR; PG8_SCHED;
            PG8_LDB(B1, 0, 1); PG8_STAGE(PG8_SB(0, 0), b2, voffB);
            PG8_BAR; PG8_WAIT_L(0); PG8_MMA(0, 1, At, B1); PG8_BAR;
            PG8_LDA(At, 0, 1); PG8_STAGE(PG8_SA(0, 0), a2, voffA);
            PG8_BAR; PG8_WAIT_L(0); PG8_MMA(1, 0, At, B0); PG8_BAR; PG8_SCHED;
            PG8_STAGE(PG8_SB(0, 1), b2 + hstep, voffB);
            PG8_WAIT_V(6); PG8_BAR; PG8_MMA(1, 1, At, B1); PG8_BAR;
            PG8_LDB(B0, 1, 0); PG8_SCHED; PG8_LDA(At, 1, 0); PG8_STAGE(PG8_SA(0, 1), a2 + hstep, voffA);
            PG8_WAIT_L(8); PG8_BAR; PG8_WAIT_L(0); PG8_MMA(0, 0, At, B0); PG8_BAR; PG8_SCHED;
            PG8_LDB(B1, 1, 1); PG8_STAGE(PG8_SB(1, 0), b3, voffB);
            PG8_BAR; PG8_WAIT_L(0); PG8_MMA(0, 1, At, B1); PG8_BAR;
            PG8_LDA(At, 1, 1); PG8_STAGE(PG8_SA(1, 0), a3, voffA);
            PG8_BAR; PG8_WAIT_L(0); PG8_MMA(1, 0, At, B0); PG8_BAR; PG8_SCHED;
            PG8_STAGE(PG8_SB(1, 1), b3 + hstep, voffB);
            PG8_WAIT_V(6); PG8_BAR; PG8_MMA(1, 1, At, B1); PG8_BAR;
            }
        }
        if constexpr (ALIGN_EPI) { if (wr == 0) PG8_BAR; }
        if constexpr (!Epi::AFTER_DRAIN) { E(acc, cur, wr, wc, fr, fq); S.done(cur); }
        bool keep_acc = false; if constexpr (Epi::KEEP_ACC) keep_acc = E.keep(cur);
        if (!has_next) break;
        if (!keep_acc)
#pragma unroll
        for (int a = 0; a < 2; ++a)
#pragma unroll
            for (int b = 0; b < 2; ++b)
#pragma unroll
                for (int m = 0; m < 4; ++m)
#pragma unroll
                    for (int n = 0; n < 2; ++n) acc[a][b][m][n] = (f32x4){0.f, 0.f, 0.f, 0.f};
        cur = nxt; cA = nA; cB = nB; ++ui;
        if constexpr (ALIGN_EPI) { if (wr == 1) PG8_BAR; }
    }
    PG8_WAIT_V(0);
    if constexpr (!ALIGN_EPI) { if (wr == 0) PG8_BAR; }
    PG8_BAR;
    if constexpr (Epi::AFTER_DRAIN) { E.fused(acc, cur, wr, wc, fr, fq, lds, wid, lane); S.done(cur); }
#undef PG8_SA
#undef PG8_SB
#undef PG8_STAGE
#undef PG8_LDA
#undef PG8_LDB
#undef PG8_MMA
#undef PG8_WAIT_V
#undef PG8_WAIT_L
#undef PG8_BAR
#undef PG8_SCHED
#undef PG8_WVF
}
}
namespace attn_body {
using bf16=unsigned short;
__device__ __forceinline__ unsigned short f2bf16(float f){unsigned u=__builtin_bit_cast(unsigned,f);return (unsigned short)((u+0x7fffu+((u>>16)&1u))>>16);}
using bf16x8=__attribute__((ext_vector_type(8)))short;
using s16x4=__attribute__((ext_vector_type(4)))short;
using f32x16=__attribute__((ext_vector_type(16)))float;
using u32x4=__attribute__((ext_vector_type(4)))unsigned;
constexpr int D=64,QP=512,KP=128;
constexpr int NW=8,QBLK=32,QB=QBLK*NW,KVBLK=64;
constexpr int NT=258;
constexpr int ATTN_UNIT_ROWS=QB;
__device__ __forceinline__ int crow(int r,int hi){return (r&3)+8*(r>>2)+4*hi;}
#define SBAR() __builtin_amdgcn_sched_barrier(0)
__device__ __forceinline__ void cmask(f32x16&p0,f32x16&p1,int jb){
  const float NEG=-INFINITY;
  if(jb==2){
    #pragma unroll
    for(int r=8;r<16;++r)p0[r]=NEG;
    #pragma unroll
    for(int r=0;r<16;++r)p1[r]=NEG;
  } else if(jb==3){
    #pragma unroll
    for(int r=0;r<16;++r){p0[r]=NEG;p1[r]=NEG;}
  }
}

constexpr int NSLOT=3, SLOTB=8192;
constexpr int LDS_K=0, LDS_V=NSLOT*SLOTB, LDS_WS=2*NSLOT*SLOTB, LDS_OST=LDS_WS+NW*64*4, LDS_BYTES=LDS_OST+NW*4096;
constexpr float C2=0.125f*1.4426950408889634f;
__device__ __forceinline__ void glds16(const void*gsrc,unsigned lds_dst){unsigned keep;
  asm volatile("s_mov_b32 %0, m0\n\ts_mov_b32 m0, %2\n\ts_nop 0\n\tglobal_load_lds_dwordx4 %1, off\n\ts_mov_b32 m0, %0":"=&s"(keep):"v"(gsrc),"s"(lds_dst):"memory");}
__device__ __forceinline__ float max3f(float a,float b,float c){float r;asm("v_max3_f32 %0, %1, %2, %3":"=v"(r):"v"(a),"v"(b),"v"(c));return r;}
__device__ __forceinline__ float max2f(float a,float b){float r;asm("v_max_f32_e32 %0, %1, %2":"=v"(r):"v"(a),"v"(b));return r;}
__device__ __forceinline__ float fadd_s(float a,float b){float r;asm("v_add_f32_e32 %0, %1, %2":"=v"(r):"v"(a),"v"(b));return r;}
__device__ __forceinline__ float fsub_s(float a,float b){float r;asm("v_sub_f32_e32 %0, %1, %2":"=v"(r):"v"(a),"v"(b));return r;}
typedef float f32x2_t __attribute__((ext_vector_type(2))); typedef __bf16 bf16x2_t __attribute__((ext_vector_type(2)));
__device__ __forceinline__ unsigned cvtpk_s(float lo,float hi){f32x2_t v={lo,hi};bf16x2_t b=__builtin_convertvector(v,bf16x2_t);return __builtin_bit_cast(unsigned,b);}
#define WAIT_BAR(N) asm volatile("s_waitcnt vmcnt(" #N ") lgkmcnt(0)\n\ts_barrier":::"memory")

__device__ __forceinline__ void qkt(f32x16&p0,f32x16&p1,const char*Kslot,const bf16x8*qr,const f32x16&negm,int r32,int hi){
  const char*kb=Kslot+hi*1024+r32*16;
  #pragma unroll
  for(int d0=0;d0<4;++d0){
    const bf16x8 b0=*reinterpret_cast<const bf16x8*>(kb+d0*2048);
    const bf16x8 b1=*reinterpret_cast<const bf16x8*>(kb+d0*2048+512);
    if(d0==0){p0=__builtin_amdgcn_mfma_f32_32x32x16_bf16(b0,qr[0],negm,0,0,0);p1=__builtin_amdgcn_mfma_f32_32x32x16_bf16(b1,qr[0],negm,0,0,0);}
    else{p0=__builtin_amdgcn_mfma_f32_32x32x16_bf16(b0,qr[d0],p0,0,0,0);p1=__builtin_amdgcn_mfma_f32_32x32x16_bf16(b1,qr[d0],p1,0,0,0);}}
}
typedef __attribute__((address_space(3))) const char* lds_cptr;
typedef short v4i16_t __attribute__((ext_vector_type(4)));
__device__ __forceinline__ void kload8(bf16x8*kf,lds_cptr kp){
  kf[0]=*(const __attribute__((address_space(3))) bf16x8*)(kp);      kf[1]=*(const __attribute__((address_space(3))) bf16x8*)(kp+512);
  kf[2]=*(const __attribute__((address_space(3))) bf16x8*)(kp+2048); kf[3]=*(const __attribute__((address_space(3))) bf16x8*)(kp+2560);
  kf[4]=*(const __attribute__((address_space(3))) bf16x8*)(kp+4096); kf[5]=*(const __attribute__((address_space(3))) bf16x8*)(kp+4608);
  kf[6]=*(const __attribute__((address_space(3))) bf16x8*)(kp+6144); kf[7]=*(const __attribute__((address_space(3))) bf16x8*)(kp+6656);
}
__device__ __forceinline__ void kload2(bf16x8*kf,lds_cptr kp,int j){ kf[2*j]=*(const __attribute__((address_space(3))) bf16x8*)(kp+j*2048); kf[2*j+1]=*(const __attribute__((address_space(3))) bf16x8*)(kp+j*2048+512); }
__device__ __forceinline__ s16x4 vtr(lds_cptr p){ return __builtin_bit_cast(s16x4,__builtin_amdgcn_ds_read_tr16_b64_v4i16((__attribute__((address_space(3))) v4i16_t*)p)); }
__device__ __forceinline__ float rowmax(const f32x16&p0,const f32x16&p1){
  float a=max3f(p0[0],p0[1],p1[0]),b=max3f(p0[2],p0[3],p1[1]);a=max3f(a,p1[2],p1[3]);
  #pragma unroll
  for(int r=4;r<16;r+=4){a=max3f(a,p0[r],p0[r+1]);b=max3f(b,p0[r+2],p0[r+3]);a=max3f(a,p1[r],p1[r+1]);b=max3f(b,p1[r+2],p1[r+3]);}
  const float m=max2f(a,b);
  auto rr=__builtin_amdgcn_permlane32_swap(__float_as_uint(m),__float_as_uint(m),false,false);
  return max2f(__uint_as_float(rr[0]),__uint_as_float(rr[1]));
}
__device__ __forceinline__ void pv(f32x16*o,int vb,bf16x8 pa0,bf16x8 pa1,bf16x8 pa2,bf16x8 pa3){
  #pragma unroll
  for(int d0=0;d0<2;++d0){s16x4 lo[4],hi[4];
    #pragma unroll
    for(int ks=0;ks<4;++ks){
      asm volatile("ds_read_b64_tr_b16 %0,%1 offset:%c2":"=&v"(lo[ks]):"v"(vb),"i"(d0*4096+ks*1024):"memory");
      asm volatile("ds_read_b64_tr_b16 %0,%1 offset:%c2":"=&v"(hi[ks]):"v"(vb),"i"(d0*4096+ks*1024+512):"memory");}
    asm volatile("s_waitcnt lgkmcnt(0)":::"memory");SBAR();
    #define PK(k) (bf16x8){lo[k][0],lo[k][1],lo[k][2],lo[k][3],hi[k][0],hi[k][1],hi[k][2],hi[k][3]}
    o[d0]=__builtin_amdgcn_mfma_f32_32x32x16_bf16(pa0,PK(0),o[d0],0,0,0);
    o[d0]=__builtin_amdgcn_mfma_f32_32x32x16_bf16(pa1,PK(1),o[d0],0,0,0);
    o[d0]=__builtin_amdgcn_mfma_f32_32x32x16_bf16(pa2,PK(2),o[d0],0,0,0);
    o[d0]=__builtin_amdgcn_mfma_f32_32x32x16_bf16(pa3,PK(3),o[d0],0,0,0);
    #undef PK
  }
}

#ifndef ATTN_STORE16
#define ATTN_STORE16(p,v) (*(u32x4*)(p)=(v))
#endif
template<int THRL> __device__ __forceinline__ void attn_unit(int h,int qb,const bf16*Q,const bf16*__restrict__ K,const bf16*__restrict__ V,bf16*O,char*shm){
  int tid_=threadIdx.x; asm volatile("":"+v"(tid_));
  const int tid=tid_,lane=tid&63,r32=lane&31,hi=lane>>5; const int wid=__builtin_amdgcn_readfirstlane(tid>>6);
  const int q0=qb*QB; const int kvh=h>>2;
  const bf16*Qw=Q+(long)(q0+wid*QBLK)*QP+h*D;
  const bf16*Kh=K+kvh*D,*Vh=V+kvh*D;
  const unsigned lds0=(unsigned)(uintptr_t)shm;
  float*wsf=(float*)(shm+LDS_WS)+wid*64;
  const bf16*ksrc=Kh+(long)lane*KP+wid*8;
  const bf16*vsrc=Vh+(long)(16*(wid&3)+(lane>>2))*KP+(wid>>2)*32+(lane&3)*8;
  const unsigned kdst=lds0+LDS_K+wid*1024, vdst=lds0+LDS_V+wid*1024;
  #define DMA_K(t,slot) glds16(ksrc+(long)(t)*KVBLK*KP,(unsigned)__builtin_amdgcn_readfirstlane(kdst+(slot)))
  #define DMA_V(t,slot) glds16(vsrc+(long)(t)*KVBLK*KP,(unsigned)__builtin_amdgcn_readfirstlane(vdst+(slot)))
  const int vb0=(int)(lds0+LDS_V)+((lane>>4)&1)*32+(lane&3)*8+(4*hi+((lane&15)>>2))*64;
  const char*Kbase=shm+LDS_K; bf16x8 kf[8];
  const lds_cptr shm3=(lds_cptr)shm; const lds_cptr kp0=shm3+LDS_K+hi*1024+r32*16; const lds_cptr vp0=shm3+LDS_V+((lane>>4)&1)*32+(lane&3)*8+(4*hi+((lane&15)>>2))*64;
  DMA_K(0,0);DMA_V(0,0);DMA_K(1,SLOTB);
  bf16x8 qr[4];
  #pragma unroll
  for(int d0=0;d0<4;++d0)qr[d0]=*reinterpret_cast<const bf16x8*>(&Qw[(long)r32*QP+d0*16+hi*8]);
  float mhat=0.f,l_reg=0.f;f32x16 o[2];o[0]=f32x16{};o[1]=f32x16{};f32x16 negm=f32x16{};asm volatile("":"+v"(negm));
  #define CMASK(P0,P1,t) do{int jb_=(t)-(NT-4); if(jb_>=2)cmask(P0,P1,jb_);}while(0)
  bool resc=false;
  #define START(P0,P1) do{ const float rm=rowmax(P0,P1); resc=false; \
    { const float dl=rm; mhat=fadd_s(mhat,dl); \
      _Pragma("unroll") for(int r=0;r<16;++r){P0[r]=fsub_s(P0[r],dl);P1[r]=fsub_s(P1[r],dl);} \
      _Pragma("unroll") for(int r=0;r<16;++r)negm[r]=-mhat; asm volatile("":"+v"(negm)); } \
    _Pragma("unroll") for(int r=0;r<16;++r)P0[r]=__builtin_amdgcn_exp2f(P0[r]); }while(0)
  #define RESC() do{ if(resc){ asm volatile("s_waitcnt lgkmcnt(0)":::"memory"); \
      _Pragma("unroll") for(int d_=0;d_<2;++d_) _Pragma("unroll") for(int r=0;r<16;++r)o[d_][r]*=wsf[crow(r,hi)]; } }while(0)
  f32x16 pA0,pA1,pB0,pB1;
  int sl_prev=0,sl_cur=0,sl_next=SLOTB;
  #define ROT() do{sl_prev=sl_cur;sl_cur=sl_next;sl_next=(sl_next==(NSLOT-1)*SLOTB)?0:sl_next+SLOTB;}while(0)
  DMA_K(2,2*SLOTB);
  WAIT_BAR(3);
  qkt(pA0,pA1,Kbase,qr,negm,r32,hi);asm volatile("s_nop 15\n\ts_nop 7":"+v"(pA0),"+v"(pA1));CMASK(pA0,pA1,0);
  START(pA0,pA1);
  _Pragma("unroll") for(int r=0;r<16;++r)pA1[r]=__builtin_amdgcn_exp2f(pA1[r]);
  WAIT_BAR(0);
  DMA_K(3,0);DMA_V(1,SLOTB);
  ROT();
  kload8(kf,kp0+sl_cur);
  WAIT_BAR(2);
  s16x4 vlo[8],vhi[8]; u32x4 pw0,pw1,pw2,pw3;
  #define PKW(P,B) cvtpk_s(P[B],P[B+1])
  #define PAF(k) __builtin_bit_cast(bf16x8,pw##k)
  #define VFR(i) (bf16x8){vlo[i][0],vlo[i][1],vlo[i][2],vlo[i][3],vhi[i][0],vhi[i][1],vhi[i][2],vhi[i][3]}
  #define PIN(x) asm volatile("":"+v"(x))
  #define MX3(a,b,c) __builtin_fmaxf(__builtin_fmaxf((a),(b)),(c))
  #define GAPA(MF,A0,A1,A2,A3,W0,W1,PW) do{ MF; sacc+=A0; sacc+=A1; sacc+=A2; sacc+=A3; PIN(sacc); W0; W1; PIN(PW); SBAR(); }while(0)
  #define EX(v) __builtin_amdgcn_exp2f(v)
  #define GAPB(MF,X,B) do{ MF; X[B]=EX(X[B]); X[B+1]=EX(X[B+1]); X[B+2]=EX(X[B+2]); X[B+3]=EX(X[B+3]); PIN(X); SBAR(); }while(0)
  #define VRD(i) do{ vlo[i]=vtr(vp_+(((i)>>2)*4096+((i)&3)*1024)); vhi[i]=vtr(vp_+(((i)>>2)*4096+((i)&3)*1024+512)); }while(0)
  #define KRD(G,j) do{ if(G){ kload2(kf,kp0+sl_next,j); SBAR(); } }while(0)
  #define STEP(C0,C1,P0,P1,t,GK,GV,GL) do{ SBAR(); \
    const lds_cptr vp_=vp0+sl_prev; \
    VRD(0); SBAR(); float sacc=(P0[0]+P0[1]); \
    GAPA(C0=__builtin_amdgcn_mfma_f32_32x32x16_bf16(kf[0],qr[0],negm,0,0,0), P0[2],P0[3],P0[4],P0[5],     pw0[0]=PKW(P0,0), pw0[1]=PKW(P0,2), pw0); \
    VRD(4); SBAR(); GAPA(C1=__builtin_amdgcn_mfma_f32_32x32x16_bf16(kf[1],qr[0],negm,0,0,0), P0[6],P0[7],P0[8],P0[9],     pw0[2]=PKW(P0,4), pw0[3]=PKW(P0,6), pw0); \
    VRD(1); SBAR(); GAPA(C0=__builtin_amdgcn_mfma_f32_32x32x16_bf16(kf[2],qr[1],C0,0,0,0),   P0[10],P0[11],P0[12],P0[13], pw1[0]=PKW(P0,8), pw1[1]=PKW(P0,10), pw1); \
    VRD(5); SBAR(); GAPA(C1=__builtin_amdgcn_mfma_f32_32x32x16_bf16(kf[3],qr[1],C1,0,0,0),   P0[14],P0[15],P1[0],P1[1],   pw1[2]=PKW(P0,12),pw1[3]=PKW(P0,14), pw1); \
    VRD(2); SBAR(); GAPA(C0=__builtin_amdgcn_mfma_f32_32x32x16_bf16(kf[4],qr[2],C0,0,0,0),   P1[2],P1[3],P1[4],P1[5],     pw2[0]=PKW(P1,0), pw2[1]=PKW(P1,2), pw2); \
    VRD(6); SBAR(); GAPA(C1=__builtin_amdgcn_mfma_f32_32x32x16_bf16(kf[5],qr[2],C1,0,0,0),   P1[6],P1[7],P1[8],P1[9],     pw2[2]=PKW(P1,4), pw2[3]=PKW(P1,6), pw2); \
    VRD(3); SBAR(); GAPA(C0=__builtin_amdgcn_mfma_f32_32x32x16_bf16(kf[6],qr[3],C0,0,0,0),   P1[10],P1[11],P1[12],P1[13], pw3[0]=PKW(P1,8), pw3[1]=PKW(P1,10), pw3); \
    VRD(7); SBAR(); GAPA(C1=__builtin_amdgcn_mfma_f32_32x32x16_bf16(kf[7],qr[3],C1,0,0,0),   P1[14],P1[15],0.f,0.f,       pw3[2]=PKW(P1,12),pw3[3]=PKW(P1,14), pw3); \
    l_reg+=sacc; \
    if(GK){DMA_K((t)+3,sl_cur);} if(GV){DMA_V((t)+1,sl_next);} \
    CMASK(C0,C1,t); \
    { float a=MX3(C0[0],C0[1],C1[0]),b=MX3(C0[2],C0[3],C1[1]); a=MX3(a,C1[2],C1[3]); \
      _Pragma("unroll") for(int r=4;r<16;r+=4){a=MX3(a,C0[r],C0[r+1]);b=MX3(b,C0[r+2],C0[r+3]);a=MX3(a,C1[r],C1[r+1]);b=MX3(b,C1[r+2],C1[r+3]);} \
      float rm=__builtin_fmaxf(a,b); { auto rr=__builtin_amdgcn_permlane32_swap(__float_as_uint(rm),__float_as_uint(rm),false,false); rm=__builtin_fmaxf(__uint_as_float(rr[0]),__uint_as_float(rr[1])); } \
      resc=false; \
      if(__builtin_expect(__any(rm>(float)THRL),0)){ const float dl=__builtin_fmaxf(rm,0.f); mhat+=dl; \
        _Pragma("unroll") for(int r=0;r<16;++r){C0[r]-=dl;C1[r]-=dl;} \
        _Pragma("unroll") for(int r=0;r<16;++r)negm[r]=-mhat; asm volatile("":"+v"(negm)); \
        const float f=__builtin_amdgcn_exp2f(-dl); l_reg*=f; if(hi==0)wsf[r32]=f; resc=true; } } \
    SBAR(); \
    GAPB(o[0]=__builtin_amdgcn_mfma_f32_32x32x16_bf16(PAF(0),VFR(0),o[0],0,0,0), C0,0); \
    GAPB(o[1]=__builtin_amdgcn_mfma_f32_32x32x16_bf16(PAF(0),VFR(4),o[1],0,0,0), C0,4); \
    KRD(GL,0); GAPB(o[0]=__builtin_amdgcn_mfma_f32_32x32x16_bf16(PAF(1),VFR(1),o[0],0,0,0), C0,8); \
    KRD(GL,1); GAPB(o[1]=__builtin_amdgcn_mfma_f32_32x32x16_bf16(PAF(1),VFR(5),o[1],0,0,0), C0,12); \
    KRD(GL,2); GAPB(o[0]=__builtin_amdgcn_mfma_f32_32x32x16_bf16(PAF(2),VFR(2),o[0],0,0,0), C1,0); \
    KRD(GL,3); GAPB(o[1]=__builtin_amdgcn_mfma_f32_32x32x16_bf16(PAF(2),VFR(6),o[1],0,0,0), C1,4); \
    GAPB(o[0]=__builtin_amdgcn_mfma_f32_32x32x16_bf16(PAF(3),VFR(3),o[0],0,0,0), C1,8); \
    GAPB(o[1]=__builtin_amdgcn_mfma_f32_32x32x16_bf16(PAF(3),VFR(7),o[1],0,0,0), C1,12); \
    }while(0)
  int t=1;
  #undef CMASK
  #define CMASK(P0,P1,t) do{}while(0)
  for(;t+5<NT;t+=2){
    STEP(pB0,pB1,pA0,pA1,t,true,true,true);     WAIT_BAR(2); RESC(); ROT();
    STEP(pA0,pA1,pB0,pB1,t+1,true,true,true);   WAIT_BAR(2); RESC(); ROT();
  }
  #undef CMASK
  #define CMASK(P0,P1,t) do{int jb_=(t)-(NT-4); if(jb_>=2)cmask(P0,P1,jb_);}while(0)
  #define ENDW(tt) do{ if((tt)+3<NT){WAIT_BAR(2);} else if((tt)+2<NT){WAIT_BAR(1);} else {WAIT_BAR(0);} }while(0)
  for(;t+1<NT;t+=2){
    STEP(pB0,pB1,pA0,pA1,t,(t+3<NT),(t+1<NT),(t+1<NT));       ENDW(t);   RESC(); ROT();
    STEP(pA0,pA1,pB0,pB1,t+1,(t+4<NT),(t+2<NT),(t+2<NT));     ENDW(t+1); RESC(); ROT();
  }
  STEP(pB0,pB1,pA0,pA1,NT-1,false,false,false); RESC();
  { float sacc=pB0[0]+pB0[1]; _Pragma("unroll") for(int r=2;r<16;++r)sacc+=pB0[r]; _Pragma("unroll") for(int r=0;r<16;++r)sacc+=pB1[r]; l_reg+=sacc;
    pw0=(u32x4){PKW(pB0,0),PKW(pB0,2),PKW(pB0,4),PKW(pB0,6)};pw1=(u32x4){PKW(pB0,8),PKW(pB0,10),PKW(pB0,12),PKW(pB0,14)};pw2=(u32x4){PKW(pB1,0),PKW(pB1,2),PKW(pB1,4),PKW(pB1,6)};pw3=(u32x4){PKW(pB1,8),PKW(pB1,10),PKW(pB1,12),PKW(pB1,14)};
    SBAR(); pv(o,vb0+sl_cur,PAF(0),PAF(1),PAF(2),PAF(3)); }
  #undef PKW
  #undef PAF
  #undef VFR
  #undef PIN
  #undef MX3
  #undef GAPA
  #undef GAPB
  #undef EX
  #undef VRD
  #undef KRD
  #undef STEP
  #undef ENDW
  {auto rr=__builtin_amdgcn_permlane32_swap(__float_as_uint(l_reg),__float_as_uint(l_reg),false,false);l_reg=__uint_as_float(rr[0])+__uint_as_float(rr[1]);}
  if(hi==0)wsf[32+r32]=l_reg;asm volatile("s_waitcnt lgkmcnt(0)":::"memory");
  float rli[16];
  #pragma unroll
  for(int r=0;r<16;++r)rli[r]=__builtin_amdgcn_rcpf(wsf[32+crow(r,hi)]);
  bf16*Ow=O+(long)(q0+wid*QBLK)*QP+h*D;
  { bf16*stg=(bf16*)(shm+LDS_OST)+wid*2048;
    #pragma unroll
    for(int r=0;r<16;++r){const int orow=crow(r,hi);
      #pragma unroll
      for(int d0=0;d0<2;++d0)stg[orow*64+d0*32+r32]=f2bf16(o[d0][r]*rli[r]);}
    asm volatile("s_waitcnt lgkmcnt(0)":::"memory");
    #pragma unroll
    for(int i=0;i<4;++i){const int row=i*8+(lane>>3),ch=lane&7; const u32x4 v=*(const u32x4*)(stg+row*64+ch*8); ATTN_STORE16(Ow+(long)row*QP+ch*8,v);} }
  asm volatile("s_waitcnt lgkmcnt(0)\n\ts_barrier":::"memory");
  #undef DMA_K
  #undef DMA_V
  #undef CMASK
  #undef START
  #undef RESC
  #undef ROT
}
__device__ __forceinline__ void attn_unit_fixed(float mref,int h,int qb,const bf16*Q,const bf16*__restrict__ K,const bf16*__restrict__ V,bf16*O,char*shm){
  int tid_=threadIdx.x; asm volatile("":"+v"(tid_));
  const int tid=tid_,lane=tid&63,r32=lane&31,hi=lane>>5; const int wid=__builtin_amdgcn_readfirstlane(tid>>6);
  const int q0=qb*QB; const int kvh=h>>2;
  const bf16*Qw=Q+(long)(q0+wid*QBLK)*QP+h*D;
  const bf16*Kh=K+kvh*D,*Vh=V+kvh*D;
  const unsigned lds0=(unsigned)(uintptr_t)shm;
  float*wsf=(float*)(shm+LDS_WS)+wid*64;
  const bf16*ksrc=Kh+(long)lane*KP+wid*8;
  const bf16*vsrc=Vh+(long)(16*(wid&3)+(lane>>2))*KP+(wid>>2)*32+(lane&3)*8;
  const unsigned kdst=lds0+LDS_K+wid*1024, vdst=lds0+LDS_V+wid*1024;
  #define DMA_K(t,slot) glds16(ksrc+(long)(t)*KVBLK*KP,(unsigned)__builtin_amdgcn_readfirstlane(kdst+(slot)))
  #define DMA_V(t,slot) glds16(vsrc+(long)(t)*KVBLK*KP,(unsigned)__builtin_amdgcn_readfirstlane(vdst+(slot)))
  const int vb0=(int)(lds0+LDS_V)+((lane>>4)&1)*32+(lane&3)*8+(4*hi+((lane&15)>>2))*64;
  const char*Kbase=shm+LDS_K; bf16x8 kf[8];
  const lds_cptr shm3=(lds_cptr)shm; const lds_cptr kp0=shm3+LDS_K+hi*1024+r32*16; const lds_cptr vp0=shm3+LDS_V+((lane>>4)&1)*32+(lane&3)*8+(4*hi+((lane&15)>>2))*64;
  DMA_K(0,0);DMA_V(0,0);DMA_K(1,SLOTB);
  bf16x8 qr[4];
  #pragma unroll
  for(int d0=0;d0<4;++d0)qr[d0]=*reinterpret_cast<const bf16x8*>(&Qw[(long)r32*QP+d0*16+hi*8]);
  f32x16 o[2];o[0]=f32x16{};o[1]=f32x16{};float l_reg=0.f;f32x16 negm;
  #pragma unroll
  for(int r=0;r<16;++r)negm[r]=-mref;
  asm volatile("":"+v"(negm));
  #define CMASK(P0,P1,t) do{int jb_=(t)-(NT-4); if(jb_>=2)cmask(P0,P1,jb_);}while(0)
  #define START(P0,P1) do{ _Pragma("unroll") for(int r=0;r<16;++r)P0[r]=__builtin_amdgcn_exp2f(P0[r]); }while(0)
  f32x16 pA0,pA1,pB0,pB1;
  int sl_prev=0,sl_cur=0,sl_next=SLOTB;
  #define ROT() do{sl_prev=sl_cur;sl_cur=sl_next;sl_next=(sl_next==(NSLOT-1)*SLOTB)?0:sl_next+SLOTB;}while(0)
  DMA_K(2,2*SLOTB);
  WAIT_BAR(3);
  qkt(pA0,pA1,Kbase,qr,negm,r32,hi);asm volatile("s_nop 15\n\ts_nop 7":"+v"(pA0),"+v"(pA1));CMASK(pA0,pA1,0);
  START(pA0,pA1);
  _Pragma("unroll") for(int r=0;r<16;++r)pA1[r]=__builtin_amdgcn_exp2f(pA1[r]);
  WAIT_BAR(0);
  DMA_K(3,0);DMA_V(1,SLOTB);
  ROT();
  kload8(kf,kp0+sl_cur);
  WAIT_BAR(2);
  s16x4 vlo[8],vhi[8]; u32x4 pw0,pw1,pw2,pw3;
  #define PKW(P,B) cvtpk_s(P[B],P[B+1])
  #define PAF(k) __builtin_bit_cast(bf16x8,pw##k)
  #define VFR(i) (bf16x8){vlo[i][0],vlo[i][1],vlo[i][2],vlo[i][3],vhi[i][0],vhi[i][1],vhi[i][2],vhi[i][3]}
  #define PIN(x) asm volatile("":"+v"(x))
  #define MX3(a,b,c) __builtin_fmaxf(__builtin_fmaxf((a),(b)),(c))
  #define GAPA(MF,A0,A1,A2,A3,W0,W1,PW) do{ MF; sacc+=A0; sacc+=A1; sacc+=A2; sacc+=A3; PIN(sacc); W0; W1; PIN(PW); SBAR(); }while(0)
  #define EX(v) __builtin_amdgcn_exp2f(v)
  #define GAPB(MF,X,B) do{ MF; X[B]=EX(X[B]); X[B+1]=EX(X[B+1]); X[B+2]=EX(X[B+2]); X[B+3]=EX(X[B+3]); PIN(X); SBAR(); }while(0)
  #define VRD(i) do{ vlo[i]=vtr(vp_+(((i)>>2)*4096+((i)&3)*1024)); vhi[i]=vtr(vp_+(((i)>>2)*4096+((i)&3)*1024+512)); }while(0)
  #define KRD(G,j) do{ if(G){ kload2(kf,kp0+sl_next,j); SBAR(); } }while(0)
  #define STEP(C0,C1,P0,P1,t,GK,GV,GL) do{ SBAR(); \
    if(GK){DMA_K((t)+3,sl_cur);} if(GV){DMA_V((t)+1,sl_next);} \
    const lds_cptr vp_=vp0+sl_prev; \
    VRD(0); SBAR(); float sacc=(P0[0]+P0[1]); \
    GAPA(C0=__builtin_amdgcn_mfma_f32_32x32x16_bf16(kf[0],qr[0],negm,0,0,0), P0[2],P0[3],P0[4],P0[5],     pw0[0]=PKW(P0,0), pw0[1]=PKW(P0,2), pw0); \
    VRD(4); SBAR(); GAPA(C1=__builtin_amdgcn_mfma_f32_32x32x16_bf16(kf[1],qr[0],negm,0,0,0), P0[6],P0[7],P0[8],P0[9],     pw0[2]=PKW(P0,4), pw0[3]=PKW(P0,6), pw0); \
    VRD(1); SBAR(); GAPA(C0=__builtin_amdgcn_mfma_f32_32x32x16_bf16(kf[2],qr[1],C0,0,0,0),   P0[10],P0[11],P0[12],P0[13], pw1[0]=PKW(P0,8), pw1[1]=PKW(P0,10), pw1); \
    VRD(5); SBAR(); GAPA(C1=__builtin_amdgcn_mfma_f32_32x32x16_bf16(kf[3],qr[1],C1,0,0,0),   P0[14],P0[15],P1[0],P1[1],   pw1[2]=PKW(P0,12),pw1[3]=PKW(P0,14), pw1); \
    VRD(2); SBAR(); GAPA(C0=__builtin_amdgcn_mfma_f32_32x32x16_bf16(kf[4],qr[2],C0,0,0,0),   P1[2],P1[3],P1[4],P1[5],     pw2[0]=PKW(P1,0), pw2[1]=PKW(P1,2), pw2); \
    VRD(6); SBAR(); GAPA(C1=__builtin_amdgcn_mfma_f32_32x32x16_bf16(kf[5],qr[2],C1,0,0,0),   P1[6],P1[7],P1[8],P1[9],     pw2[2]=PKW(P1,4), pw2[3]=PKW(P1,6), pw2); \
    VRD(3); SBAR(); GAPA(C0=__builtin_amdgcn_mfma_f32_32x32x16_bf16(kf[6],qr[3],C0,0,0,0),   P1[10],P1[11],P1[12],P1[13], pw3[0]=PKW(P1,8), pw3[1]=PKW(P1,10), pw3); \
    VRD(7); SBAR(); GAPA(C1=__builtin_amdgcn_mfma_f32_32x32x16_bf16(kf[7],qr[3],C1,0,0,0),   P1[14],P1[15],0.f,0.f,       pw3[2]=PKW(P1,12),pw3[3]=PKW(P1,14), pw3); \
    l_reg+=sacc; \
    CMASK(C0,C1,t); \
    SBAR(); \
    GAPB(o[0]=__builtin_amdgcn_mfma_f32_32x32x16_bf16(PAF(0),VFR(0),o[0],0,0,0), C0,0); \
    GAPB(o[1]=__builtin_amdgcn_mfma_f32_32x32x16_bf16(PAF(0),VFR(4),o[1],0,0,0), C0,4); \
    KRD(GL,0); GAPB(o[0]=__builtin_amdgcn_mfma_f32_32x32x16_bf16(PAF(1),VFR(1),o[0],0,0,0), C0,8); \
    KRD(GL,1); GAPB(o[1]=__builtin_amdgcn_mfma_f32_32x32x16_bf16(PAF(1),VFR(5),o[1],0,0,0), C0,12); \
    KRD(GL,2); GAPB(o[0]=__builtin_amdgcn_mfma_f32_32x32x16_bf16(PAF(2),VFR(2),o[0],0,0,0), C1,0); \
    KRD(GL,3); GAPB(o[1]=__builtin_amdgcn_mfma_f32_32x32x16_bf16(PAF(2),VFR(6),o[1],0,0,0), C1,4); \
    GAPB(o[0]=__builtin_amdgcn_mfma_f32_32x32x16_bf16(PAF(3),VFR(3),o[0],0,0,0), C1,8); \
    GAPB(o[1]=__builtin_amdgcn_mfma_f32_32x32x16_bf16(PAF(3),VFR(7),o[1],0,0,0), C1,12); \
    }while(0)
  int t=1;
  #undef CMASK
  #define CMASK(P0,P1,t) do{}while(0)
  for(;t+5<NT;t+=2){
    STEP(pB0,pB1,pA0,pA1,t,true,true,true);     WAIT_BAR(2); ROT();
    STEP(pA0,pA1,pB0,pB1,t+1,true,true,true);   WAIT_BAR(2); ROT();
  }
  #undef CMASK
  #define CMASK(P0,P1,t) do{int jb_=(t)-(NT-4); if(jb_>=2)cmask(P0,P1,jb_);}while(0)
  #define ENDW(tt) do{ if((tt)+3<NT){WAIT_BAR(2);} else if((tt)+2<NT){WAIT_BAR(1);} else {WAIT_BAR(0);} }while(0)
  for(;t+1<NT;t+=2){
    STEP(pB0,pB1,pA0,pA1,t,(t+3<NT),(t+1<NT),(t+1<NT));       ENDW(t);   ROT();
    STEP(pA0,pA1,pB0,pB1,t+1,(t+4<NT),(t+2<NT),(t+2<NT));     ENDW(t+1); ROT();
  }
  STEP(pB0,pB1,pA0,pA1,NT-1,false,false,false);
  {
    pw0=(u32x4){PKW(pB0,0),PKW(pB0,2),PKW(pB0,4),PKW(pB0,6)};pw1=(u32x4){PKW(pB0,8),PKW(pB0,10),PKW(pB0,12),PKW(pB0,14)};pw2=(u32x4){PKW(pB1,0),PKW(pB1,2),PKW(pB1,4),PKW(pB1,6)};pw3=(u32x4){PKW(pB1,8),PKW(pB1,10),PKW(pB1,12),PKW(pB1,14)};
    { float sacc=pB0[0]+pB0[1]; _Pragma("unroll") for(int r=2;r<16;++r)sacc+=pB0[r]; _Pragma("unroll") for(int r=0;r<16;++r)sacc+=pB1[r]; l_reg+=sacc; }
    SBAR(); pv(o,vb0+sl_cur,PAF(0),PAF(1),PAF(2),PAF(3)); }
  #undef PKW
  #undef PAF
  #undef VFR
  #undef PIN
  #undef MX3
  #undef GAPA
  #undef GAPB
  #undef EX
  #undef VRD
  #undef KRD
  #undef STEP
  #undef ENDW
  {auto rr=__builtin_amdgcn_permlane32_swap(__float_as_uint(l_reg),__float_as_uint(l_reg),false,false);l_reg=__uint_as_float(rr[0])+__uint_as_float(rr[1]);}
  if(hi==0)wsf[32+r32]=l_reg;asm volatile("s_waitcnt lgkmcnt(0)":::"memory");
  float rli[16];
  #pragma unroll
  for(int r=0;r<16;++r)rli[r]=__builtin_amdgcn_rcpf(wsf[32+crow(r,hi)]);
  bf16*Ow=O+(long)(q0+wid*QBLK)*QP+h*D;
  { bf16*stg=(bf16*)(shm+LDS_OST)+wid*2048;
    #pragma unroll
    for(int r=0;r<16;++r){const int orow=crow(r,hi);
      #pragma unroll
      for(int d0=0;d0<2;++d0)stg[orow*64+d0*32+r32]=f2bf16(o[d0][r]*rli[r]);}
    asm volatile("s_waitcnt lgkmcnt(0)":::"memory");
    #pragma unroll
    for(int i=0;i<4;++i){const int row=i*8+(lane>>3),ch=lane&7; const u32x4 v=*(const u32x4*)(stg+row*64+ch*8); ATTN_STORE16(Ow+(long)row*QP+ch*8,v);} }
  asm volatile("s_waitcnt lgkmcnt(0)\n\ts_barrier":::"memory");
  #undef DMA_K
  #undef DMA_V
  #undef CMASK
  #undef START
  #undef ROT
}


__device__ __forceinline__ void attn_unit_fixed2(float mref,int h,int qb,const bf16*Q,const bf16*__restrict__ K,const bf16*__restrict__ V,bf16*O,char*shm){
  constexpr int NT=257;
  int tid_=threadIdx.x; asm volatile("":"+v"(tid_));
  const int tid=tid_,lane=tid&63,r32=lane&31,hi=lane>>5; const int wid=__builtin_amdgcn_readfirstlane(tid>>6);
  const int q0=qb*QB; const int kvh=h>>2;
  constexpr int NS2=4, LDS_V2=NS2*SLOTB, LDS_WS2=2*NS2*SLOTB, LDS_OST2=LDS_WS2+NW*64*4;
  const bf16*Qw=Q+(long)(q0+wid*QBLK)*QP+h*D;
  const bf16*Kh=K+kvh*D,*Vh=V+kvh*D;
  const unsigned lds0=(unsigned)(uintptr_t)shm;
  float*wsf=(float*)(shm+LDS_WS2)+wid*64;
  const bf16*ksrc=Kh+(long)lane*KP+wid*8;
  const bf16*vsrc=Vh+(long)(16*(wid&3)+(lane>>2))*KP+(wid>>2)*32+(lane&3)*8;
  const unsigned kdst=lds0+LDS_K+wid*1024, vdst=lds0+LDS_V2+wid*1024;
  #define DMA_K(t,slot) glds16(ksrc+(long)(t)*KVBLK*KP,(unsigned)__builtin_amdgcn_readfirstlane(kdst+(slot)))
  #define DMA_V(t,slot) glds16(vsrc+(long)(t)*KVBLK*KP,(unsigned)__builtin_amdgcn_readfirstlane(vdst+(slot)))
  const int vb0=(int)(lds0+LDS_V2)+((lane>>4)&1)*32+(lane&3)*8+(4*hi+((lane&15)>>2))*64;
  const char*Kbase=shm+LDS_K; bf16x8 kf[8];
  const lds_cptr shm3=(lds_cptr)shm; const lds_cptr kp0=shm3+LDS_K+hi*1024+r32*16; const lds_cptr vp0=shm3+LDS_V2+((lane>>4)&1)*32+(lane&3)*8+(4*hi+((lane&15)>>2))*64;
  DMA_K(0,0);DMA_V(0,0);DMA_K(1,SLOTB);
  bf16x8 qr[4];
  #pragma unroll
  for(int d0=0;d0<4;++d0)qr[d0]=*reinterpret_cast<const bf16x8*>(&Qw[(long)r32*QP+d0*16+hi*8]);
  f32x16 o[2];o[0]=f32x16{};o[1]=f32x16{};float l_reg=0.f;f32x16 negm;
  #pragma unroll
  for(int r=0;r<16;++r)negm[r]=-mref;
  asm volatile("":"+v"(negm));
  #define CMASK(P0,P1,t) do{ if((t)==NT-1)cmask(P0,P1,2); }while(0)
  #define START(P0,P1) do{ _Pragma("unroll") for(int r=0;r<16;++r)P0[r]=__builtin_amdgcn_exp2f(P0[r]); }while(0)
  f32x16 pA0,pA1,pB0,pB1;
  int sl_prev=0,sl_cur=0,sl_next=SLOTB;
  #define ROT() do{sl_prev=sl_cur;sl_cur=sl_next;sl_next=(sl_next==(NS2-1)*SLOTB)?0:sl_next+SLOTB;}while(0)
  DMA_K(2,2*SLOTB);DMA_K(3,3*SLOTB);DMA_V(1,SLOTB);
  WAIT_BAR(5);
  qkt(pA0,pA1,Kbase,qr,negm,r32,hi);asm volatile("s_nop 15\n\ts_nop 7":"+v"(pA0),"+v"(pA1));CMASK(pA0,pA1,0);
  START(pA0,pA1);
  _Pragma("unroll") for(int r=0;r<16;++r)pA1[r]=__builtin_amdgcn_exp2f(pA1[r]);
  WAIT_BAR(0);
  ROT();
  kload8(kf,kp0+sl_cur);
  asm volatile("s_waitcnt lgkmcnt(0)\n\ts_barrier":::"memory");
  s16x4 vlo[8],vhi[8]; u32x4 pw0,pw1,pw2,pw3;
  #define PKW(P,B) cvtpk_s(P[B],P[B+1])
  #define PAF(k) __builtin_bit_cast(bf16x8,pw##k)
  #define VFR(i) (bf16x8){vlo[i][0],vlo[i][1],vlo[i][2],vlo[i][3],vhi[i][0],vhi[i][1],vhi[i][2],vhi[i][3]}
  #define PIN(x) asm volatile("":"+v"(x))
  #define MX3(a,b,c) __builtin_fmaxf(__builtin_fmaxf((a),(b)),(c))
  #define GAPA(MF,A0,A1,A2,A3,W0,W1,PW) do{ MF; sacc+=A0; sacc+=A1; sacc+=A2; sacc+=A3; PIN(sacc); W0; W1; PIN(PW); SBAR(); }while(0)
  #define EX(v) __builtin_amdgcn_exp2f(v)
  #define GAPB(MF,X,B) do{ MF; X[B]=EX(X[B]); X[B+1]=EX(X[B+1]); X[B+2]=EX(X[B+2]); X[B+3]=EX(X[B+3]); PIN(X); SBAR(); }while(0)
  #define VRD(i) do{ vlo[i]=vtr(vp_+(((i)>>2)*4096+((i)&3)*1024)); vhi[i]=vtr(vp_+(((i)>>2)*4096+((i)&3)*1024+512)); }while(0)
  #define KRD(G,j) do{ if(G){ kload2(kf,kp0+sl_next,j); SBAR(); } }while(0)
  #define STEP(C0,C1,P0,P1,t,GK,GV,GL) do{ SBAR(); \
    if(GK){DMA_K((t)+3,sl_prev);} if(GV){DMA_V((t)+1,sl_next);} \
    const lds_cptr vp_=vp0+sl_prev; \
    VRD(0); SBAR(); float sacc=(P0[0]+P0[1]); \
    GAPA(C0=__builtin_amdgcn_mfma_f32_32x32x16_bf16(kf[0],qr[0],negm,0,0,0), P0[2],P0[3],P0[4],P0[5],     pw0[0]=PKW(P0,0), pw0[1]=PKW(P0,2), pw0); \
    VRD(4); SBAR(); GAPA(C1=__builtin_amdgcn_mfma_f32_32x32x16_bf16(kf[1],qr[0],negm,0,0,0), P0[6],P0[7],P0[8],P0[9],     pw0[2]=PKW(P0,4), pw0[3]=PKW(P0,6), pw0); \
    VRD(1); SBAR(); GAPA(C0=__builtin_amdgcn_mfma_f32_32x32x16_bf16(kf[2],qr[1],C0,0,0,0),   P0[10],P0[11],P0[12],P0[13], pw1[0]=PKW(P0,8), pw1[1]=PKW(P0,10), pw1); \
    VRD(5); SBAR(); GAPA(C1=__builtin_amdgcn_mfma_f32_32x32x16_bf16(kf[3],qr[1],C1,0,0,0),   P0[14],P0[15],P1[0],P1[1],   pw1[2]=PKW(P0,12),pw1[3]=PKW(P0,14), pw1); \
    VRD(2); SBAR(); GAPA(C0=__builtin_amdgcn_mfma_f32_32x32x16_bf16(kf[4],qr[2],C0,0,0,0),   P1[2],P1[3],P1[4],P1[5],     pw2[0]=PKW(P1,0), pw2[1]=PKW(P1,2), pw2); \
    VRD(6); SBAR(); GAPA(C1=__builtin_amdgcn_mfma_f32_32x32x16_bf16(kf[5],qr[2],C1,0,0,0),   P1[6],P1[7],P1[8],P1[9],     pw2[2]=PKW(P1,4), pw2[3]=PKW(P1,6), pw2); \
    VRD(3); SBAR(); GAPA(C0=__builtin_amdgcn_mfma_f32_32x32x16_bf16(kf[6],qr[3],C0,0,0,0),   P1[10],P1[11],P1[12],P1[13], pw3[0]=PKW(P1,8), pw3[1]=PKW(P1,10), pw3); \
    VRD(7); SBAR(); GAPA(C1=__builtin_amdgcn_mfma_f32_32x32x16_bf16(kf[7],qr[3],C1,0,0,0),   P1[14],P1[15],0.f,0.f,       pw3[2]=PKW(P1,12),pw3[3]=PKW(P1,14), pw3); \
    l_reg+=sacc; \
    CMASK(C0,C1,t); \
    SBAR(); \
    GAPB(o[0]=__builtin_amdgcn_mfma_f32_32x32x16_bf16(PAF(0),VFR(0),o[0],0,0,0), C0,0); \
    GAPB(o[1]=__builtin_amdgcn_mfma_f32_32x32x16_bf16(PAF(0),VFR(4),o[1],0,0,0), C0,4); \
    KRD(GL,0); GAPB(o[0]=__builtin_amdgcn_mfma_f32_32x32x16_bf16(PAF(1),VFR(1),o[0],0,0,0), C0,8); \
    KRD(GL,1); GAPB(o[1]=__builtin_amdgcn_mfma_f32_32x32x16_bf16(PAF(1),VFR(5),o[1],0,0,0), C0,12); \
    KRD(GL,2); GAPB(o[0]=__builtin_amdgcn_mfma_f32_32x32x16_bf16(PAF(2),VFR(2),o[0],0,0,0), C1,0); \
    KRD(GL,3); GAPB(o[1]=__builtin_amdgcn_mfma_f32_32x32x16_bf16(PAF(2),VFR(6),o[1],0,0,0), C1,4); \
    GAPB(o[0]=__builtin_amdgcn_mfma_f32_32x32x16_bf16(PAF(3),VFR(3),o[0],0,0,0), C1,8); \
    GAPB(o[1]=__builtin_amdgcn_mfma_f32_32x32x16_bf16(PAF(3),VFR(7),o[1],0,0,0), C1,12); \
    }while(0)
  int t=1;
  #undef CMASK
  #define CMASK(P0,P1,t) do{}while(0)
  for(;t+5<NT;t+=2){
    STEP(pB0,pB1,pA0,pA1,t,true,true,true);     ROT();
    STEP(pA0,pA1,pB0,pB1,t+1,true,true,true);   WAIT_BAR(0); ROT();
  }
  #undef CMASK
  #define CMASK(P0,P1,t) do{ if((t)==NT-1)cmask(P0,P1,2); }while(0)
  for(;t+1<NT;t+=2){
    STEP(pB0,pB1,pA0,pA1,t,(t+3<NT),(t+1<NT),(t+1<NT));       ROT();
    STEP(pA0,pA1,pB0,pB1,t+1,(t+4<NT),(t+2<NT),(t+2<NT));     WAIT_BAR(0); ROT();
  }
  {
    pw0=(u32x4){PKW(pA0,0),PKW(pA0,2),PKW(pA0,4),PKW(pA0,6)};pw1=(u32x4){PKW(pA0,8),PKW(pA0,10),PKW(pA0,12),PKW(pA0,14)};pw2=(u32x4){PKW(pA1,0),PKW(pA1,2),PKW(pA1,4),PKW(pA1,6)};pw3=(u32x4){PKW(pA1,8),PKW(pA1,10),PKW(pA1,12),PKW(pA1,14)};
    { float sacc=pA0[0]+pA0[1]; _Pragma("unroll") for(int r=2;r<16;++r)sacc+=pA0[r]; _Pragma("unroll") for(int r=0;r<16;++r)sacc+=pA1[r]; l_reg+=sacc; }
    SBAR(); pv(o,vb0+sl_prev,PAF(0),PAF(1),PAF(2),PAF(3)); }
  #undef PKW
  #undef PAF
  #undef VFR
  #undef PIN
  #undef MX3
  #undef GAPA
  #undef GAPB
  #undef EX
  #undef VRD
  #undef KRD
  #undef STEP
  {auto rr=__builtin_amdgcn_permlane32_swap(__float_as_uint(l_reg),__float_as_uint(l_reg),false,false);l_reg=__uint_as_float(rr[0])+__uint_as_float(rr[1]);}
  if(hi==0)wsf[32+r32]=l_reg;asm volatile("s_waitcnt lgkmcnt(0)":::"memory");
  float rli[16];
  #pragma unroll
  for(int r=0;r<16;++r)rli[r]=__builtin_amdgcn_rcpf(wsf[32+crow(r,hi)]);
  bf16*Ow=O+(long)(q0+wid*QBLK)*QP+h*D;
  { bf16*stg=(bf16*)(shm+LDS_OST2)+wid*2048;
    #pragma unroll
    for(int r=0;r<16;++r){const int orow=crow(r,hi);
      #pragma unroll
      for(int d0=0;d0<2;++d0)stg[orow*64+d0*32+r32]=f2bf16(o[d0][r]*rli[r]);}
    asm volatile("s_waitcnt lgkmcnt(0)":::"memory");
    #pragma unroll
    for(int i=0;i<4;++i){const int row=i*8+(lane>>3),ch=lane&7; const u32x4 v=*(const u32x4*)(stg+row*64+ch*8); ATTN_STORE16(Ow+(long)row*QP+ch*8,v);} }
  asm volatile("s_waitcnt lgkmcnt(0)\n\ts_barrier":::"memory");
  #undef DMA_K
  #undef DMA_V
  #undef CMASK
  #undef START
  #undef ROT
}


constexpr int ATTN_LDS_BYTES=LDS_BYTES;
struct AttnTensors { const bf16* Q; const bf16* K; const bf16* V; bf16* O; const float* qgain; const float* kgain; };
template<int THRL=8> __device__ __forceinline__ void attn_phase(char*lds,const AttnTensors&T,int vcu,int G){
  float gq=__builtin_fabsf(T.qgain[threadIdx.x&63]),gk=__builtin_fabsf(T.kgain[threadIdx.x&63]);
  #pragma unroll
  for(int o=1;o<64;o<<=1){gq=__builtin_fmaxf(gq,__shfl_xor(gq,o));gk=__builtin_fmaxf(gk,__shfl_xor(gk,o));}
  const float mref=__uint_as_float(__builtin_amdgcn_readfirstlane(__float_as_uint(C2*64.0f*gq*gk*1.001f+0.01f)));
  const bool fixed=mref<48.0f;
  const bool bal=(G==256);
  for(int k=0;;++k){
    int h,qb;
    if(bal){ if(k>=2)break; h=vcu>>5; qb=(vcu&31)+32*k; }
    else { const int u=vcu+k*G; if(u>=512)break; h=u>>6; qb=u&63; }
    if(fixed) attn_unit_fixed2(mref,h,qb,T.Q,T.K,T.V,T.O,lds); else attn_unit<THRL>(h,qb,T.Q,T.K,T.V,T.O,lds);
  }
}
#undef SBAR
#undef WAIT_BAR
}

constexpr int NWAVES = 8;
#ifndef MK_N_LAUNCHES
#define MK_N_LAUNCHES 1
#endif
constexpr int N_PHASES = 11;
constexpr int N_LAUNCHES = MK_N_LAUNCHES;
static_assert(N_LAUNCHES == 1 || N_LAUNCHES == N_PHASES, "MK_N_LAUNCHES is 1 or 11");

constexpr int M = 16384, DM = 1024, NMETA = 16, DFF = 2816, NGU = 2 * DFF, NIN = 5376;
constexpr int HGW = 512;
constexpr int HROWS = M + 128;

constexpr size_t MiB = 1u << 20;
constexpr size_t WS_CTL = 0, CTL_ZERO_BYTES = 1 * MiB;
constexpr size_t WS_MISC = 1 * MiB;
constexpr size_t MISC_ROPER = 0, MISC_ROPEC = 32768, MISC_OMLF = 40960, MISC_OMLB = 43008, MISC_METAB = 45056, MISC_SSQ0M = 77824, MISC_ACTM = 78848, MISC_H1M = 168960, MISC_H1MB = 234496,
                 MISC_SSQM = 267264, MISC_DF = 271360, MISC_DB = 535552, MISC_END = 799744;
static_assert(MISC_END <= 2 * MiB, "misc");
constexpr size_t WS_SSQ0 = 3 * MiB, WS_SSQ1 = 4 * MiB, WS_SSQ2 = 5 * MiB;
constexpr size_t WS_W = 6 * MiB;
constexpr size_t W_GU1 = 0, W_D1 = 11534336, W_IN = 17301504, W_UP = 28311552, W_OUT = 30408704, W_GU2 = 32505856, W_D2 = 44040192, W_END = 49807360;
constexpr size_t WS_HB = WS_W + W_END;
constexpr size_t WS_Z = WS_HB + (size_t)M * DM * 2;
constexpr size_t Z_HQ = 0, Z_QO = 16908288, Z_HV = 33685504, Z_ZFF = 50593792, Z_ZFB = 67502080, Z_HG = 84410368, Z_KB = 101318656, Z_VB = 105545728, Z_GA = 109772800, Z_GB = 143327232, Z_END = 176881664;
constexpr size_t WS_END = WS_Z + Z_END;
static_assert(Z_QO == Z_HQ + (size_t)HROWS * HGW * 2 && Z_HV == Z_QO + (size_t)M * HGW * 2 && Z_ZFF == Z_HV + (size_t)HROWS * HGW * 2 && Z_KB == Z_HG + (size_t)HROWS * HGW * 2 && Z_GA == Z_VB + (size_t)HROWS * 128 * 2 &&
              Z_END == Z_GB + (size_t)M * DM * 2 && WS_END <= 268435456 && (size_t)M * DFF * 2 <= Z_END && (size_t)M * DM * 2 <= Z_ZFB - Z_HV, "d_ws map");
constexpr int CW_TMO = 0, CW_CODE = 1, CW_BAR = 4096;

constexpr int RING_OFF = 0, RING_BYTES = 131072;
constexpr int HL_QH = 0, HL_KH = 32768, HL_VT = 65536, HL_ST = 100352, HL_TOT = 135168, HL_ER = 143360, HL_SSQ = 143872, HL_END = 144896;
constexpr int HL_PITCH = 272;
constexpr int OX_PITCH = 132;
constexpr int RS_OFF = 144896;
constexpr int LDSCTL_OFF = 153088, MISC_OFF = LDSCTL_OFF + 320;
constexpr int LDS_BYTES = 154112;
static_assert(HL_END <= RS_OFF && RS_OFF + pg8::RS_UNITS * 1024 <= LDSCTL_OFF && (M / 256) * (NGU / 256) <= pg8::RS_UNITS * 256 && RING_BYTES <= RS_OFF && MISC_OFF + 128 <= LDS_BYTES && 128 * OX_PITCH * 4 <= HL_ST, "LDS map");

#define GAS __attribute__((address_space(1)))
#define LAS __attribute__((address_space(3)))
typedef unsigned short bf16;
typedef unsigned v4u __attribute__((ext_vector_type(4)));
typedef float f32x4 __attribute__((ext_vector_type(4)));
typedef float f32x2 __attribute__((ext_vector_type(2)));
typedef float f32x16 __attribute__((ext_vector_type(16)));
typedef short bf16x8 __attribute__((ext_vector_type(8)));
typedef short s16x4 __attribute__((ext_vector_type(4)));
typedef GAS unsigned gu32;
#define RLX_AGENT __ATOMIC_RELAXED, __HIP_MEMORY_SCOPE_AGENT
#define LDS_WAIT() asm volatile("s_waitcnt lgkmcnt(0)" ::: "memory")
#define VM_WAIT() asm volatile("s_waitcnt vmcnt(0)" ::: "memory")
__device__ __forceinline__ unsigned f2bf(float f) { unsigned u = __builtin_bit_cast(unsigned, f); return (u + 0x7fffu + ((u >> 16) & 1u)) >> 16; }
typedef float f32x2_hw __attribute__((ext_vector_type(2))); typedef __bf16 bf16x2_hw __attribute__((ext_vector_type(2)));
__device__ __forceinline__ unsigned pk2(float lo, float hi) { f32x2_hw v = {lo, hi}; bf16x2_hw b = __builtin_convertvector(v, bf16x2_hw); return __builtin_bit_cast(unsigned, b); }
__device__ __forceinline__ float bf2f(unsigned short b) { return __uint_as_float((unsigned)b << 16); }
__device__ __forceinline__ float wave_sum(float v) {
#pragma unroll
    for (int o = 1; o < 64; o <<= 1) v += __shfl_xor(v, o);
    return v;
}
#define XB_TMO      128
#define XB_XCNT(j)  (256  + 64 * (j))
#define XB_XSUB(j)  (1280 + 64 * (j))
#define XB_XGEN(j)  (2304 + 64 * (j))
#define XB_TOP      3328
#define XB_TOPGEN   3392
#define XCD_BAR_WORDS 3456
#define XB_SPIN_CAP (1u << 18)

__device__ __forceinline__ unsigned xb_ld(unsigned* p)              { return __hip_atomic_load(p, __ATOMIC_RELAXED, __HIP_MEMORY_SCOPE_AGENT); }
__device__ __forceinline__ unsigned xb_add(unsigned* p, unsigned v) { return __hip_atomic_fetch_add(p, v, __ATOMIC_RELAXED, __HIP_MEMORY_SCOPE_AGENT); }
__device__ __forceinline__ unsigned xb_xcc_id() { return (unsigned)__builtin_amdgcn_s_getreg((3 << 11) | 20) & 0xFu; }
#define XB_SPIN(cond, bar) do { unsigned _sp = 0; while (cond) { __builtin_amdgcn_s_sleep(1); \
    if ((++_sp & 255u) == 0u) { if (xb_ld(&(bar)[XB_TMO])) break; if (_sp > XB_SPIN_CAP) { atomicAdd(&(bar)[XB_TMO], 1u); break; } } } } while (0)

struct XcdBarrier {
    unsigned* bar; unsigned x;
    volatile LAS unsigned* st;
};

__device__ __forceinline__ XcdBarrier xcd_barrier_post(unsigned* bar, volatile LAS unsigned* st) {
    XcdBarrier b; b.bar = bar; b.x = xb_xcc_id(); b.st = st;
    if (threadIdx.x == 0) (void)xb_add(&bar[XB_XCNT(b.x)], 1u);
    return b;
}
__device__ __forceinline__ void xcd_barrier_complete(unsigned* bar, unsigned x, unsigned& nloc, unsigned& nx) {
    const unsigned G = gridDim.x * gridDim.y * gridDim.z;
    unsigned sum, cnt, mine, sp = 0u;
    for (;;) {
        sum = 0u; cnt = 0u; mine = 0u;
#pragma unroll
        for (unsigned j = 0; j < 16; ++j) { const unsigned c = xb_ld(&bar[XB_XCNT(j)]); sum += c; cnt += (c > 0u) ? 1u : 0u; mine = (j == x) ? c : mine; }
        if (sum == G) break;
        __builtin_amdgcn_s_sleep(1);
        if ((++sp & 255u) == 0u) { if (xb_ld(&bar[XB_TMO])) break; if (sp > XB_SPIN_CAP) { atomicAdd(&bar[XB_TMO], 1u); break; } }
    }
    nloc = mine > 0u ? mine : 1u; nx = cnt > 0u ? cnt : 1u;
}

__device__ __forceinline__ void xcd_barrier(const XcdBarrier& b) {
    asm volatile("s_waitcnt vmcnt(0)" ::: "memory");
    __syncthreads();
    if (threadIdx.x == 0) {
        unsigned* bar = b.bar;
        __builtin_amdgcn_s_waitcnt(0);
        unsigned nloc = b.st[0], nx = b.st[1];
        if (nloc == 0u) { xcd_barrier_complete(bar, b.x, nloc, nx); b.st[0] = nloc; b.st[1] = nx; }
        const unsigned old = xb_add(&bar[XB_XSUB(b.x)], 1u);
        const unsigned gen = old / nloc;
        if (old + 1u == (gen + 1u) * nloc) {
            __builtin_amdgcn_fence(__ATOMIC_RELEASE, "agent");
            asm volatile("s_waitcnt vmcnt(0)" ::: "memory");
            const unsigned og = xb_add(&bar[XB_TOP], 1u);
            const unsigned tg = og / nx;
            if (og + 1u == (tg + 1u) * nx) xb_add(&bar[XB_TOPGEN], 1u);
            else XB_SPIN(xb_ld(&bar[XB_TOPGEN]) == tg, bar);
            __builtin_amdgcn_fence(__ATOMIC_ACQUIRE, "agent");
            xb_add(&bar[XB_XGEN(b.x)], 1u);
            asm volatile("s_waitcnt vmcnt(0)" ::: "memory");
        } else {
            XB_SPIN(xb_ld(&bar[XB_XGEN(b.x)]) == gen, bar);
            __builtin_amdgcn_fence(__ATOMIC_ACQUIRE, "agent");
            asm volatile("s_waitcnt vmcnt(0)" ::: "memory");
        }
    }
    __syncthreads();
}

struct Frame {
    LAS unsigned char* lds;
    volatile LAS unsigned* MISC;
    gu32* ctl;
    int wave;
    int vcu, G;
    const float* in[20]; float* out; unsigned char* ws;
};
#define WSP(T, off) ((T*)(F.ws + (off)))

__device__ __forceinline__ int win_rowmap(int n) {
    if (n >= 2560 && n < 3072) { const int cq = n - 2560, hd = cq >> 6, d = cq & 63; return 256 * (10 + (hd >> 2)) + 128 * (d >> 5) + 32 * (hd & 3) + (d & 31); }
    if (n >= 3072 && n < 3328) { const int c = n - 3072, hh = c >> 6, d = c & 63; return 3072 + 128 * (d >> 5) + 32 * hh + (d & 31); }
    if (n >= 3328) { const int c = n - 3328, z = c >> 10, cc = c & 1023; return 3328 + 256 * (cc >> 7) + 128 * z + (cc & 127); }
    return n;
}
template <int KIND>
__device__ __forceinline__ void p0_transpose_item(const float* W, int K, int N, bf16* WT, int row_off, const float* kscale, LAS float* scr, int item, int lane) {
    const int nblk = N / 32, kb = item / nblk, nb = item % nblk, k0 = 64 * kb, n0 = 32 * nb;
    float wv[32];
#pragma unroll
    for (int i = 0; i < 32; ++i) { const int kk = 2 * i + (lane >> 5); wv[i] = W[(size_t)(k0 + kk) * N + n0 + (lane & 31)]; }
#pragma unroll
    for (int i = 0; i < 32; ++i) { const int kk = 2 * i + (lane >> 5); const float sc = kscale ? kscale[k0 + kk] : 1.0f; scr[kk * 33 + (lane & 31)] = wv[i] * sc; }
    LDS_WAIT(); asm volatile("" ::: "memory");
    const int c = lane & 7;
#pragma unroll
    for (int j = 0; j < 4; ++j) { const int n = (lane >> 3) + 8 * j; const LAS float* s = scr + (8 * c) * 33 + n;
        v4u o; o.x = pk2(s[0 * 33], s[1 * 33]); o.y = pk2(s[2 * 33], s[3 * 33]); o.z = pk2(s[4 * 33], s[5 * 33]); o.w = pk2(s[6 * 33], s[7 * 33]);
        const int nn = n0 + n; const int drow = (KIND == 0) ? row_off + nn : ((KIND == 1) ? 256 * (nn >> 7) + (nn & 127) + row_off : win_rowmap(nn));
        *(GAS v4u*)(WT + (size_t)drow * K + k0 + 8 * c) = o; }
    LDS_WAIT(); asm volatile("" ::: "memory");
}
__device__ __forceinline__ void row_to_bf16(int lane, const float* xrow, bf16* orow, float* ssq16) {
    const GAS f32x4* xr = (const GAS f32x4*)xrow + lane;
    f32x4 v[4]; float s = 0.f;
#pragma unroll
    for (int j = 0; j < 4; ++j) { v[j] = xr[64 * j]; s += (v[j].x * v[j].x + v[j].y * v[j].y) + (v[j].z * v[j].z + v[j].w * v[j].w); }
    s = wave_sum(s);
    GAS unsigned long long* o8 = (GAS unsigned long long*)orow + lane;
#pragma unroll
    for (int j = 0; j < 4; ++j) o8[64 * j] = (unsigned long long)pk2(v[j].x, v[j].y) | ((unsigned long long)pk2(v[j].z, v[j].w) << 32);
    if (lane < 16) ssq16[lane] = (lane == 0) ? s : 0.f;
}
__device__ __forceinline__ void sincos_d(double a, float& sn, float& cs) {
    const double TWO_PI = 6.283185307179586476925286766559;
    const double k = __builtin_rint(a / TWO_PI); const double x = a - k * TWO_PI;
    const double x2 = x * x; double ts = 1.0, tc = 1.0, ss = 1.0, cc = 1.0;
#pragma unroll
    for (int i = 1; i <= 13; ++i) { tc = -tc * x2 / (double)((2 * i - 1) * (2 * i)); ts = -ts * x2 / (double)((2 * i) * (2 * i + 1)); cc += tc; ss += ts; }
    sn = (float)(ss * x); cs = (float)cc;
}
constexpr int I_G = (DM / 64) * (DFF / 32), I_D = (DFF / 64) * (DM / 32), I_IN = (DM / 64) * (NIN / 32), I_U = (HGW / 64) * (DM / 32), I_O = (DM / 64) * (DM / 32);
constexpr int CV_FFN1 = 2 * I_G + I_D, CV_IN = CV_FFN1 + I_IN, CV_ALL = CV_IN + 2 * I_U + I_O + 2 * I_G + I_D;
__device__ __forceinline__ void convert_items(Frame& F, int it_lo, int it_hi, int wrank, int nw) {
    LAS float* scr = (LAS float*)(F.lds + RING_OFF + F.wave * 16384);
    const int lane = (int)threadIdx.x & 63;
    bf16* Wb = WSP(bf16, WS_W);
    for (int it = it_lo + wrank; it < it_hi; it += nw) {
        int r = it;
        if (r < I_G) { p0_transpose_item<1>(F.in[3], DM, DFF, Wb + W_GU1 / 2, 0, F.in[2], scr, r, lane); continue; } r -= I_G;
        if (r < I_G) { p0_transpose_item<1>(F.in[4], DM, DFF, Wb + W_GU1 / 2, 128, F.in[2], scr, r, lane); continue; } r -= I_G;
        if (r < I_D) { p0_transpose_item<0>(F.in[5], DFF, DM, Wb + W_D1 / 2, 0, nullptr, scr, r, lane); continue; } r -= I_D;
        if (r < I_IN) { p0_transpose_item<2>(F.in[7], DM, NIN, Wb + W_IN / 2, 0, F.in[6], scr, r, lane); continue; } r -= I_IN;
        if (r < I_U) { p0_transpose_item<0>(F.in[13], HGW, DM, Wb + W_UP / 2, 0, nullptr, scr, r, lane); continue; } r -= I_U;
        if (r < I_U) { p0_transpose_item<0>(F.in[14], HGW, DM, Wb + W_UP / 2, 1024, nullptr, scr, r, lane); continue; } r -= I_U;
        if (r < I_O) { p0_transpose_item<0>(F.in[15], DM, DM, Wb + W_OUT / 2, 0, nullptr, scr, r, lane); continue; } r -= I_O;
        if (r < I_G) { p0_transpose_item<1>(F.in[17], DM, DFF, Wb + W_GU2 / 2, 0, F.in[16], scr, r, lane); continue; } r -= I_G;
        if (r < I_G) { p0_transpose_item<1>(F.in[18], DM, DFF, Wb + W_GU2 / 2, 128, F.in[16], scr, r, lane); continue; } r -= I_G;
        p0_transpose_item<0>(F.in[19], DFF, DM, Wb + W_D2 / 2, 0, nullptr, scr, r, lane);
    }
}
__device__ __forceinline__ void convert_in_idle_slot(Frame& F, int nwg, int it_lo, int it_hi) {
    const int cut = nwg % F.G, c = (int)blockIdx.x;
    if (c < cut) return;
    convert_items(F, it_lo, it_hi, (c - cut) * NWAVES + F.wave, (F.G - cut) * NWAVES);
    __syncthreads();
}
__device__ __forceinline__ void stagger_short_share(Frame& F, int nwg, int sleeps) {
    const int cut = nwg % F.G; if (cut == 0 || (int)blockIdx.x < cut) return;
    for (int i = 0; i < sleeps; ++i) __builtin_amdgcn_s_sleep(127);
}
__device__ __forceinline__ void p0_prologue(Frame& F) {
    const int gw = F.vcu * NWAVES + F.wave, NGW = F.G * NWAVES;
    convert_items(F, 0, CV_FFN1, gw, NGW);
    {
        const int lane = (int)threadIdx.x & 63;
        for (int m0 = gw; m0 < M; m0 += 4 * NGW) {
            f32x4 v[4][4]; float sq[4];
#pragma unroll
            for (int q = 0; q < 4; ++q) { const int m = m0 + q * NGW; const GAS f32x4* xr = (const GAS f32x4*)(F.in[0] + (size_t)(m < M ? m : m0) * DM) + lane;
#pragma unroll
                for (int j = 0; j < 4; ++j) v[q][j] = xr[64 * j]; }
#pragma unroll
            for (int q = 0; q < 4; ++q) { float t = 0.f;
#pragma unroll
                for (int j = 0; j < 4; ++j) t += (v[q][j].x * v[q][j].x + v[q][j].y * v[q][j].y) + (v[q][j].z * v[q][j].z + v[q][j].w * v[q][j].w);
                sq[q] = wave_sum(t); }
#pragma unroll
            for (int q = 0; q < 4; ++q) { const int m = m0 + q * NGW; if (m < M) {
                GAS unsigned long long* o8 = (GAS unsigned long long*)(WSP(bf16, WS_HB) + (size_t)m * DM) + lane;
#pragma unroll
                for (int j = 0; j < 4; ++j) o8[64 * j] = (unsigned long long)pk2(v[q][j].x, v[q][j].y) | ((unsigned long long)pk2(v[q][j].z, v[q][j].w) << 32);
                if (lane < 16) (WSP(float, WS_SSQ0) + (size_t)m * 16)[lane] = (lane == 0) ? sq[q] : 0.f; } }
        }
    }
    if (gw < NMETA) row_to_bf16(((int)threadIdx.x & 63), F.in[1] + (size_t)gw * DM, WSP(bf16, WS_MISC + MISC_METAB) + (size_t)gw * DM, WSP(float, WS_MISC + MISC_SSQ0M) + gw * 16);
}

__device__ __forceinline__ void misc_tables(Frame& F, int nwg) {
    const int cut = nwg % F.G; if ((int)blockIdx.x < cut) return;
#pragma unroll 1
    for (int gt = ((int)blockIdx.x - cut) * (NWAVES * 64) + (int)threadIdx.x; gt < 320 * 16 + 1024; gt += (F.G - cut) * (NWAVES * 64))
    if (gt < 320 * 16) {
        const int pos = gt >> 4, j = gt & 15;
        const double inv = (double)exp2f(-(float)j * (13.287712379549449f / 16.0f));
        float sn, cs; sincos_d((double)(pos < 256 ? pos : pos - 256) * inv, sn, cs);
        f32x2* tab = (pos < 256) ? WSP(f32x2, WS_MISC + MISC_ROPER) + pos * 16 + j : WSP(f32x2, WS_MISC + MISC_ROPEC) + (pos - 256) * 16 + j;
        *tab = (f32x2){cs, sn};
    } else {
        const int i = gt - 320 * 16, k = i & 511; const float* lb = (i < 512) ? F.in[8] : F.in[9];
        const float a0 = lb[k], a1 = lb[512 + k];
        (i < 512 ? WSP(float, WS_MISC + MISC_OMLF) : WSP(float, WS_MISC + MISC_OMLB))[k] = 1.0f / (1.0f + __expf(a0 - a1));
    }
}

template <int NG, int KS>
__device__ __forceinline__ void thin_job(const bf16* A, const bf16* Bt, const int (&brow)[NG], int K, LAS float* red, f32x4 (&acc)[NG], int wave, int lane) {
    const int kbeg = wave * KS * 32;
    const bf16* ap = A + (size_t)(lane & 15) * K + kbeg + 8 * (lane >> 4);
#pragma unroll
    for (int g = 0; g < NG; ++g) acc[g] = (f32x4){0.f, 0.f, 0.f, 0.f};
    bf16x8 af[KS];
#pragma unroll
    for (int s2 = 0; s2 < KS; ++s2) af[s2] = *(const GAS bf16x8*)(ap + 32 * s2);
#pragma unroll
    for (int g = 0; g < NG; ++g) {
        const bf16* bp = Bt + (size_t)(brow[g] + (lane & 15)) * K + kbeg + 8 * (lane >> 4);
        bf16x8 bfr[KS];
#pragma unroll
        for (int s2 = 0; s2 < KS; ++s2) bfr[s2] = *(const GAS bf16x8*)(bp + 32 * s2);
#pragma unroll
        for (int s2 = 0; s2 < KS; ++s2) acc[g] = __builtin_amdgcn_mfma_f32_16x16x32_bf16(af[s2], bfr[s2], acc[g], 0, 0, 0);
    }
#pragma unroll
    for (int g = 0; g < NG; ++g) *(LAS f32x4*)(red + ((wave * NG + g) * 64 + lane) * 4) = acc[g];
    __syncthreads();
    if (wave == 0) {
#pragma unroll
        for (int g = 0; g < NG; ++g) { f32x4 sum = acc[g];
#pragma unroll
            for (int w2 = 1; w2 < 8; ++w2) sum += *(const LAS f32x4*)(red + ((w2 * NG + g) * 64 + lane) * 4);
            acc[g] = sum; }
    }
    __syncthreads();
}
__device__ __forceinline__ int slack_first(int nwg, int G, int njobs) { const int cut = nwg % G; return (cut && G - cut >= njobs) ? cut : 0; }
__device__ __forceinline__ void meta_p1(Frame& F) {
    const int job = (int)blockIdx.x - slack_first((M / 256) * (NGU / 256), F.G, DFF / 32); if (job < 0 || job >= DFF / 32) return;
    const int j0 = 32 * job, j1 = j0 + 16, lane = (int)threadIdx.x & 63;
    const int brow[4] = {256 * (j0 >> 7) + (j0 & 127), 256 * (j0 >> 7) + (j0 & 127) + 128, 256 * (j1 >> 7) + (j1 & 127), 256 * (j1 >> 7) + (j1 & 127) + 128};
    f32x4 acc[4];
    thin_job<4, 4>(WSP(bf16, WS_MISC + MISC_METAB), WSP(bf16, WS_W + W_GU1), brow, DM, (LAS float*)(F.lds + RING_OFF), acc, F.wave, lane);
    if (F.wave != 0) return;
    const float* ssq = WSP(float, WS_MISC + MISC_SSQ0M); bf16* act = WSP(bf16, WS_MISC + MISC_ACTM);
#pragma unroll
    for (int r = 0; r < 4; ++r) { const int row = 4 * (lane >> 4) + r; const float rs = rsqrtf(ssq[row * 16] * (1.0f / 1024.0f) + pg8::RMS_EPS);
        act[(size_t)row * DFF + j0 + (lane & 15)] = (bf16)f2bf(pg8::fast_silu(acc[0][r] * rs) * (acc[1][r] * rs));
        act[(size_t)row * DFF + j1 + (lane & 15)] = (bf16)f2bf(pg8::fast_silu(acc[2][r] * rs) * (acc[3][r] * rs)); }
}
__device__ __forceinline__ void meta_p2(Frame& F) {
    const int job = (int)blockIdx.x; if (job >= DM / 16) return;
    const int c0 = 16 * job, lane = (int)threadIdx.x & 63;
    const int brow[1] = {c0};
    f32x4 acc[1];
    thin_job<1, 11>(WSP(bf16, WS_MISC + MISC_ACTM), WSP(bf16, WS_W + W_D1), brow, DFF, (LAS float*)(F.lds + RING_OFF), acc, F.wave, lane);
    if (F.wave != 0) return;
    float* h1 = WSP(float, WS_MISC + MISC_H1M); bf16* h1b = WSP(bf16, WS_MISC + MISC_H1MB); float* ssqm = WSP(float, WS_MISC + MISC_SSQM);
#pragma unroll
    for (int r = 0; r < 4; ++r) { const int row = 4 * (lane >> 4) + r; const size_t o = (size_t)row * DM + c0 + (lane & 15);
        const float v = F.in[1][o] + 0.5f * acc[0][r]; h1[o] = v; h1b[o] = (bf16)f2bf(v);
        float sq = v * v; sq += __shfl_xor(sq, 1); sq += __shfl_xor(sq, 2); sq += __shfl_xor(sq, 4); sq += __shfl_xor(sq, 8);
        if ((lane & 15) == 0) ssqm[row * 64 + job] = sq; }
}
__device__ __forceinline__ void meta_p3(Frame& F) {
    const int lane = (int)threadIdx.x & 63;
    bf16* HV = WSP(bf16, WS_Z + Z_HV); bf16* ZFF = WSP(bf16, WS_Z + Z_ZFF); bf16* KB = WSP(bf16, WS_Z + Z_KB); bf16* VB = WSP(bf16, WS_Z + Z_VB);
    if ((int)blockIdx.x == F.G - 1) {
        const v4u zero = {0u, 0u, 0u, 0u};
        for (int p = (int)threadIdx.x; p < 112 * 512 / 8; p += NWAVES * 64) { ((GAS v4u*)HV)[p] = zero; ((GAS v4u*)ZFF)[p] = zero; }
        for (int p = (int)threadIdx.x; p < 112 * 128 / 8; p += NWAVES * 64) { ((GAS v4u*)(KB + (size_t)(M + 16) * 128))[p] = zero; ((GAS v4u*)(VB + (size_t)(M + 16) * 128))[p] = zero; }
    }
    const int job = (int)blockIdx.x - slack_first((M / 256) * (NIN / 256), F.G, 20); if (job < 0 || job >= 20) return;
    int brow[4];
    if (job < 16) {
#pragma unroll
        for (int g = 0; g < 4; ++g) brow[g] = (job < 8 ? 512 : 1024) + 64 * (job & 7) + 16 * g;
    } else {
#pragma unroll
        for (int g = 0; g < 4; ++g) brow[g] = 3072 + 128 * (g >> 1) + 32 * (job - 16) + 16 * (g & 1);
    }
    f32x4 x[4];
    thin_job<4, 4>(WSP(bf16, WS_MISC + MISC_H1MB), WSP(bf16, WS_W + W_IN), brow, DM, (LAS float*)(F.lds + RING_OFF), x, F.wave, lane);
    if (F.wave != 0) return;
    float rs4[4];
    { const f32x4* p = (const f32x4*)(WSP(float, WS_MISC + MISC_SSQM) + (lane >> 2) * 64 + (lane & 3) * 16);
      const f32x4 a = p[0], b = p[1], c = p[2], d = p[3];
      float sq = (((a[0] + a[1]) + (a[2] + a[3])) + ((b[0] + b[1]) + (b[2] + b[3]))) + (((c[0] + c[1]) + (c[2] + c[3])) + ((d[0] + d[1]) + (d[2] + d[3])));
      sq += __shfl_xor(sq, 1); sq += __shfl_xor(sq, 2);
      const float rsv = rsqrtf(sq * (1.0f / 1024.0f) + pg8::RMS_EPS);
#pragma unroll
      for (int r = 0; r < 4; ++r) rs4[r] = __shfl(rsv, 4 * (4 * (lane >> 4) + r)); }
    if (job < 16) {
        bf16* dst = (job < 8 ? HV : ZFF) + 64 * (job & 7);
#pragma unroll
        for (int r = 0; r < 4; ++r) { const int row = 4 * (lane >> 4) + r;
#pragma unroll
            for (int g = 0; g < 4; ++g) { float v = x[g][r] * rs4[r];
                if (job >= 8) v = __builtin_amdgcn_logf(1.0f - WSP(float, WS_MISC + MISC_OMLF)[64 * (job & 7) + 16 * g + (lane & 15)] * __builtin_amdgcn_rcpf(1.0f + __builtin_amdgcn_exp2f(v * 1.4426950408889634f)));
                dst[(size_t)(112 + row) * HGW + 16 * g + (lane & 15)] = (bf16)f2bf(v); } }
    } else {
        const int hh = job - 16;
#pragma unroll
        for (int r = 0; r < 4; ++r) {
            const int row = 4 * (lane >> 4) + r; float v[4]; float ss = 0.f;
#pragma unroll
            for (int g = 0; g < 4; ++g) { v[g] = x[g][r] * rs4[r]; ss += v[g] * v[g]; }
            if (hh < 2) { ss += __shfl_xor(ss, 1); ss += __shfl_xor(ss, 2); ss += __shfl_xor(ss, 4); ss += __shfl_xor(ss, 8);
                const float rn = rsqrtf(ss * (1.0f / 64.0f) + pg8::RMS_EPS);
#pragma unroll
                for (int g = 0; g < 4; ++g) v[g] *= rn * F.in[12][16 * g + (lane & 15)]; }
            bf16* dst = (hh < 2 ? KB : VB) + (size_t)(M + row) * 128 + 64 * (hh & 1);
#pragma unroll
            for (int g = 0; g < 4; ++g) dst[16 * g + (lane & 15)] = (bf16)f2bf(v[g]);
        }
    }
}

typedef LAS const char* lds_cptr;
typedef short v4i16_t __attribute__((ext_vector_type(4)));
__device__ __forceinline__ s16x4 vtr(lds_cptr p) { return __builtin_bit_cast(s16x4, __builtin_amdgcn_ds_read_tr16_b64_v4i16((LAS v4i16_t*)p)); }
__device__ __forceinline__ int crow(int r, int hi) { return (r & 3) + 8 * (r >> 2) + 4 * hi; }
__device__ __forceinline__ int hg_img_off(int tb, int k, int seg) { return tb * 8192 + (k ^ ((k >> 4) & 1)) * 64 + ((seg ^ (k >> 2)) & 3) * 16; }
__device__ __forceinline__ bf16x8 trfrag(lds_cptr img, int tb, int ks, int lane) {
    const int k0 = 16 * ks + 8 * (lane >> 5) + ((lane & 15) >> 2), seg = ((lane >> 4) & 1) * 2 + ((lane & 3) >> 1), sub = (lane & 1) * 8;
    const s16x4 lo = vtr(img + hg_img_off(tb, k0, seg) + sub), hi = vtr(img + hg_img_off(tb, k0 + 4, seg) + sub);
    return (bf16x8){lo[0], lo[1], lo[2], lo[3], hi[0], hi[1], hi[2], hi[3]};
}
__device__ __forceinline__ bf16* hg_slot(Frame& F, int dir, int j, int h) { return (bf16*)F.out + ((size_t)((dir * 128 + (j - 1)) * 4 + h) << 14); }

typedef unsigned u32x2g __attribute__((ext_vector_type(2)));
__device__ __forceinline__ void hg_load8(const bf16* base  , int sg, int cq, u32x2g (&r)[8]) {
    const bf16* p = base + (size_t)(8 * sg) * HGW + 4 * cq;
#pragma unroll
    for (int i = 0; i < 8; ++i) r[i] = *(const GAS u32x2g*)(p + (size_t)i * HGW);
}
__device__ __forceinline__ float hg_elem(const u32x2g (&r)[8], int i, int c) { const unsigned w = (c < 2) ? r[i].x : r[i].y; return (c & 1) ? __uint_as_float(w & 0xffff0000u) : __uint_as_float(w << 16); }
__device__ __forceinline__ unsigned hg_raw(const u32x2g (&r)[8], int i, int c) { const unsigned w = (c < 2) ? r[i].x : r[i].y; return (c & 1) ? (w >> 16) : (w & 0xffffu); }
__device__ __forceinline__ f32x4 hg_gates8(const u32x2g (&z)[8], float (&kk)[4][8], LAS float* tot, int sg, int cq) {
    f32x4 run = {0.f, 0.f, 0.f, 0.f};
#pragma unroll
    for (int c = 0; c < 4; ++c)
#pragma unroll
        for (int i = 0; i < 8; ++i) { const float g = hg_elem(z, i, c); run[c] += g; kk[c][i] = 1.0f - __builtin_amdgcn_exp2f(g); }
    *(LAS f32x4*)(tot + sg * 128 + 4 * cq) = run;
    return run;
}
__device__ __forceinline__ void hg_prefix(const LAS float* tot, const f32x4 own, int sg, int cq, int dir, f32x4& pre, f32x4& ref, f32x4& all) {
    f32x4 lo = {0.f, 0.f, 0.f, 0.f}, hi = lo, pf = lo;
#pragma unroll
    for (int s2 = 0; s2 < 16; ++s2) { const f32x4 v = *(const LAS f32x4*)(tot + s2 * 128 + 4 * cq); const float m = (s2 < sg) ? 1.0f : 0.0f;
        if (s2 < 8) lo += v; else hi += v;
        pf[0] = __builtin_fmaf(v[0], m, pf[0]); pf[1] = __builtin_fmaf(v[1], m, pf[1]); pf[2] = __builtin_fmaf(v[2], m, pf[2]); pf[3] = __builtin_fmaf(v[3], m, pf[3]); }
    all = lo + hi;
    if (dir) { pre = all - pf - own; ref = hi; } else { pre = pf; ref = lo; }
}
__device__ __forceinline__ v4u hg_pack8(const float (&x)[8], int dir) {
    v4u w;
    if (!dir) { w.x = pk2(x[0], x[1]); w.y = pk2(x[2], x[3]); w.z = pk2(x[4], x[5]); w.w = pk2(x[6], x[7]); }
    else { w.x = pk2(x[7], x[6]); w.y = pk2(x[5], x[4]); w.z = pk2(x[3], x[2]); w.w = pk2(x[1], x[0]); }
    return w;
}
__device__ __forceinline__ v4u hg_pack8raw(const u32x2g (&r)[8], int c, int dir) {
    v4u w;
    if (!dir) { w.x = hg_raw(r, 0, c) | (hg_raw(r, 1, c) << 16); w.y = hg_raw(r, 2, c) | (hg_raw(r, 3, c) << 16); w.z = hg_raw(r, 4, c) | (hg_raw(r, 5, c) << 16); w.w = hg_raw(r, 6, c) | (hg_raw(r, 7, c) << 16); }
    else { w.x = hg_raw(r, 7, c) | (hg_raw(r, 6, c) << 16); w.y = hg_raw(r, 5, c) | (hg_raw(r, 4, c) << 16); w.z = hg_raw(r, 3, c) | (hg_raw(r, 2, c) << 16); w.w = hg_raw(r, 1, c) | (hg_raw(r, 0, c) << 16); }
    return w;
}
template <int DIR> __device__ __forceinline__ void hg_pass2_state(const float (&kk)[8], const u32x2g (&zr)[8], int cc, float pre, float B, float (&kx)[8]) {
    float b = pre;
#pragma unroll
    for (int ii = 0; ii < 8; ++ii) { constexpr int dummy = 0; (void)dummy; const int i = DIR ? 7 - ii : ii; const float k = kk[i]; b += hg_elem(zr, i, cc); kx[i] = k * __builtin_amdgcn_exp2f(B - b); }
}
template <int DIR> __device__ __forceinline__ void hg_pass2_out(const float (&kk)[8], const u32x2g (&zr)[8], const u32x2g (&qr)[8], int cc, float pre, float rref, float (&qx)[8], float (&kx)[8]) {
    float b = pre;
#pragma unroll
    for (int ii = 0; ii < 8; ++ii) { const int i = DIR ? 7 - ii : ii; const float k = kk[i]; b += hg_elem(zr, i, cc); const float e = b - rref;
        qx[i] = hg_elem(qr, i, cc) * __builtin_amdgcn_exp2f(fminf(e, 115.f)); kx[i] = k * __builtin_amdgcn_exp2f(fminf(-e, 115.f)); }
}
#define HG4_DECODE(uid_, c_, h_, d_) const int d_ = ((uid_) >= 512) ? 1 : 0, c_ = d_ ? 2 + (((uid_) - 512) >> 2) : ((uid_) >> 2), h_ = (uid_) & 3
#define HG4_ISSUE_LOADS(uid_) do { HG4_DECODE(uid_, cN_, hN_, dN_); const size_t cb_ = ((size_t)128 * cN_) * HGW + hN_ * 128; \
        hg_load8(WSP(bf16, WS_Z + (dN_ ? Z_ZFB : Z_ZFF)) + cb_, sg, cq, zr); hg_load8(WSP(bf16, WS_Z + Z_HV) + cb_, sg, cq, vr); } while (0)
__device__ __forceinline__ void hg_state_phase(Frame& F) {
    const int w = F.wave;
    LAS float* tot = (LAS float*)(F.lds + HL_TOT);
    if (F.vcu >= 1020) return;
    u32x2g zr[8], vr[8];
    { const int tid = threadIdx.x, cq = tid & 31, sg = tid >> 5; HG4_ISSUE_LOADS(F.vcu); }
#pragma unroll 1
    for (int uid = F.vcu; uid < 1020; uid += F.G) {
        int tid_ = threadIdx.x; asm volatile("" : "+v"(tid_));
        const int tid = tid_, lane = tid & 63, r = lane & 31, hi = lane >> 5, cq = tid & 31, sg = tid >> 5;
        HG4_DECODE(uid, c, h, dir);
        const int sgu = dir ? 15 - sg : sg;
        float kk[4][8];
        const f32x4 own = hg_gates8(zr, kk, tot, sg, cq);
#pragma unroll
        for (int cc = 0; cc < 4; ++cc) *(LAS v4u*)(F.lds + HL_VT + (4 * cq + cc) * HL_PITCH + sgu * 16) = hg_pack8raw(vr, cc, dir);
        __syncthreads();
        f32x4 pre, ref, B; hg_prefix(tot, own, sg, cq, dir, pre, ref, B);
#pragma unroll
        for (int cc = 0; cc < 4; ++cc) {
            float kx[8];
            if (dir) hg_pass2_state<1>(kk[cc], zr, cc, pre[cc], B[cc], kx); else hg_pass2_state<0>(kk[cc], zr, cc, pre[cc], B[cc], kx);
            *(LAS v4u*)(F.lds + HL_QH + (4 * cq + cc) * HL_PITCH + sgu * 16) = hg_pack8(kx, dir);
        }
        if (sg == 0) { f32x4 dd; dd[0] = __builtin_amdgcn_exp2f(B[0]); dd[1] = __builtin_amdgcn_exp2f(B[1]); dd[2] = __builtin_amdgcn_exp2f(B[2]); dd[3] = __builtin_amdgcn_exp2f(B[3]); *(f32x4*)(WSP(float, WS_MISC + (dir ? MISC_DB : MISC_DF)) + c * HGW + h * 128 + 4 * cq) = dd; }
        if (uid + F.G < 1020) HG4_ISSUE_LOADS(uid + F.G);
        __syncthreads();
        const int vb = w >> 1;
#pragma unroll
        for (int kbi = 0; kbi < 2; ++kbi) {
            const int kb = 2 * (w & 1) + kbi; f32x16 acc = {};
#pragma unroll
            for (int ks = 0; ks < 8; ++ks) {
                const bf16x8 a = *(const LAS bf16x8*)(F.lds + HL_VT + (32 * vb + r) * HL_PITCH + (16 * ks + 8 * hi) * 2);
                const bf16x8 bq = *(const LAS bf16x8*)(F.lds + HL_QH + (32 * kb + r) * HL_PITCH + (16 * ks + 8 * hi) * 2);
                acc = __builtin_amdgcn_mfma_f32_32x32x16_bf16(bq, a, acc, 0, 0, 0);
            }
            LAS unsigned char* ut = F.lds + HL_ST + (32 * vb + r) * HL_PITCH + (32 * kb + 4 * hi) * 2;
#pragma unroll
            for (int q4 = 0; q4 < 4; ++q4) { u32x2g w; w.x = pk2(acc[4 * q4], acc[4 * q4 + 1]); w.y = pk2(acc[4 * q4 + 2], acc[4 * q4 + 3]); *(LAS u32x2g*)(ut + 16 * q4) = w; }
        }
        __syncthreads();
        { bf16* slot = hg_slot(F, dir, dir ? c - 1 : c + 1, h);
#pragma unroll
          for (int j = 0; j < 4; ++j) { const int p = tid + 512 * j, v = p >> 4, k8 = (p & 15) * 8; *(GAS v4u*)(slot + (size_t)v * 128 + k8) = *(const LAS v4u*)(F.lds + HL_ST + v * HL_PITCH + k8 * 2); } }
    }
    __syncthreads();
}
#undef HG4_ISSUE_LOADS
#undef HG4_DECODE
__device__ __forceinline__ void hg_scan_phase(Frame& F) {
    if ((int)threadIdx.x >= 256) return;
    for (int task = F.vcu * 256 + (int)threadIdx.x; task < 65536; task += F.G * 256) {
        const int dir = task >> 15, h = (task >> 13) & 3, p = task & 8191, v = p >> 6, k = (p & 63) * 2;
        const float* dd = WSP(float, WS_MISC + (dir ? MISC_DB : MISC_DF)) + h * 128 + k;
        unsigned* base = (unsigned*)(hg_slot(F, dir, 1, h) + v * 128 + k);
        const size_t jstride = (size_t)4 * 8192;
        const int j0 = dir ? 127 : 1, step = dir ? -1 : 1;
        unsigned w0 = base[(size_t)(j0 - 1) * jstride]; float s0 = pg8::bf_lo(w0), s1 = pg8::bf_hi(w0);
#pragma unroll 1
        for (int n = 0; n < 127 - dir; n += 32) {
            unsigned wv[32]; f32x2 dv[32];
#pragma unroll
            for (int q = 0; q < 32; ++q) { const int j = j0 + step * (n + q + 1); const bool ok = (n + q) < 127 - dir; const int jj = ok ? j : j0;
                wv[q] = base[(size_t)(jj - 1) * jstride]; dv[q] = *(const f32x2*)(dd + (size_t)(jj - step) * HGW); }
#pragma unroll
            for (int q = 0; q < 32; ++q) { if ((n + q) < 127 - dir) { const int j = j0 + step * (n + q + 1);
                s0 = dv[q].x * s0 + pg8::bf_lo(wv[q]); s1 = dv[q].y * s1 + pg8::bf_hi(wv[q]);
                base[(size_t)(j - 1) * jstride] = pk2(s0, s1); } }
        }
    }
}
template <int CTRL> __device__ __forceinline__ float dpp_add(float v) { return v + __builtin_bit_cast(float, __builtin_amdgcn_update_dpp(0, __builtin_bit_cast(int, v), CTRL, 0xf, 0xf, false)); }
#define HG_ISSUE_LOADS(cN, hN, dirN) do { \
        const size_t cb_ = ((size_t)128 * (cN)) * HGW + (hN) * 128; \
        hg_load8(WSP(bf16, WS_Z + ((dirN) ? Z_ZFB : Z_ZFF)) + cb_, sg, cq, zr); \
        const bool hs_ = !((dirN) == 1 && (cN) == 128); const bf16* sl_ = hg_slot(F, (dirN), hs_ ? (cN) : 1, (hN)); \
        _Pragma("unroll") for (int j_ = 0; j_ < 4; ++j_) { const int p_ = tid + 512 * j_; sraw[j_] = *(const GAS v4u*)(sl_ + (size_t)(p_ >> 4) * 128 + (p_ & 15) * 8); } } while (0)
__device__ __forceinline__ void hg_out_phase(Frame& F, bf16* yabase) {
    const int w = F.wave, vh = w >> 2, tb = vh ? 3 - (w & 3) : (w & 3);
    LAS float* tot = (LAS float*)(F.lds + HL_TOT); LAS float* er = (LAS float*)(F.lds + HL_ER); LAS float* ssqx = (LAS float*)(F.lds + HL_SSQ); LAS float* ox = (LAS float*)(F.lds);
    const lds_cptr QH = (lds_cptr)(F.lds + HL_QH), KH = (lds_cptr)(F.lds + HL_KH);
    const int nun = (512 - F.vcu + F.G - 1) / F.G;
    if (nun <= 0) return;
    u32x2g zr[8]; v4u sraw[4];
    { const int tid = threadIdx.x, cq = tid & 31, sg = tid >> 5; HG_ISSUE_LOADS(1 + (F.vcu >> 2), F.vcu & 3, 0); }
    f32x16 of0 = {}, of1 = {};
#pragma unroll 1
    for (int st = 0; st < 2 * nun; ++st) {
        int tid_ = threadIdx.x; asm volatile("" : "+v"(tid_));
        const int tid = tid_, lane = tid & 63, r = lane & 31, hi = lane >> 5, cq = tid & 31, sg = tid >> 5;
        const int uid = F.vcu + (st >> 1) * F.G, c = 1 + (uid >> 2), h = uid & 3, dir = st & 1;
        const bool hasS = !(dir == 1 && c == 128);
        const int sgu = dir ? 15 - sg : sg;
        u32x2g qr[8], vr[8];
        { const size_t cb = ((size_t)128 * c) * HGW + h * 128; hg_load8(WSP(bf16, WS_Z + Z_HQ) + cb, sg, cq, qr); hg_load8(WSP(bf16, WS_Z + Z_HV) + cb, sg, cq, vr); }
        float kk[4][8];
        const f32x4 own = hg_gates8(zr, kk, tot, sg, cq);
#pragma unroll
        for (int cc = 0; cc < 4; ++cc) *(LAS v4u*)(F.lds + HL_VT + (4 * cq + cc) * HL_PITCH + sgu * 16) = hg_pack8raw(vr, cc, dir);
        __syncthreads();
        f32x4 pre, rref, ball; hg_prefix(tot, own, sg, cq, dir, pre, rref, ball);
#pragma unroll
        for (int cc = 0; cc < 4; ++cc) {
            float qx[8], kx[8];
            if (dir) hg_pass2_out<1>(kk[cc], zr, qr, cc, pre[cc], rref[cc], qx, kx); else hg_pass2_out<0>(kk[cc], zr, qr, cc, pre[cc], rref[cc], qx, kx);
            const int off = hg_img_off(sgu >> 2, 4 * cq + cc, sgu & 3);
            *(LAS v4u*)(F.lds + HL_QH + off) = hg_pack8(qx, dir); *(LAS v4u*)(F.lds + HL_KH + off) = hg_pack8(kx, dir);
        }
        if (sg == 0) { f32x4 ee; ee[0] = __builtin_amdgcn_exp2f(rref[0]); ee[1] = __builtin_amdgcn_exp2f(rref[1]); ee[2] = __builtin_amdgcn_exp2f(rref[2]); ee[3] = __builtin_amdgcn_exp2f(rref[3]); *(LAS f32x4*)(er + 4 * cq) = ee; }
        __syncthreads();
        if (hasS) {
#pragma unroll
            for (int j = 0; j < 4; ++j) { const int p = tid + 512 * j, v = p >> 4, k8 = (p & 15) * 8;
                const v4u sv = sraw[j];
                const f32x4 e0 = *(const LAS f32x4*)(er + k8), e1 = *(const LAS f32x4*)(er + k8 + 4); v4u o;
                o.x = pk2(pg8::bf_lo(sv.x) * e0[0], pg8::bf_hi(sv.x) * e0[1]); o.y = pk2(pg8::bf_lo(sv.y) * e0[2], pg8::bf_hi(sv.y) * e0[3]);
                o.z = pk2(pg8::bf_lo(sv.z) * e1[0], pg8::bf_hi(sv.z) * e1[1]); o.w = pk2(pg8::bf_lo(sv.w) * e1[2], pg8::bf_hi(sv.w) * e1[3]);
                *(LAS v4u*)(F.lds + HL_ST + v * HL_PITCH + k8 * 2) = o; }
        }
        if (st + 1 < 2 * nun) { const int uidn = F.vcu + ((st + 1) >> 1) * F.G; HG_ISSUE_LOADS(1 + (uidn >> 2), uidn & 3, (st + 1) & 1); }
        __syncthreads();
        f32x16 o0 = {}, o1 = {};
        bf16x8 qf[8];
#pragma unroll
        for (int ks = 0; ks < 8; ++ks) qf[ks] = trfrag(QH, tb, ks, lane);
        if (hasS) {
#pragma unroll
            for (int ks = 0; ks < 8; ++ks) {
                const bf16x8 a = qf[ks];
                const bf16x8 b0 = *(const LAS bf16x8*)(F.lds + HL_ST + (64 * vh + r) * HL_PITCH + (16 * ks + 8 * hi) * 2);
                const bf16x8 b1 = *(const LAS bf16x8*)(F.lds + HL_ST + (64 * vh + 32 + r) * HL_PITCH + (16 * ks + 8 * hi) * 2);
                o0 = __builtin_amdgcn_mfma_f32_32x32x16_bf16(a, b0, o0, 0, 0, 0); o1 = __builtin_amdgcn_mfma_f32_32x32x16_bf16(a, b1, o1, 0, 0, 0);
            }
        }
#pragma unroll 1
        for (int sb = 0; sb <= tb; ++sb) {
            f32x16 ct = {};
#pragma unroll
            for (int ks = 0; ks < 8; ++ks) { const bf16x8 a = trfrag(KH, sb, ks, lane); ct = __builtin_amdgcn_mfma_f32_32x32x16_bf16(a, qf[ks], ct, 0, 0, 0); }
            if (sb == tb) {
                int rr = r - 4 * hi; asm volatile("" : "+v"(rr));
#pragma unroll
                for (int g = 0; g < 16; ++g) if ((g & 3) + 8 * (g >> 2) > rr) ct[g] = 0.f;
            }
            v4u pw[2];
#pragma unroll
            for (int s2 = 0; s2 < 2; ++s2) { pw[s2].x = pk2(ct[8 * s2], ct[8 * s2 + 1]); pw[s2].y = pk2(ct[8 * s2 + 2], ct[8 * s2 + 3]); pw[s2].z = pk2(ct[8 * s2 + 4], ct[8 * s2 + 5]); pw[s2].w = pk2(ct[8 * s2 + 6], ct[8 * s2 + 7]); }
#pragma unroll
            for (int s2 = 0; s2 < 2; ++s2) {
                const bf16x8 pa = __builtin_bit_cast(bf16x8, pw[s2]);
                const LAS unsigned char* v0 = F.lds + HL_VT + (64 * vh + r) * HL_PITCH + (32 * sb + 16 * s2 + 4 * hi) * 2; const LAS unsigned char* v1 = v0 + 32 * HL_PITCH;
                const s16x4 a0 = *(const LAS s16x4*)v0, a1 = *(const LAS s16x4*)(v0 + 16), c0 = *(const LAS s16x4*)v1, c1 = *(const LAS s16x4*)(v1 + 16);
                o0 = __builtin_amdgcn_mfma_f32_32x32x16_bf16(pa, (bf16x8){a0[0], a0[1], a0[2], a0[3], a1[0], a1[1], a1[2], a1[3]}, o0, 0, 0, 0);
                o1 = __builtin_amdgcn_mfma_f32_32x32x16_bf16(pa, (bf16x8){c0[0], c0[1], c0[2], c0[3], c1[0], c1[1], c1[2], c1[3]}, o1, 0, 0, 0);
            }
        }
        __syncthreads();
        if (dir == 0) { of0 = o0; of1 = o1; }
        else {
            int lane2 = lane; asm volatile("" : "+v"(lane2)); const int r2 = lane2 & 31, hi2 = lane2 >> 5;
            int ub = (32 * tb + 4 * hi2) * OX_PITCH + 64 * vh + r2; asm volatile("" : "+v"(ub));
#pragma unroll
            for (int g = 0; g < 16; ++g) { const int cg = ((g & 3) + 8 * (g >> 2)) * OX_PITCH; ox[ub + cg] = o0[g]; ox[ub + cg + 32] = o1[g]; }
            int tid2 = tid; asm volatile("" : "+v"(tid2));
            v4u hgr[4];
            { const bf16* hgp = WSP(bf16, WS_Z + Z_HG) + ((size_t)128 * c + (tid2 >> 2)) * HGW + h * 128 + 32 * (tid2 & 3);
#pragma unroll
              for (int j = 0; j < 4; ++j) hgr[j] = *(const GAS v4u*)(hgp + 8 * j); }
            const float* ow = F.in[10] + h * 128 + 64 * vh + r2; const float w0 = ow[0], w1 = ow[32];
            __syncthreads();
            int tbase = 32 * tb + 4 * hi2; asm volatile("" : "+v"(tbase));
            { const int rb = (127 - tbase) * OX_PITCH + 64 * vh + r2;
              float sqv[16];
#pragma unroll
              for (int g = 0; g < 16; ++g) { const int cg = (g & 3) + 8 * (g >> 2);
                of0[g] += ox[rb - cg * OX_PITCH]; of1[g] += ox[rb - cg * OX_PITCH + 32];
                sqv[g] = of0[g] * of0[g] + of1[g] * of1[g]; }
#pragma unroll
              for (int g = 0; g < 16; ++g) { float sq = sqv[g]; sq = dpp_add<0xB1>(sq); sq = dpp_add<0x4E>(sq); sq = dpp_add<0x141>(sq); sq = dpp_add<0x140>(sq); sqv[g] = sq; }
              if ((r2 & 15) == 0) {
#pragma unroll
                for (int g = 0; g < 16; ++g) { const int cg = (g & 3) + 8 * (g >> 2); ssqx[(tbase + cg) * 4 + 2 * vh + (r2 >> 4)] = sqv[g]; } } }
            __syncthreads();
            { const int yb = tbase * OX_PITCH + 64 * vh + r2;
#pragma unroll
              for (int g = 0; g < 16; ++g) { const int cg = (g & 3) + 8 * (g >> 2);
                const f32x4 pp = *(const LAS f32x4*)(ssqx + (tbase + cg) * 4);
                const float rn = rsqrtf(((pp[0] + pp[1]) + (pp[2] + pp[3])) * (1.0f / 128.0f) + pg8::RMS_EPS);
                ox[yb + cg * OX_PITCH] = of0[g] * rn * w0; ox[yb + cg * OX_PITCH + 32] = of1[g] * rn * w1; } }
            __syncthreads();
            { const int t = tid2 >> 2, c0 = 32 * (tid2 & 3);
              bf16* ya = yabase + ((size_t)128 * c + t) * HGW + h * 128 + c0;
#pragma unroll
              for (int j = 0; j < 4; ++j) { const f32x4 y0 = *(const LAS f32x4*)(ox + t * OX_PITCH + c0 + 8 * j), y1 = *(const LAS f32x4*)(ox + t * OX_PITCH + c0 + 8 * j + 4); const v4u gq = hgr[j]; v4u o;
                  o.x = pk2(y0[0] * pg8::bf_lo(gq.x), y0[1] * pg8::bf_hi(gq.x)); o.y = pk2(y0[2] * pg8::bf_lo(gq.y), y0[3] * pg8::bf_hi(gq.y));
                  o.z = pk2(y1[0] * pg8::bf_lo(gq.z), y1[1] * pg8::bf_hi(gq.z)); o.w = pk2(y1[2] * pg8::bf_lo(gq.w), y1[3] * pg8::bf_hi(gq.w));
                  *(GAS v4u*)(ya + 8 * j) = o; } }
            __syncthreads();
        }
    }
}
#undef HG_ISSUE_LOADS

struct Args { const float* in[20]; float* out; unsigned char* ws; int ph_lo, ph_hi; };
__global__ void __launch_bounds__(NWAVES * 64, 2) mk_fwd(Args args) {
    extern __shared__ __attribute__((aligned(16))) unsigned char lds[];
    Frame F;
    F.lds = (LAS unsigned char*)lds;
    F.MISC = (volatile LAS unsigned*)(F.lds + MISC_OFF);
    F.wave = __builtin_amdgcn_readfirstlane((int)threadIdx.x >> 6);
    F.G = gridDim.x; { const int bx = blockIdx.x; F.vcu = (F.G % 8 == 0) ? (bx % 8) * (F.G / 8) + bx / 8 : bx; }
    F.ws = args.ws; F.out = args.out;
#pragma unroll
    for (int i = 0; i < 20; ++i) F.in[i] = args.in[i];
    F.ctl = (gu32*)(F.ws + WS_CTL);
    for (int u = (int)threadIdx.x; u < (LDS_BYTES - LDSCTL_OFF) / 4; u += NWAVES * 64) ((LAS unsigned*)(F.lds + LDSCTL_OFF))[u] = 0u;
    __syncthreads();
    XcdBarrier bar; bar.bar = (unsigned*)(F.ctl + CW_BAR); bar.x = 0; bar.st = nullptr;
    if (N_LAUNCHES == 1) bar = xcd_barrier_post((unsigned*)(F.ctl + CW_BAR), F.MISC + 8);
    const int lo = args.ph_lo, hi = args.ph_hi;
    bf16* Wb = WSP(bf16, WS_W); bf16* HB = WSP(bf16, WS_HB); bf16* ACT = WSP(bf16, WS_Z); bf16* MIXED = WSP(bf16, WS_Z + Z_HV);

#ifndef PHMASK
#define PHMASK 0x7ff
#endif
#define IN(k) (((PHMASK >> (k)) & 1) && lo <= (k) && (k) < hi)
#define SEAM(k) do { if ((k) + 1 < hi) xcd_barrier(bar); } while (0)
#define PH_GATEUP(W_off, SSQ_off) do { \
        pg8::Gemm g{HB, Wb + (W_off) / 2, M, NGU, DM}; pg8::RsOrder S; S.init(M, NGU, F.G, (int)blockIdx.x); S.ssqp = WSP(float, SSQ_off); S.tab = (LAS float*)(F.lds + RS_OFF); S.prefill(); \
        pg8::EpiSwiglu E{ACT, (const LAS float*)(F.lds + RS_OFF), DFF}; \
        pg8::gemm_phase<pg8::EpiSwiglu, pg8::RsOrder, true, true>(F.lds + RING_OFF, g, S, E); } while (0)
#define PH_RES(Aptr, W_off, Kdim, BASE32, BASE16, OUT32, HBOUT, SSQOUT, SCALE) do { \
        pg8::Gemm g{Aptr, Wb + (W_off) / 2, M, DM, Kdim}; pg8::StaticOrder S; S.init(M, DM, F.G, (int)blockIdx.x); \
        if (S.nwg <= F.G) { pg8::EpiResT E{BASE16, OUT32, HBOUT, SSQOUT, SCALE}; pg8::gemm_phase<pg8::EpiResT, pg8::StaticOrder, true, true>(F.lds + RING_OFF, g, S, E); }     \
        else { pg8::EpiRes E{BASE32, BASE16, OUT32, HBOUT, SSQOUT, SCALE}; pg8::gemm_phase<pg8::EpiRes, pg8::StaticOrder, true, true>(F.lds + RING_OFF, g, S, E); } } while (0)

#ifndef DUP_PHASE
#define DUP_PHASE -1
#endif
#define DUP(k) (DUP_PHASE == (k))
    if (IN(0)) { if (DUP(0)) { p0_prologue(F); xcd_barrier(bar); } p0_prologue(F); SEAM(0); }
    if (IN(1)) { if (DUP(1)) { meta_p1(F); PH_GATEUP(W_GU1, WS_SSQ0); xcd_barrier(bar); } meta_p1(F); misc_tables(F, (M / 256) * (NGU / 256)); convert_in_idle_slot(F, (M / 256) * (NGU / 256), CV_FFN1, CV_IN); PH_GATEUP(W_GU1, WS_SSQ0); SEAM(1); }
    if (IN(2)) { if (DUP(2)) { meta_p2(F); PH_RES(ACT, W_D1, DFF, (const float*)nullptr, HB, (float*)nullptr, HB, WSP(float, WS_SSQ1), 0.5f); xcd_barrier(bar); } meta_p2(F); PH_RES(ACT, W_D1, DFF, (const float*)nullptr, HB, (float*)nullptr, HB, WSP(float, WS_SSQ1), 0.5f); SEAM(2); }
#define PH_MIX() do { \
        meta_p3(F); \
        pg8::Gemm g{HB, Wb + W_IN / 2, M, NIN, DM}; pg8::RsOrder S; S.init(M, NIN, F.G, (int)blockIdx.x); S.ssqp = WSP(float, WS_SSQ1); S.tab = (LAS float*)(F.lds + RS_OFF); S.prefill(); \
        pg8::EpiMix E{(const LAS float*)(F.lds + RS_OFF), WSP(bf16, WS_Z + Z_HQ) + 128 * HGW, WSP(bf16, WS_Z + Z_HV) + 128 * HGW, WSP(bf16, WS_Z + Z_ZFF) + 128 * HGW, WSP(bf16, WS_Z + Z_ZFB) + 128 * HGW, WSP(bf16, WS_Z + Z_HG) + 128 * HGW, \
                      WSP(bf16, WS_Z + Z_QO), WSP(bf16, WS_Z + Z_KB), WSP(bf16, WS_Z + Z_VB), WSP(bf16, WS_Z + Z_GA), WSP(bf16, WS_Z + Z_GB), \
                      F.in[11], F.in[12], WSP(pg8::f32x2, WS_MISC + MISC_ROPER), WSP(pg8::f32x2, WS_MISC + MISC_ROPEC), attn_body::C2, WSP(float, WS_MISC + MISC_OMLF), WSP(float, WS_MISC + MISC_OMLB)}; \
        pg8::gemm_phase<pg8::EpiMix, pg8::RsOrder, true, true>(F.lds + RING_OFF, g, S, E); } while (0)
    if (IN(3)) { if (DUP(3)) { PH_MIX(); xcd_barrier(bar); } convert_in_idle_slot(F, (M / 256) * (NIN / 256), CV_IN, CV_ALL); PH_MIX(); SEAM(3); }
    if (IN(4)) { if (DUP(4)) { hg_state_phase(F); xcd_barrier(bar); } hg_state_phase(F); SEAM(4); }
    if (IN(5)) {
        if (DUP(5)) { const attn_body::AttnTensors ATd{WSP(bf16, WS_Z + Z_QO), WSP(bf16, WS_Z + Z_KB), WSP(bf16, WS_Z + Z_VB), Wb, F.in[11], F.in[12]}; attn_body::attn_phase<8>((char*)lds + RING_OFF, ATd, F.vcu, F.G); xcd_barrier(bar); }
        hg_scan_phase(F);
        const attn_body::AttnTensors AT{WSP(bf16, WS_Z + Z_QO), WSP(bf16, WS_Z + Z_KB), WSP(bf16, WS_Z + Z_VB), WSP(bf16, WS_Z + Z_QO), F.in[11], F.in[12]};
        attn_body::attn_phase<8>((char*)lds + RING_OFF, AT, F.vcu, F.G);
        SEAM(5);
    }
    if (IN(6)) { if (DUP(6)) { hg_out_phase(F, Wb); xcd_barrier(bar); } hg_out_phase(F, WSP(bf16, WS_Z + Z_HQ)); SEAM(6); }
    for (int rep7 = 0; rep7 < (DUP(7) ? 2 : 1); ++rep7)
    if (IN(7)) {
        if (rep7) xcd_barrier(bar);
        pg8::Gemm g{WSP(bf16, WS_Z + Z_HQ) + 128 * HGW, Wb + W_UP / 2, 2 * M, 2 * DM, HGW}; pg8::UpOrder S; S.init(F.G, (int)blockIdx.x);
        pg8::EpiUp E{WSP(bf16, WS_Z + Z_GA), WSP(bf16, WS_Z + Z_GB), MIXED};
        pg8::gemm_phase<pg8::EpiUp, pg8::UpOrder, true, true>(F.lds + RING_OFF, g, S, E);
        SEAM(7);
    }
    if (IN(8)) { PH_RES(MIXED, W_OUT, DM, (const float*)nullptr, HB, (float*)nullptr, HB, WSP(float, WS_SSQ2), 1.0f); SEAM(8); }
    if (IN(9)) { if (DUP(9)) { PH_GATEUP(W_GU2, WS_SSQ2); xcd_barrier(bar); } stagger_short_share(F, (M / 256) * (NGU / 256), 3); PH_GATEUP(W_GU2, WS_SSQ2); SEAM(9); }
    if (IN(10)) { PH_RES(ACT, W_D2, DFF, (const float*)nullptr, HB, F.out, (bf16*)nullptr, (float*)nullptr, 0.5f);
    }
#undef IN
#undef SEAM
}

extern "C" void kernel_launch(void* const* d_in, const int* in_sizes, int n_in, void* d_out, int out_size, void* d_ws, size_t ws_size, hipStream_t stream) {
    static int grid = 0;
    if (grid == 0) {
        if (n_in != 20 || in_sizes[0] != M * DM || out_size != M * DM || ws_size < WS_END) { fprintf(stderr, "kernel_launch: built for 20 inputs, x/out of %d floats, >= %zu bytes of workspace; got n_in %d, in0 %d, out %d, ws %zu; nothing launched\n", M * DM, (size_t)WS_END, n_in, n_in > 0 ? in_sizes[0] : -1, out_size, ws_size); grid = -1; return; }
        int dev = 0, cus = 0, per_cu = 0;
        if (hipGetDevice(&dev) != hipSuccess || hipDeviceGetAttribute(&cus, hipDeviceAttributeMultiprocessorCount, dev) != hipSuccess) { fprintf(stderr, "kernel_launch: device query failed\n"); grid = -1; return; }
        if (hipFuncSetAttribute((const void*)mk_fwd, hipFuncAttributeMaxDynamicSharedMemorySize, LDS_BYTES) != hipSuccess) { fprintf(stderr, "kernel_launch: hipFuncSetAttribute failed\n"); grid = -1; return; }
        if (hipOccupancyMaxActiveBlocksPerMultiprocessor(&per_cu, (const void*)mk_fwd, NWAVES * 64, LDS_BYTES) != hipSuccess || per_cu < 1) { fprintf(stderr, "kernel_launch: occupancy query reports %d workgroups per CU\n", per_cu); per_cu = 1; }
        (void)hipGetLastError();
        if (cus < DFF / 16) { fprintf(stderr, "kernel_launch: %d CUs; the meta-token side path deals one job per workgroup and needs >= %d workgroups; nothing launched\n", cus, DFF / 16); grid = -1; return; }
        grid = cus;
    }
    if (grid < 0) return;
    if (hipMemsetAsync((char*)d_ws + WS_CTL, 0, CTL_ZERO_BYTES, stream) != hipSuccess) { fprintf(stderr, "kernel_launch: memset failed\n"); return; }
    Args a{};
    for (int i = 0; i < 20; ++i) a.in[i] = (const float*)d_in[i];
    a.out = (float*)d_out; a.ws = (unsigned char*)d_ws;
    for (int li = 0; li < N_LAUNCHES; ++li) {
        a.ph_lo = (N_LAUNCHES == 1) ? 0 : li; a.ph_hi = (N_LAUNCHES == 1) ? N_PHASES : li + 1;
        hipLaunchKernelGGL(mk_fwd, dim3(grid), dim3(NWAVES * 64), LDS_BYTES, stream, a);
        const hipError_t le = hipPeekAtLastError();
        if (le != hipSuccess) { fprintf(stderr, "kernel_launch: launch %d failed: %s\n", li, hipGetErrorName(le)); break; }
    }
}
```

```cpp
#include <hip/hip_runtime.h>
#include <cstdio>
#include <cstdint>
#include <cmath>
namespace pg8 {
#define PG8_LAS __attribute__((address_space(3)))
typedef unsigned short bf16_t;
typedef short bf16x8 __attribute__((ext_vector_type(8)));
typedef float f32x4 __attribute__((ext_vector_type(4)));
typedef unsigned u32x4 __attribute__((ext_vector_type(4)));
constexpr int BM = 256, BK = 64, HALF = 128, HTB = HALF * BK * 2  , STAGE_BYTES = 8 * HTB, NXCD = 8, WGM = 8;

__host__ __device__ __forceinline__ int lds_byte(int r, int c) { const int st = (r >> 4) * 2 + (c >> 5), rr = r & 15, cc = c & 31, ob = rr * 64 + cc * 2; return st * 1024 + (ob ^ (((ob >> 9) & 1) << 5)); }
__host__ __device__ __forceinline__ void stage_rc(int b, int& R, int& C) { const int st = b / 1024, sb = b % 1024, swz = sb ^ (((sb >> 9) & 1) << 5); R = (st >> 1) * 16 + swz / 64; C = (st & 1) * 32 + (swz % 64) / 2; }
__host__ __device__ __forceinline__ int perm32(int rho) { const int n = rho >> 4, i = rho & 15; return 8 * (i >> 2) + 4 * n + (i & 3); }

struct Unit { int pm, pn, idx; };
struct Gemm { const bf16_t* A; const bf16_t* Bt; int M, N, K; };

struct StaticOrder {
    int nM, nN, nwg, G, c;
    __host__ __device__ void init(int M, int N, int G_, int c_) { nM = M / BM; nN = N / BM; nwg = nM * nN; G = G_; c = c_; }
    __host__ __device__ bool next(int i, Unit& u) const {
        const long L = (long)i * G + c; if (L >= nwg) return false;
        int wgid = (int)L; { const int q = nwg / NXCD, r = nwg % NXCD, xcd = wgid % NXCD, off = wgid / NXCD; wgid = (xcd < r ? xcd * (q + 1) : r * (q + 1) + (xcd - r) * q) + off; }
        const int nig = WGM * nN, gid = wgid / nig, fm = gid * WGM, gsz = (nM - fm) < WGM ? (nM - fm) : WGM;
        u.pm = fm + ((wgid % nig) % gsz); u.pn = (wgid % nig) / gsz; u.idx = i; return true;
    }
    __device__ __forceinline__ void a_ready(const Unit&) const {}
    __device__ __forceinline__ void done(const Unit&) const {}
};


constexpr int RS_UNITS = 8;
struct RsOrder : StaticOrder {
    const float* ssqp; PG8_LAS float* tab;
    __device__ __forceinline__ void prefill() const {
        const int tid = threadIdx.x, row = tid >> 1, hf = tid & 1;
        f32x4 a[RS_UNITS], b[RS_UNITS]; bool ok[RS_UNITS]; Unit u0; next(0, u0);
#pragma unroll
        for (int i = 0; i < RS_UNITS; ++i) { Unit u; ok[i] = next(i, u); if (!ok[i]) u = u0;
            const f32x4* p = (const f32x4*)(ssqp + (size_t)(u.pm * BM + row) * 16 + hf * 8); a[i] = p[0]; b[i] = p[1]; }
#pragma unroll
        for (int i = 0; i < RS_UNITS; ++i) {
            float s = ((a[i][0] + a[i][1]) + (a[i][2] + a[i][3])) + ((b[i][0] + b[i][1]) + (b[i][2] + b[i][3]));
            s += __shfl_xor(s, 1);
            if (hf == 0 && ok[i]) tab[i * BM + row] = rsqrtf(s * (1.0f / 1024.0f) + 1e-6f);
        }
        __syncthreads();
    }
    __device__ __forceinline__ void a_ready(const Unit&) const {}
};

typedef float f32x2_cv __attribute__((ext_vector_type(2))); typedef __bf16 bf16x2_cv __attribute__((ext_vector_type(2)));
__device__ __forceinline__ unsigned cvt_pk_bf16(float lo, float hi) { f32x2_cv v = {lo, hi}; bf16x2_cv b = __builtin_convertvector(v, bf16x2_cv); return __builtin_bit_cast(unsigned, b); }
typedef float f32x2 __attribute__((ext_vector_type(2)));
typedef unsigned u32x2 __attribute__((ext_vector_type(2)));
__device__ __forceinline__ float bf_lo(unsigned w) { return __uint_as_float(w << 16); }
__device__ __forceinline__ float bf_hi(unsigned w) { return __uint_as_float(w & 0xffff0000u); }
__device__ __forceinline__ float fast_sigmoid(float v) { return __builtin_amdgcn_rcpf(1.0f + __expf(-v)); }
__device__ __forceinline__ float fast_silu(float v) { return v * __builtin_amdgcn_rcpf(1.0f + __expf(-v)); }
constexpr float RMS_EPS = 1e-6f;
__device__ __forceinline__ float rstd_from(const float* ssqp, int row) {
    const f32x4* p = (const f32x4*)(ssqp + (size_t)row * 16);
    const f32x4 a = p[0], b = p[1], c = p[2], d = p[3];
    const float s = (((a[0] + a[1]) + (a[2] + a[3])) + ((b[0] + b[1]) + (b[2] + b[3]))) + (((c[0] + c[1]) + (c[2] + c[3])) + ((d[0] + d[1]) + (d[2] + d[3])));
    return rsqrtf(s * (1.0f / 1024.0f) + RMS_EPS);
}

struct EpiSwiglu {
    static constexpr bool PERM = true, AFTER_DRAIN = false, KEEP_ACC = false, LAST_FUSED = false;
    bf16_t* O; const PG8_LAS float* tab; int ldo;
    __device__ __forceinline__ void operator()(const f32x4 (&acc)[2][2][4][2], const Unit& u, int wr, int wc, int fr, int fq) const {
        const int row0 = u.pm * BM + wr * 64 + fr, col0 = u.pn * HALF + wc * 32 + 8 * fq;
#pragma unroll
        for (int ai = 0; ai < 2; ++ai)
#pragma unroll
            for (int m = 0; m < 4; ++m) {
                const int row = row0 + ai * HALF + m * 16; const float rs = tab[u.idx * BM + ai * HALF + wr * 64 + m * 16 + fr];
                float o[8];
#pragma unroll
                for (int n = 0; n < 2; ++n)
#pragma unroll
                    for (int i = 0; i < 4; ++i) { const float g = acc[ai][0][m][n][i] * rs, up = acc[ai][1][m][n][i] * rs; o[4 * n + i] = fast_silu(g) * up; }
                u32x4 w; w.x = cvt_pk_bf16(o[0], o[1]); w.y = cvt_pk_bf16(o[2], o[3]); w.z = cvt_pk_bf16(o[4], o[5]); w.w = cvt_pk_bf16(o[6], o[7]);
                *(u32x4*)(O + (size_t)row * ldo + col0) = w;
            }
    }
};

struct EpiRes {
    static constexpr bool PERM = false, AFTER_DRAIN = false, KEEP_ACC = false, LAST_FUSED = false;
    const float* base32; const bf16_t* base16; float* out32; bf16_t* hb; float* ssqp; float scale;
    __device__ __forceinline__ void operator()(const f32x4 (&acc)[2][2][4][2], const Unit& u, int wr, int wc, int fr, int fq) const {
        const int row0 = u.pm * BM + wr * 64 + fr, col0 = u.pn * BM + wc * 32 + 4 * fq;
#pragma unroll
        for (int ai = 0; ai < 2; ++ai)
#pragma unroll
            for (int m = 0; m < 4; ++m) {
                const int row = row0 + ai * HALF + m * 16; const size_t off = (size_t)row * 1024 + col0; float ss = 0.f;
                f32x4 b[2][2];
#pragma unroll
                for (int bj = 0; bj < 2; ++bj)
#pragma unroll
                    for (int n = 0; n < 2; ++n) {
                        if (base32) b[bj][n] = *(const f32x4*)(base32 + off + bj * HALF + n * 16);
                        else { const u32x2 w = *(const u32x2*)(base16 + off + bj * HALF + n * 16); b[bj][n] = (f32x4){bf_lo(w.x), bf_hi(w.x), bf_lo(w.y), bf_hi(w.y)}; }
                    }
#pragma unroll
                for (int bj = 0; bj < 2; ++bj)
#pragma unroll
                    for (int n = 0; n < 2; ++n) {
                        const f32x4 v = b[bj][n] + acc[ai][bj][m][n] * scale;
                        if (out32) *(f32x4*)(out32 + off + bj * HALF + n * 16) = v;
                        if (hb) { u32x2 w; w.x = cvt_pk_bf16(v[0], v[1]); w.y = cvt_pk_bf16(v[2], v[3]); *(u32x2*)(hb + off + bj * HALF + n * 16) = w; }
                        ss += (v[0] * v[0] + v[1] * v[1]) + (v[2] * v[2] + v[3] * v[3]);
                    }
                if (ssqp) { ss += __shfl_xor(ss, 16); ss += __shfl_xor(ss, 32); if (fq == 0) ssqp[(size_t)row * 16 + u.pn * 4 + wc] = ss; }
            }
    }
};

template <int CTRL> __device__ __forceinline__ float dpp_addf(float v) { return v + __builtin_bit_cast(float, __builtin_amdgcn_update_dpp(0, __builtin_bit_cast(int, v), CTRL, 0xf, 0xf, false)); }
struct EpiResT {
    static constexpr bool PERM = false, AFTER_DRAIN = true, KEEP_ACC = false, LAST_FUSED = false;
    static constexpr int TP = 260;
    const bf16_t* base16; float* out32; bf16_t* hb; float* ssqp; float scale;
    __device__ __forceinline__ void operator()(const f32x4 (&)[2][2][4][2], const Unit&, int, int, int, int) const {}
    __device__ __forceinline__ void fused(const f32x4 (&acc)[2][2][4][2], const Unit& u, int wr, int wc, int fr, int fq, PG8_LAS unsigned char* lds, int wid, int lane) const {
        PG8_LAS float* T = (PG8_LAS float*)lds;
        const int tid = wid * 64 + lane, rr = tid >> 5, cc = (tid & 31) * 8;
#pragma unroll
        for (int ai = 0; ai < 2; ++ai) {
            const size_t g0 = (size_t)(u.pm * BM + ai * HALF + rr) * 1024 + u.pn * BM + cc;
            u32x4 bq[8];
#pragma unroll
            for (int i = 0; i < 8; ++i) bq[i] = *(const u32x4*)(base16 + g0 + (size_t)(16 * i) * 1024);
#pragma unroll
            for (int bj = 0; bj < 2; ++bj)
#pragma unroll
                for (int m = 0; m < 4; ++m)
#pragma unroll
                    for (int n = 0; n < 2; ++n) *(PG8_LAS f32x4*)(T + (wr * 64 + 16 * m + fr) * TP + bj * HALF + wc * 32 + 16 * n + 4 * fq) = acc[ai][bj][m][n];
            __syncthreads();
#pragma unroll
            for (int i = 0; i < 8; ++i) {
                const f32x4 a0 = *(const PG8_LAS f32x4*)(T + (rr + 16 * i) * TP + cc), a1 = *(const PG8_LAS f32x4*)(T + (rr + 16 * i) * TP + cc + 4);
                const u32x4 w = bq[i]; const size_t g = g0 + (size_t)(16 * i) * 1024;
                const f32x4 v0 = (f32x4){bf_lo(w.x), bf_hi(w.x), bf_lo(w.y), bf_hi(w.y)} + a0 * scale, v1 = (f32x4){bf_lo(w.z), bf_hi(w.z), bf_lo(w.w), bf_hi(w.w)} + a1 * scale;
                if (out32) { *(f32x4*)(out32 + g) = v0; *(f32x4*)(out32 + g + 4) = v1; }
                if (hb) { u32x4 o; o.x = cvt_pk_bf16(v0[0], v0[1]); o.y = cvt_pk_bf16(v0[2], v0[3]); o.z = cvt_pk_bf16(v1[0], v1[1]); o.w = cvt_pk_bf16(v1[2], v1[3]); *(u32x4*)(hb + g) = o; }
                if (ssqp) {
                    float ss = ((v0[0] * v0[0] + v0[1] * v0[1]) + (v0[2] * v0[2] + v0[3] * v0[3])) + ((v1[0] * v1[0] + v1[1] * v1[1]) + (v1[2] * v1[2] + v1[3] * v1[3]));
                    ss = dpp_addf<0xB1>(ss); ss = dpp_addf<0x4E>(ss); ss = dpp_addf<0x141>(ss);
                    if ((tid & 7) == 0) ssqp[(size_t)(u.pm * BM + ai * HALF + rr + 16 * i) * 16 + u.pn * 4 + ((tid & 31) >> 3)] = ss;
                }
            }
            __syncthreads();
        }
    }
};

struct EpiMix {
    static constexpr bool PERM = true, AFTER_DRAIN = false, KEEP_ACC = false, LAST_FUSED = false;
    const PG8_LAS float* tab;
    bf16_t *HQ, *HV, *ZFF, *ZFB, *HG;
    bf16_t *QO; bf16_t *KB, *VB;
    bf16_t *GA, *GB;
    const float *qnw, *knw; const f32x2* ropeR; const f32x2* ropeC; float c2; const float *omlf, *omlb;
    template <int ACT>
    __device__ __forceinline__ void ew_store(const f32x4 (&acc)[2][2][4][2], const Unit& u, bf16_t* dst, int pitch, int row0, int col0, int wr, int fr, const float* oml = nullptr) const {
        float om[2][8];
        if (ACT == 3) {
#pragma unroll
            for (int bj = 0; bj < 2; ++bj) { const f32x4 a = *(const f32x4*)(oml + col0 + bj * HALF), b = *(const f32x4*)(oml + col0 + bj * HALF + 4); om[bj][0] = a[0]; om[bj][1] = a[1]; om[bj][2] = a[2]; om[bj][3] = a[3]; om[bj][4] = b[0]; om[bj][5] = b[1]; om[bj][6] = b[2]; om[bj][7] = b[3]; }
        }
#pragma unroll
        for (int ai = 0; ai < 2; ++ai)
#pragma unroll
            for (int m = 0; m < 4; ++m) {
                const int row = row0 + ai * HALF + m * 16; const float rs = tab[u.idx * BM + ai * HALF + wr * 64 + m * 16 + fr];
#pragma unroll
                for (int bj = 0; bj < 2; ++bj) {
                    float o[8];
#pragma unroll
                    for (int n = 0; n < 2; ++n)
#pragma unroll
                        for (int i = 0; i < 4; ++i) { const float v = acc[ai][bj][m][n][i] * rs;
                            if (ACT == 3) o[4 * n + i] = __builtin_amdgcn_logf(1.0f - om[bj][4 * n + i] * __builtin_amdgcn_rcpf(1.0f + __builtin_amdgcn_exp2f(v * 1.4426950408889634f)));
                            else o[4 * n + i] = (ACT == 0) ? v : ((ACT == 1) ? fast_silu(v) : fast_sigmoid(v)); }
                    u32x4 w; w.x = cvt_pk_bf16(o[0], o[1]); w.y = cvt_pk_bf16(o[2], o[3]); w.z = cvt_pk_bf16(o[4], o[5]); w.w = cvt_pk_bf16(o[6], o[7]);
                    *(u32x4*)(dst + (size_t)row * pitch + col0 + bj * HALF) = w;
                }
            }
    }
    __device__ __forceinline__ void operator()(const f32x4 (&acc)[2][2][4][2], const Unit& u, int wr, int wc, int fr, int fq) const {
        const int row0 = u.pm * BM + wr * 64 + fr; const int pn = u.pn;
        if (pn >= 13) {
            const int col0 = (pn - 13) * HALF + wc * 32 + 8 * fq;
#pragma unroll
            for (int ai = 0; ai < 2; ++ai)
#pragma unroll
                for (int m = 0; m < 4; ++m) {
                    const int row = row0 + ai * HALF + m * 16; const float rs = tab[u.idx * BM + ai * HALF + wr * 64 + m * 16 + fr];
                    float sb[8], ra[8];
#pragma unroll
                    for (int n = 0; n < 2; ++n)
#pragma unroll
                        for (int i = 0; i < 4; ++i) sb[4 * n + i] = fmaxf(fast_sigmoid(acc[ai][1][m][n][i] * rs), 1e-30f);
                    u32x4 wb; wb.x = cvt_pk_bf16(sb[0], sb[1]); wb.y = cvt_pk_bf16(sb[2], sb[3]); wb.z = cvt_pk_bf16(sb[4], sb[5]); wb.w = cvt_pk_bf16(sb[6], sb[7]);
                    const float gbr[8] = {bf_lo(wb.x), bf_hi(wb.x), bf_lo(wb.y), bf_hi(wb.y), bf_lo(wb.z), bf_hi(wb.z), bf_lo(wb.w), bf_hi(wb.w)};
#pragma unroll
                    for (int n = 0; n < 2; ++n)
#pragma unroll
                        for (int i = 0; i < 4; ++i) ra[4 * n + i] = fast_sigmoid(acc[ai][0][m][n][i] * rs) * __builtin_amdgcn_rcpf(gbr[4 * n + i]);
                    u32x4 wa; wa.x = cvt_pk_bf16(ra[0], ra[1]); wa.y = cvt_pk_bf16(ra[2], ra[3]); wa.z = cvt_pk_bf16(ra[4], ra[5]); wa.w = cvt_pk_bf16(ra[6], ra[7]);
                    *(u32x4*)(GA + (size_t)row * 1024 + col0) = wa; *(u32x4*)(GB + (size_t)row * 1024 + col0) = wb;
                }
        } else if (pn < 10) {
            bf16_t* dst; int pitch, ct, act; const float* oml = nullptr;
            if (pn < 2) { dst = HQ; pitch = 512; ct = pn; act = 1; }
            else if (pn < 4) { dst = HV; pitch = 512; ct = pn - 2; act = 0; }
            else if (pn < 6) { dst = ZFF; pitch = 512; ct = pn - 4; act = 3; oml = omlf; }
            else if (pn < 8) { dst = ZFB; pitch = 512; ct = pn - 6; act = 3; oml = omlb; }
            else { dst = HG; pitch = 512; ct = pn - 8; act = 1; }
            const int col0 = ct * BM + wc * 32 + 8 * fq;
            if (act == 0) ew_store<0>(acc, u, dst, pitch, row0, col0, wr, fr); else if (act == 1) ew_store<1>(acc, u, dst, pitch, row0, col0, wr, fr); else if (act == 2) ew_store<2>(acc, u, dst, pitch, row0, col0, wr, fr); else ew_store<3>(acc, u, dst, pitch, row0, col0, wr, fr, oml);
        } else {
            const bool isv = (pn == 12) && (wc >= 2);
            const bool isq = (pn < 12);
            bf16_t* dst; int pitch, hcol;
            if (isq) { dst = QO; pitch = 512; hcol = (4 * (pn - 10) + wc) * 64; }
            else if (!isv) { dst = KB; pitch = 128; hcol = wc * 64; }
            else { dst = VB; pitch = 128; hcol = (wc - 2) * 64; }
            const float* nw = isq ? qnw : knw; const float osc = isq ? c2 : 1.0f;
            float wgt[2][8];
#pragma unroll
            for (int bj = 0; bj < 2; ++bj)
#pragma unroll
                for (int j = 0; j < 8; ++j) wgt[bj][j] = nw[32 * bj + 8 * fq + j] * osc;
#pragma unroll
            for (int ai = 0; ai < 2; ++ai)
#pragma unroll
                for (int m = 0; m < 4; ++m) {
                    const int row = row0 + ai * HALF + m * 16; const float rs = tab[u.idx * BM + ai * HALF + wr * 64 + m * 16 + fr];
                    float x[2][8]; float ss = 0.f;
#pragma unroll
                    for (int bj = 0; bj < 2; ++bj)
#pragma unroll
                        for (int n = 0; n < 2; ++n)
#pragma unroll
                            for (int i = 0; i < 4; ++i) { const float v = acc[ai][bj][m][n][i] * rs; x[bj][4 * n + i] = v; ss += v * v; }
                    if (!isv) {
                        ss += __shfl_xor(ss, 16); ss += __shfl_xor(ss, 32);
                        const float rn = rsqrtf(ss * (1.0f / 64.0f) + RMS_EPS);
                        const int rpos = row >> 6, cpos = row & 63;
#pragma unroll
                        for (int bj = 0; bj < 2; ++bj) {
                            const f32x2* tab = (bj == 0 ? ropeR + rpos * 16 : ropeC + cpos * 16) + 4 * fq;
#pragma unroll
                            for (int pr = 0; pr < 4; ++pr) {
                                const f32x2 cs = tab[pr];
                                const float a = x[bj][2 * pr] * rn * wgt[bj][2 * pr], b = x[bj][2 * pr + 1] * rn * wgt[bj][2 * pr + 1];
                                x[bj][2 * pr] = a * cs.x - b * cs.y; x[bj][2 * pr + 1] = a * cs.y + b * cs.x;
                            }
                        }
                    }
#pragma unroll
                    for (int bj = 0; bj < 2; ++bj) {
                        u32x4 w; w.x = cvt_pk_bf16(x[bj][0], x[bj][1]); w.y = cvt_pk_bf16(x[bj][2], x[bj][3]); w.z = cvt_pk_bf16(x[bj][4], x[bj][5]); w.w = cvt_pk_bf16(x[bj][6], x[bj][7]);
                        *(u32x4*)(dst + (size_t)row * pitch + hcol + 32 * bj + 8 * fq) = w;
                    }
                }
        }
    }
};

struct EpiUp {
    static constexpr bool PERM = true, AFTER_DRAIN = false, KEEP_ACC = true, LAST_FUSED = true;
    const bf16_t *R, *GB; bf16_t* MX;
    __device__ __forceinline__ void fused(const f32x4 (&acc)[2][2][4][2], const Unit& u, int wr, int wc, int fr, int fq, PG8_LAS unsigned char* lds, int wid, int lane) const {
        constexpr int TP = 260;
        PG8_LAS float* T = (PG8_LAS float*)lds;
        const int pm = u.pm - 64, pn = u.pn - 4;
        const int tid = wid * 64 + lane, rr = tid >> 5, cc = (tid & 31) * 8;
#pragma unroll
        for (int ai = 0; ai < 2; ++ai) {
            const size_t g0 = (size_t)(pm * BM + ai * HALF + rr) * 1024 + pn * BM + cc;
            u32x4 gq[8];
#pragma unroll
            for (int i = 0; i < 8; ++i) gq[i] = *(const u32x4*)(GB + g0 + (size_t)(16 * i) * 1024);
#pragma unroll
            for (int bj = 0; bj < 2; ++bj)
#pragma unroll
                for (int m = 0; m < 4; ++m)
#pragma unroll
                    for (int n = 0; n < 2; ++n) *(PG8_LAS f32x4*)(T + (wr * 64 + 16 * m + fr) * TP + bj * HALF + wc * 32 + 8 * fq + 4 * n) = acc[ai][bj][m][n];
            __syncthreads();
#pragma unroll
            for (int i = 0; i < 8; ++i) {
                const f32x4 a0 = *(const PG8_LAS f32x4*)(T + (rr + 16 * i) * TP + cc), a1 = *(const PG8_LAS f32x4*)(T + (rr + 16 * i) * TP + cc + 4);
                const u32x4 g = gq[i];
                u32x4 o; o.x = cvt_pk_bf16(a0[0] * bf_lo(g.x), a0[1] * bf_hi(g.x)); o.y = cvt_pk_bf16(a0[2] * bf_lo(g.y), a0[3] * bf_hi(g.y)); o.z = cvt_pk_bf16(a1[0] * bf_lo(g.z), a1[1] * bf_hi(g.z)); o.w = cvt_pk_bf16(a1[2] * bf_lo(g.w), a1[3] * bf_hi(g.w));
                *(u32x4*)(MX + g0 + (size_t)(16 * i) * 1024) = o;
            }
            __syncthreads();
        }
    }
    __device__ __forceinline__ bool keep(const Unit& u) const { return u.pn < 4; }
    __device__ __forceinline__ void operator()(f32x4 (&acc)[2][2][4][2], const Unit& u, int wr, int wc, int fr, int fq) const {
        const int z = (u.pn >= 4) ? 1 : 0; const int pm = u.pm - 64 * z, pn = u.pn - 4 * z;
        const bf16_t* G = z ? GB : R;
        const int row0 = pm * BM + wr * 64 + fr, col0 = pn * BM + wc * 32 + 8 * fq;
        u32x4 gq[16];
#define UP_OFF(it) ((size_t)(row0 + ((it) >> 3) * HALF + (((it) >> 1) & 3) * 16) * 1024 + col0 + ((it) & 1) * HALF)
#pragma unroll
        for (int it = 0; it < 4; ++it) gq[it] = *(const u32x4*)(G + UP_OFF(it));
#pragma unroll
        for (int it = 0; it < 16; ++it) {
            const int ai = it >> 3, m = (it >> 1) & 3, bj = it & 1;
            const u32x4 g = gq[it];
            if (it + 4 < 16) gq[it + 4] = *(const u32x4*)(G + UP_OFF(it + 4));
            const f32x4 g0 = {bf_lo(g.x), bf_hi(g.x), bf_lo(g.y), bf_hi(g.y)}, g1 = {bf_lo(g.z), bf_hi(g.z), bf_lo(g.w), bf_hi(g.w)};
            const f32x4 o0 = acc[ai][bj][m][0] * g0, o1 = acc[ai][bj][m][1] * g1;
            if (!z) { acc[ai][bj][m][0] = o0; acc[ai][bj][m][1] = o1; }
            else { u32x4 w; w.x = cvt_pk_bf16(o0[0], o0[1]); w.y = cvt_pk_bf16(o0[2], o0[3]); w.z = cvt_pk_bf16(o1[0], o1[1]); w.w = cvt_pk_bf16(o1[2], o1[3]);
                *(u32x4*)(MX + UP_OFF(it)) = w; }
        }
#undef UP_OFF
    }
};
struct UpOrder {
    StaticOrder so;
    __device__ void init(int G_, int c_) { so.init(16384, 1024, G_, c_); }
    __device__ bool next(int i, Unit& u) const {
        const int rounds = (so.nwg + so.G - 1) / so.G; if (i >= 2 * rounds) return false;
        Unit t; if (!so.next(i >> 1, t)) return false;
        const int z = i & 1; u.pm = t.pm + 64 * z; u.pn = t.pn + 4 * z; u.idx = i; return true;
    }
    __device__ __forceinline__ void a_ready(const Unit&) const {}
    __device__ __forceinline__ void done(const Unit&) const {}
};
template <class Epi, class Sched, bool ALIGN_EPI = false, bool SP2 = false>
__device__ __forceinline__ void gemm_phase(PG8_LAS unsigned char* lds, const Gemm g, const Sched& S, const Epi& E) {
    int tid_ = threadIdx.x; asm volatile("" : "+v"(tid_));
    const int tid = tid_, wid = __builtin_amdgcn_readfirstlane(tid >> 6), lane = tid & 63, wr = wid >> 2, wc = wid & 3, fr = lane & 15, fq = lane >> 4;
    const int K = g.K, nt = K / BK;
    unsigned voffA[2], voffB[2];
#pragma unroll
    for (int i = 0; i < 2; ++i) { int R, C; stage_rc(tid * 16 + i * 8192, R, C); const int Rb = Epi::PERM ? ((R & ~31) + perm32(R & 31)) : R;
        voffA[i] = (unsigned)(R * K + C) * 2u; voffB[i] = (unsigned)(Rb * K + C) * 2u; }
    const size_t kstep = (size_t)(BK * 2);
    const size_t hstep = (size_t)HALF * K * 2;
    const size_t tstep = 2 * hstep;
    const unsigned ldsw = (unsigned)wid * 1024u;
    const int aoff = lds_byte(wr * 64 + fr, fq * 8), boff = lds_byte(wc * 32 + fr, fq * 8);
#define PG8_SA(b, h) (((b) * 2 + (h)) * HTB)
#define PG8_SB(b, h) ((4 + (b) * 2 + (h)) * HTB)
#define PG8_STAGE(bufoff, gbase, voff) do { _Pragma("unroll") for (int _i = 0; _i < 2; ++_i) \
        __builtin_amdgcn_global_load_lds((const unsigned*)((const char*)(gbase) + (voff)[_i]), (PG8_LAS unsigned*)(lds + (bufoff) + ldsw + _i * 8192), 16, 0, 0); } while (0)
#define PG8_LDA(dst, b, h) do { _Pragma("unroll") for (int m = 0; m < 4; ++m) _Pragma("unroll") for (int k = 0; k < 2; ++k) dst[m][k] = *(const PG8_LAS bf16x8*)(lds + PG8_SA(b, h) + aoff + m * 2048 + k * 1024); } while (0)
#define PG8_LDB(dst, b, h) do { _Pragma("unroll") for (int n = 0; n < 2; ++n) _Pragma("unroll") for (int k = 0; k < 2; ++k) dst[n][k] = *(const PG8_LAS bf16x8*)(lds + PG8_SB(b, h) + boff + n * 2048 + k * 1024); } while (0)
#define PG8_MMA(ai, bj, At, Bt) do { __builtin_amdgcn_s_setprio(1); _Pragma("unroll") for (int m = 0; m < 4; ++m) _Pragma("unroll") for (int n = 0; n < 2; ++n) _Pragma("unroll") for (int k = 0; k < 2; ++k) \
        acc[ai][bj][m][n] = __builtin_amdgcn_mfma_f32_16x16x32_bf16(Bt[n][k], At[m][k], acc[ai][bj][m][n], 0, 0, 0); __builtin_amdgcn_s_setprio(0); } while (0)
#define PG8_WAIT_V(n) asm volatile("s_waitcnt vmcnt(" #n ")" ::: "memory")
#define PG8_WAIT_L(n) asm volatile("s_waitcnt lgkmcnt(" #n ")" ::: "memory")
#define PG8_BAR __builtin_amdgcn_s_barrier()
#define PG8_SCHED __builtin_amdgcn_sched_barrier(0)
    Unit cur, nxt; int ui = 0;
    if (!S.next(0, cur)) return;
    f32x4 acc[2][2][4][2];
#pragma unroll
    for (int a = 0; a < 2; ++a)
#pragma unroll
        for (int b = 0; b < 2; ++b)
#pragma unroll
            for (int m = 0; m < 4; ++m)
#pragma unroll
                for (int n = 0; n < 2; ++n) acc[a][b][m][n] = (f32x4){0.f, 0.f, 0.f, 0.f};
    bf16x8 At[4][2], B0[2][2], B1[2][2];
    const char* cA = (const char*)g.A + (size_t)cur.pm * tstep; const char* cB = (const char*)g.Bt + (size_t)cur.pn * tstep;
    S.a_ready(cur);
    if constexpr (SP2) {
        PG8_STAGE(PG8_SB(0, 0), cB, voffB); PG8_STAGE(PG8_SB(0, 1), cB + hstep, voffB); PG8_STAGE(PG8_SA(0, 0), cA, voffA); PG8_STAGE(PG8_SA(0, 1), cA + hstep, voffA);
        if (wr == 1) PG8_BAR;
        PG8_WAIT_V(2); PG8_BAR;
        PG8_STAGE(PG8_SB(1, 0), cB + kstep, voffB); PG8_STAGE(PG8_SB(1, 1), cB + hstep + kstep, voffB);
        PG8_WAIT_V(4); PG8_BAR;
    } else {
        PG8_STAGE(PG8_SB(0, 0), cB, voffB); PG8_STAGE(PG8_SA(0, 0), cA, voffA); PG8_STAGE(PG8_SB(0, 1), cB + hstep, voffB); PG8_STAGE(PG8_SA(0, 1), cA + hstep, voffA);
        if (wr == 1) PG8_BAR;
        PG8_WAIT_V(4); PG8_BAR;
        PG8_STAGE(PG8_SB(1, 0), cB + kstep, voffB); PG8_STAGE(PG8_SA(1, 0), cA + kstep, voffA); PG8_STAGE(PG8_SB(1, 1), cB + hstep + kstep, voffB);
        PG8_WAIT_V(6); PG8_BAR;
    }
    for (;;) {
        const bool has_next = S.next(ui + 1, nxt);
        const char* nA = has_next ? (const char*)g.A + (size_t)nxt.pm * tstep : cA; const char* nB = has_next ? (const char*)g.Bt + (size_t)nxt.pn * tstep : cB;
        for (int t = 0; t < nt; t += 2) {
            const bool last = (t == nt - 2);
            const char* a1 = cA + (size_t)(t + 1) * kstep;
            const char* a2 = last ? nA : cA + (size_t)(t + 2) * kstep; const char* b2 = last ? nB : cB + (size_t)(t + 2) * kstep;
            const char* a3 = a2 + kstep; const char* b3 = b2 + kstep;
            if (last && has_next) S.a_ready(nxt);
            const bool fin = SP2 && last && !has_next;
#define PG8_WVF(nn, nf) do { if (fin) { PG8_WAIT_V(nf); } else { PG8_WAIT_V(nn); } } while (0)
            if constexpr (SP2) {
            PG8_LDB(B0, 0, 0); PG8_LDB(B1, 0, 1); PG8_SCHED; PG8_LDA(At, 0, 0); PG8_STAGE(PG8_SA(1, 0), a1, voffA); PG8_STAGE(PG8_SA(1, 1), a1 + hstep, voffA);
            PG8_WAIT_V(8); PG8_WAIT_L(0); PG8_BAR; PG8_MMA(0, 0, At, B0); PG8_MMA(0, 1, At, B1); PG8_BAR; PG8_SCHED;
            PG8_LDA(At, 0, 1); if (!fin) { PG8_STAGE(PG8_SB(0, 0), b2, voffB); PG8_STAGE(PG8_SB(0, 1), b2 + hstep, voffB); }
            PG8_WVF(6, 2); PG8_WAIT_L(0); PG8_BAR; PG8_MMA(1, 0, At, B0); PG8_MMA(1, 1, At, B1); PG8_BAR; PG8_SCHED;
            PG8_LDB(B0, 1, 0); PG8_LDB(B1, 1, 1); PG8_SCHED; PG8_LDA(At, 1, 0); if (!fin) { PG8_STAGE(PG8_SA(0, 0), a2, voffA); PG8_STAGE(PG8_SA(0, 1), a2 + hstep, voffA); }
            PG8_WVF(8, 0); PG8_WAIT_L(0); PG8_BAR; PG8_MMA(0, 0, At, B0); PG8_MMA(0, 1, At, B1); PG8_BAR; PG8_SCHED;
            PG8_LDA(At, 1, 1); if (!fin) { PG8_STAGE(PG8_SB(1, 0), b3, voffB); PG8_STAGE(PG8_SB(1, 1), b3 + hstep, voffB); }
            PG8_WVF(6, 0); PG8_WAIT_L(0); PG8_BAR; PG8_MMA(1, 0, At, B0); PG8_MMA(1, 1, At, B1); PG8_BAR; PG8_SCHED;
            } else {
            PG8_LDB(B0, 0, 0); PG8_SCHED; PG8_LDA(At, 0, 0); PG8_STAGE(PG8_SA(1, 1), a1 + hstep, voffA);
            PG8_WAIT_L(8); PG8_BAR; PG8_WAIT_L(0); PG8_MMA(0, 0, At, B0); PG8_BAR; PG8_SCHED;
            PG8_LDB(B1, 0, 1); PG8_STAGE(PG8_SB(0, 0), b2, voffB);
            PG8_BAR; PG8_WAIT_L(0); PG8_MMA(0, 1, At, B1); PG8_BAR;
            PG8_LDA(At, 0, 1); PG8_STAGE(PG8_SA(0, 0), a2, voffA);
            PG8_BAR; PG8_WAIT_L(0); PG8_MMA(1, 0, At, B0); PG8_BAR; PG8_SCHED;
            PG8_STAGE(PG8_SB(0, 1), b2 + hstep, voffB);
            PG8_WAIT_V(6); PG8_BAR; PG8_MMA(1, 1, At, B1); PG8_BAR;
            PG8_LDB(B0, 1, 0); PG8_SCHED; PG8_LDA(At, 1, 0); PG8_STAGE(PG8_SA(0, 1), a2 + hstep, voffA);
            PG8_WAIT_L(8); PG8_BAR; PG8_WAIT_L(0); PG8_MMA(0, 0, At, B0); PG8_BAR; PG8_SCHED;
            PG8_LDB(B1, 1, 1); PG8_STAGE(PG8_SB(1, 0), b3, voffB);
            PG8_BAR; PG8_WAIT_L(0); PG8_MMA(0, 1, At, B1); PG8_BAR;
            PG8_LDA(At, 1, 1); PG8_STAGE(PG8_SA(1, 0), a3, voffA);
            PG8_BAR; PG8_WAIT_L(0); PG8_MMA(1, 0, At, B0); PG8_BAR; PG8_SCHED;
            PG8_STAGE(PG8_SB(1, 1), b3 + hstep, voffB);
            PG8_WAIT_V(6); PG8_BAR; PG8_MMA(1, 1, At, B1); PG8_BAR;
            }
        }
        if constexpr (ALIGN_EPI) { if (wr == 0) PG8_BAR; }
        if constexpr (!Epi::AFTER_DRAIN) { if (!(Epi::LAST_FUSED && !has_next)) { E(acc, cur, wr, wc, fr, fq); S.done(cur); } }
        bool keep_acc = false; if constexpr (Epi::KEEP_ACC) keep_acc = E.keep(cur);
        if (!has_next) break;
        if (!keep_acc)
#pragma unroll
        for (int a = 0; a < 2; ++a)
#pragma unroll
            for (int b = 0; b < 2; ++b)
#pragma unroll
                for (int m = 0; m < 4; ++m)
#pragma unroll
                    for (int n = 0; n < 2; ++n) acc[a][b][m][n] = (f32x4){0.f, 0.f, 0.f, 0.f};
        cur = nxt; cA = nA; cB = nB; ++ui;
        if constexpr (ALIGN_EPI) { if (wr == 1) PG8_BAR; }
    }
    PG8_WAIT_V(0);
    if constexpr (!ALIGN_EPI) { if (wr == 0) PG8_BAR; }
    PG8_BAR;
    if constexpr (Epi::AFTER_DRAIN || Epi::LAST_FUSED) { E.fused(acc, cur, wr, wc, fr, fq, lds, wid, lane); S.done(cur); }
#undef PG8_SA
#undef PG8_SB
#undef PG8_STAGE
#undef PG8_LDA
#undef PG8_LDB
#undef PG8_MMA
#undef PG8_WAIT_V
#undef PG8_WAIT_L
#undef PG8_BAR
#undef PG8_SCHED
#undef PG8_WVF
}
}
namespace attn_body {
using bf16=unsigned short;
__device__ __forceinline__ unsigned short f2bf16(float f){unsigned u=__builtin_bit_cast(unsigned,f);return (unsigned short)((u+0x7fffu+((u>>16)&1u))>>16);}
using bf16x8=__attribute__((ext_vector_type(8)))short;
using s16x4=__attribute__((ext_vector_type(4)))short;
using f32x16=__attribute__((ext_vector_type(16)))float;
using u32x4=__attribute__((ext_vector_type(4)))unsigned;
constexpr int D=64,QP=512,KP=128;
constexpr int NW=8,QBLK=32,QB=QBLK*NW,KVBLK=64;
constexpr int NT=258;
constexpr int ATTN_UNIT_ROWS=QB;
__device__ __forceinline__ int crow(int r,int hi){return (r&3)+8*(r>>2)+4*hi;}
#define SBAR() __builtin_amdgcn_sched_barrier(0)
__device__ __forceinline__ void cmask(f32x16&p0,f32x16&p1,int jb){
  const float NEG=-INFINITY;
  if(jb==2){
    #pragma unroll
    for(int r=8;r<16;++r)p0[r]=NEG;
    #pragma unroll
    for(int r=0;r<16;++r)p1[r]=NEG;
  } else if(jb==3){
    #pragma unroll
    for(int r=0;r<16;++r){p0[r]=NEG;p1[r]=NEG;}
  }
}

constexpr int NSLOT=3, SLOTB=8192;
constexpr int LDS_K=0, LDS_V=NSLOT*SLOTB, LDS_WS=2*NSLOT*SLOTB, LDS_OST=LDS_WS+NW*64*4, LDS_BYTES=LDS_OST+NW*4096;
constexpr float C2=0.125f*1.4426950408889634f;
__device__ __forceinline__ void glds16(const void*gsrc,unsigned lds_dst){unsigned keep;
  asm volatile("s_mov_b32 %0, m0\n\ts_mov_b32 m0, %2\n\ts_nop 0\n\tglobal_load_lds_dwordx4 %1, off\n\ts_mov_b32 m0, %0":"=&s"(keep):"v"(gsrc),"s"(lds_dst):"memory");}
__device__ __forceinline__ float max3f(float a,float b,float c){float r;asm("v_max3_f32 %0, %1, %2, %3":"=v"(r):"v"(a),"v"(b),"v"(c));return r;}
__device__ __forceinline__ float max2f(float a,float b){float r;asm("v_max_f32_e32 %0, %1, %2":"=v"(r):"v"(a),"v"(b));return r;}
__device__ __forceinline__ float fadd_s(float a,float b){float r;asm("v_add_f32_e32 %0, %1, %2":"=v"(r):"v"(a),"v"(b));return r;}
__device__ __forceinline__ float fsub_s(float a,float b){float r;asm("v_sub_f32_e32 %0, %1, %2":"=v"(r):"v"(a),"v"(b));return r;}
typedef float f32x2_t __attribute__((ext_vector_type(2))); typedef __bf16 bf16x2_t __attribute__((ext_vector_type(2)));
__device__ __forceinline__ unsigned cvtpk_s(float lo,float hi){f32x2_t v={lo,hi};bf16x2_t b=__builtin_convertvector(v,bf16x2_t);return __builtin_bit_cast(unsigned,b);}
#define WAIT_BAR(N) asm volatile("s_waitcnt vmcnt(" #N ") lgkmcnt(0)\n\ts_barrier":::"memory")

__device__ __forceinline__ void qkt(f32x16&p0,f32x16&p1,const char*Kslot,const bf16x8*qr,const f32x16&negm,int r32,int hi){
  const char*kb=Kslot+hi*1024+r32*16;
  #pragma unroll
  for(int d0=0;d0<4;++d0){
    const bf16x8 b0=*reinterpret_cast<const bf16x8*>(kb+d0*2048);
    const bf16x8 b1=*reinterpret_cast<const bf16x8*>(kb+d0*2048+512);
    if(d0==0){p0=__builtin_amdgcn_mfma_f32_32x32x16_bf16(b0,qr[0],negm,0,0,0);p1=__builtin_amdgcn_mfma_f32_32x32x16_bf16(b1,qr[0],negm,0,0,0);}
    else{p0=__builtin_amdgcn_mfma_f32_32x32x16_bf16(b0,qr[d0],p0,0,0,0);p1=__builtin_amdgcn_mfma_f32_32x32x16_bf16(b1,qr[d0],p1,0,0,0);}}
}
typedef __attribute__((address_space(3))) const char* lds_cptr;
typedef short v4i16_t __attribute__((ext_vector_type(4)));
__device__ __forceinline__ void kload8(bf16x8*kf,lds_cptr kp){
  kf[0]=*(const __attribute__((address_space(3))) bf16x8*)(kp);      kf[1]=*(const __attribute__((address_space(3))) bf16x8*)(kp+512);
  kf[2]=*(const __attribute__((address_space(3))) bf16x8*)(kp+2048); kf[3]=*(const __attribute__((address_space(3))) bf16x8*)(kp+2560);
  kf[4]=*(const __attribute__((address_space(3))) bf16x8*)(kp+4096); kf[5]=*(const __attribute__((address_space(3))) bf16x8*)(kp+4608);
  kf[6]=*(const __attribute__((address_space(3))) bf16x8*)(kp+6144); kf[7]=*(const __attribute__((address_space(3))) bf16x8*)(kp+6656);
}
__device__ __forceinline__ void kload2(bf16x8*kf,lds_cptr kp,int j){ kf[2*j]=*(const __attribute__((address_space(3))) bf16x8*)(kp+j*2048); kf[2*j+1]=*(const __attribute__((address_space(3))) bf16x8*)(kp+j*2048+512); }
__device__ __forceinline__ s16x4 vtr(lds_cptr p){ return __builtin_bit_cast(s16x4,__builtin_amdgcn_ds_read_tr16_b64_v4i16((__attribute__((address_space(3))) v4i16_t*)p)); }
__device__ __forceinline__ float rowmax(const f32x16&p0,const f32x16&p1){
  float a=max3f(p0[0],p0[1],p1[0]),b=max3f(p0[2],p0[3],p1[1]);a=max3f(a,p1[2],p1[3]);
  #pragma unroll
  for(int r=4;r<16;r+=4){a=max3f(a,p0[r],p0[r+1]);b=max3f(b,p0[r+2],p0[r+3]);a=max3f(a,p1[r],p1[r+1]);b=max3f(b,p1[r+2],p1[r+3]);}
  const float m=max2f(a,b);
  auto rr=__builtin_amdgcn_permlane32_swap(__float_as_uint(m),__float_as_uint(m),false,false);
  return max2f(__uint_as_float(rr[0]),__uint_as_float(rr[1]));
}
__device__ __forceinline__ void pv(f32x16*o,int vb,bf16x8 pa0,bf16x8 pa1,bf16x8 pa2,bf16x8 pa3){
  #pragma unroll
  for(int d0=0;d0<2;++d0){s16x4 lo[4],hi[4];
    #pragma unroll
    for(int ks=0;ks<4;++ks){
      asm volatile("ds_read_b64_tr_b16 %0,%1 offset:%c2":"=&v"(lo[ks]):"v"(vb),"i"(d0*4096+ks*1024):"memory");
      asm volatile("ds_read_b64_tr_b16 %0,%1 offset:%c2":"=&v"(hi[ks]):"v"(vb),"i"(d0*4096+ks*1024+512):"memory");}
    asm volatile("s_waitcnt lgkmcnt(0)":::"memory");SBAR();
    #define PK(k) (bf16x8){lo[k][0],lo[k][1],lo[k][2],lo[k][3],hi[k][0],hi[k][1],hi[k][2],hi[k][3]}
    o[d0]=__builtin_amdgcn_mfma_f32_32x32x16_bf16(pa0,PK(0),o[d0],0,0,0);
    o[d0]=__builtin_amdgcn_mfma_f32_32x32x16_bf16(pa1,PK(1),o[d0],0,0,0);
    o[d0]=__builtin_amdgcn_mfma_f32_32x32x16_bf16(pa2,PK(2),o[d0],0,0,0);
    o[d0]=__builtin_amdgcn_mfma_f32_32x32x16_bf16(pa3,PK(3),o[d0],0,0,0);
    #undef PK
  }
}

#ifndef ATTN_STORE16
#define ATTN_STORE16(p,v) (*(u32x4*)(p)=(v))
#endif
template<int THRL> __device__ __forceinline__ void attn_unit(int h,int qb,const bf16*Q,const bf16*__restrict__ K,const bf16*__restrict__ V,bf16*O,char*shm){
  int tid_=threadIdx.x; asm volatile("":"+v"(tid_));
  const int tid=tid_,lane=tid&63,r32=lane&31,hi=lane>>5; const int wid=__builtin_amdgcn_readfirstlane(tid>>6);
  const int q0=qb*QB; const int kvh=h>>2;
  const bf16*Qw=Q+(long)(q0+wid*QBLK)*QP+h*D;
  const bf16*Kh=K+kvh*D,*Vh=V+kvh*D;
  const unsigned lds0=(unsigned)(uintptr_t)shm;
  float*wsf=(float*)(shm+LDS_WS)+wid*64;
  const bf16*ksrc=Kh+(long)lane*KP+wid*8;
  const bf16*vsrc=Vh+(long)(16*(wid&3)+(lane>>2))*KP+(wid>>2)*32+(lane&3)*8;
  const unsigned kdst=lds0+LDS_K+wid*1024, vdst=lds0+LDS_V+wid*1024;
  #define DMA_K(t,slot) glds16(ksrc+(long)(t)*KVBLK*KP,(unsigned)__builtin_amdgcn_readfirstlane(kdst+(slot)))
  #define DMA_V(t,slot) glds16(vsrc+(long)(t)*KVBLK*KP,(unsigned)__builtin_amdgcn_readfirstlane(vdst+(slot)))
  const int vb0=(int)(lds0+LDS_V)+((lane>>4)&1)*32+(lane&3)*8+(4*hi+((lane&15)>>2))*64;
  const char*Kbase=shm+LDS_K; bf16x8 kf[8];
  const lds_cptr shm3=(lds_cptr)shm; const lds_cptr kp0=shm3+LDS_K+hi*1024+r32*16; const lds_cptr vp0=shm3+LDS_V+((lane>>4)&1)*32+(lane&3)*8+(4*hi+((lane&15)>>2))*64;
  DMA_K(0,0);DMA_V(0,0);DMA_K(1,SLOTB);
  bf16x8 qr[4];
  #pragma unroll
  for(int d0=0;d0<4;++d0)qr[d0]=*reinterpret_cast<const bf16x8*>(&Qw[(long)r32*QP+d0*16+hi*8]);
  float mhat=0.f,l_reg=0.f;f32x16 o[2];o[0]=f32x16{};o[1]=f32x16{};f32x16 negm=f32x16{};asm volatile("":"+v"(negm));
  #define CMASK(P0,P1,t) do{int jb_=(t)-(NT-4); if(jb_>=2)cmask(P0,P1,jb_);}while(0)
  bool resc=false;
  #define START(P0,P1) do{ const float rm=rowmax(P0,P1); resc=false; \
    { const float dl=rm; mhat=fadd_s(mhat,dl); \
      _Pragma("unroll") for(int r=0;r<16;++r){P0[r]=fsub_s(P0[r],dl);P1[r]=fsub_s(P1[r],dl);} \
      _Pragma("unroll") for(int r=0;r<16;++r)negm[r]=-mhat; asm volatile("":"+v"(negm)); } \
    _Pragma("unroll") for(int r=0;r<16;++r)P0[r]=__builtin_amdgcn_exp2f(P0[r]); }while(0)
  #define RESC() do{ if(resc){ asm volatile("s_waitcnt lgkmcnt(0)":::"memory"); \
      _Pragma("unroll") for(int d_=0;d_<2;++d_) _Pragma("unroll") for(int r=0;r<16;++r)o[d_][r]*=wsf[crow(r,hi)]; } }while(0)
  f32x16 pA0,pA1,pB0,pB1;
  int sl_prev=0,sl_cur=0,sl_next=SLOTB;
  #define ROT() do{sl_prev=sl_cur;sl_cur=sl_next;sl_next=(sl_next==(NSLOT-1)*SLOTB)?0:sl_next+SLOTB;}while(0)
  DMA_K(2,2*SLOTB);
  WAIT_BAR(3);
  qkt(pA0,pA1,Kbase,qr,negm,r32,hi);asm volatile("s_nop 15\n\ts_nop 7":"+v"(pA0),"+v"(pA1));CMASK(pA0,pA1,0);
  START(pA0,pA1);
  _Pragma("unroll") for(int r=0;r<16;++r)pA1[r]=__builtin_amdgcn_exp2f(pA1[r]);
  WAIT_BAR(0);
  DMA_K(3,0);DMA_V(1,SLOTB);
  ROT();
  kload8(kf,kp0+sl_cur);
  WAIT_BAR(2);
  s16x4 vlo[8],vhi[8]; u32x4 pw0,pw1,pw2,pw3;
  #define PKW(P,B) cvtpk_s(P[B],P[B+1])
  #define PAF(k) __builtin_bit_cast(bf16x8,pw##k)
  #define VFR(i) (bf16x8){vlo[i][0],vlo[i][1],vlo[i][2],vlo[i][3],vhi[i][0],vhi[i][1],vhi[i][2],vhi[i][3]}
  #define PIN(x) asm volatile("":"+v"(x))
  #define MX3(a,b,c) __builtin_fmaxf(__builtin_fmaxf((a),(b)),(c))
  #define GAPA(MF,A0,A1,A2,A3,W0,W1,PW) do{ MF; sacc+=A0; sacc+=A1; sacc+=A2; sacc+=A3; PIN(sacc); W0; W1; PIN(PW); SBAR(); }while(0)
  #define EX(v) __builtin_amdgcn_exp2f(v)
  #define GAPB(MF,X,B) do{ MF; X[B]=EX(X[B]); X[B+1]=EX(X[B+1]); X[B+2]=EX(X[B+2]); X[B+3]=EX(X[B+3]); PIN(X); SBAR(); }while(0)
  #define VRD(i) do{ vlo[i]=vtr(vp_+(((i)>>2)*4096+((i)&3)*1024)); vhi[i]=vtr(vp_+(((i)>>2)*4096+((i)&3)*1024+512)); }while(0)
  #define KRD(G,j) do{ if(G){ kload2(kf,kp0+sl_next,j); SBAR(); } }while(0)
  #define STEP(C0,C1,P0,P1,t,GK,GV,GL) do{ SBAR(); \
    const lds_cptr vp_=vp0+sl_prev; \
    VRD(0); SBAR(); float sacc=(P0[0]+P0[1]); \
    GAPA(C0=__builtin_amdgcn_mfma_f32_32x32x16_bf16(kf[0],qr[0],negm,0,0,0), P0[2],P0[3],P0[4],P0[5],     pw0[0]=PKW(P0,0), pw0[1]=PKW(P0,2), pw0); \
    VRD(4); SBAR(); GAPA(C1=__builtin_amdgcn_mfma_f32_32x32x16_bf16(kf[1],qr[0],negm,0,0,0), P0[6],P0[7],P0[8],P0[9],     pw0[2]=PKW(P0,4), pw0[3]=PKW(P0,6), pw0); \
    VRD(1); SBAR(); GAPA(C0=__builtin_amdgcn_mfma_f32_32x32x16_bf16(kf[2],qr[1],C0,0,0,0),   P0[10],P0[11],P0[12],P0[13], pw1[0]=PKW(P0,8), pw1[1]=PKW(P0,10), pw1); \
    VRD(5); SBAR(); GAPA(C1=__builtin_amdgcn_mfma_f32_32x32x16_bf16(kf[3],qr[1],C1,0,0,0),   P0[14],P0[15],P1[0],P1[1],   pw1[2]=PKW(P0,12),pw1[3]=PKW(P0,14), pw1); \
    VRD(2); SBAR(); GAPA(C0=__builtin_amdgcn_mfma_f32_32x32x16_bf16(kf[4],qr[2],C0,0,0,0),   P1[2],P1[3],P1[4],P1[5],     pw2[0]=PKW(P1,0), pw2[1]=PKW(P1,2), pw2); \
    VRD(6); SBAR(); GAPA(C1=__builtin_amdgcn_mfma_f32_32x32x16_bf16(kf[5],qr[2],C1,0,0,0),   P1[6],P1[7],P1[8],P1[9],     pw2[2]=PKW(P1,4), pw2[3]=PKW(P1,6), pw2); \
    VRD(3); SBAR(); GAPA(C0=__builtin_amdgcn_mfma_f32_32x32x16_bf16(kf[6],qr[3],C0,0,0,0),   P1[10],P1[11],P1[12],P1[13], pw3[0]=PKW(P1,8), pw3[1]=PKW(P1,10), pw3); \
    VRD(7); SBAR(); GAPA(C1=__builtin_amdgcn_mfma_f32_32x32x16_bf16(kf[7],qr[3],C1,0,0,0),   P1[14],P1[15],0.f,0.f,       pw3[2]=PKW(P1,12),pw3[3]=PKW(P1,14), pw3); \
    l_reg+=sacc; \
    if(GK){DMA_K((t)+3,sl_cur);} if(GV){DMA_V((t)+1,sl_next);} \
    CMASK(C0,C1,t); \
    { float a=MX3(C0[0],C0[1],C1[0]),b=MX3(C0[2],C0[3],C1[1]); a=MX3(a,C1[2],C1[3]); \
      _Pragma("unroll") for(int r=4;r<16;r+=4){a=MX3(a,C0[r],C0[r+1]);b=MX3(b,C0[r+2],C0[r+3]);a=MX3(a,C1[r],C1[r+1]);b=MX3(b,C1[r+2],C1[r+3]);} \
      float rm=__builtin_fmaxf(a,b); { auto rr=__builtin_amdgcn_permlane32_swap(__float_as_uint(rm),__float_as_uint(rm),false,false); rm=__builtin_fmaxf(__uint_as_float(rr[0]),__uint_as_float(rr[1])); } \
      resc=false; \
      if(__builtin_expect(__any(rm>(float)THRL),0)){ const float dl=__builtin_fmaxf(rm,0.f); mhat+=dl; \
        _Pragma("unroll") for(int r=0;r<16;++r){C0[r]-=dl;C1[r]-=dl;} \
        _Pragma("unroll") for(int r=0;r<16;++r)negm[r]=-mhat; asm volatile("":"+v"(negm)); \
        const float f=__builtin_amdgcn_exp2f(-dl); l_reg*=f; if(hi==0)wsf[r32]=f; resc=true; } } \
    SBAR(); \
    GAPB(o[0]=__builtin_amdgcn_mfma_f32_32x32x16_bf16(PAF(0),VFR(0),o[0],0,0,0), C0,0); \
    GAPB(o[1]=__builtin_amdgcn_mfma_f32_32x32x16_bf16(PAF(0),VFR(4),o[1],0,0,0), C0,4); \
    KRD(GL,0); GAPB(o[0]=__builtin_amdgcn_mfma_f32_32x32x16_bf16(PAF(1),VFR(1),o[0],0,0,0), C0,8); \
    KRD(GL,1); GAPB(o[1]=__builtin_amdgcn_mfma_f32_32x32x16_bf16(PAF(1),VFR(5),o[1],0,0,0), C0,12); \
    KRD(GL,2); GAPB(o[0]=__builtin_amdgcn_mfma_f32_32x32x16_bf16(PAF(2),VFR(2),o[0],0,0,0), C1,0); \
    KRD(GL,3); GAPB(o[1]=__builtin_amdgcn_mfma_f32_32x32x16_bf16(PAF(2),VFR(6),o[1],0,0,0), C1,4); \
    GAPB(o[0]=__builtin_amdgcn_mfma_f32_32x32x16_bf16(PAF(3),VFR(3),o[0],0,0,0), C1,8); \
    GAPB(o[1]=__builtin_amdgcn_mfma_f32_32x32x16_bf16(PAF(3),VFR(7),o[1],0,0,0), C1,12); \
    }while(0)
  int t=1;
  #undef CMASK
  #define CMASK(P0,P1,t) do{}while(0)
  for(;t+5<NT;t+=2){
    STEP(pB0,pB1,pA0,pA1,t,true,true,true);     WAIT_BAR(2); RESC(); ROT();
    STEP(pA0,pA1,pB0,pB1,t+1,true,true,true);   WAIT_BAR(2); RESC(); ROT();
  }
  #undef CMASK
  #define CMASK(P0,P1,t) do{int jb_=(t)-(NT-4); if(jb_>=2)cmask(P0,P1,jb_);}while(0)
  #define ENDW(tt) do{ if((tt)+3<NT){WAIT_BAR(2);} else if((tt)+2<NT){WAIT_BAR(1);} else {WAIT_BAR(0);} }while(0)
  for(;t+1<NT;t+=2){
    STEP(pB0,pB1,pA0,pA1,t,(t+3<NT),(t+1<NT),(t+1<NT));       ENDW(t);   RESC(); ROT();
    STEP(pA0,pA1,pB0,pB1,t+1,(t+4<NT),(t+2<NT),(t+2<NT));     ENDW(t+1); RESC(); ROT();
  }
  STEP(pB0,pB1,pA0,pA1,NT-1,false,false,false); RESC();
  { float sacc=pB0[0]+pB0[1]; _Pragma("unroll") for(int r=2;r<16;++r)sacc+=pB0[r]; _Pragma("unroll") for(int r=0;r<16;++r)sacc+=pB1[r]; l_reg+=sacc;
    pw0=(u32x4){PKW(pB0,0),PKW(pB0,2),PKW(pB0,4),PKW(pB0,6)};pw1=(u32x4){PKW(pB0,8),PKW(pB0,10),PKW(pB0,12),PKW(pB0,14)};pw2=(u32x4){PKW(pB1,0),PKW(pB1,2),PKW(pB1,4),PKW(pB1,6)};pw3=(u32x4){PKW(pB1,8),PKW(pB1,10),PKW(pB1,12),PKW(pB1,14)};
    SBAR(); pv(o,vb0+sl_cur,PAF(0),PAF(1),PAF(2),PAF(3)); }
  #undef PKW
  #undef PAF
  #undef VFR
  #undef PIN
  #undef MX3
  #undef GAPA
  #undef GAPB
  #undef EX
  #undef VRD
  #undef KRD
  #undef STEP
  #undef ENDW
  {auto rr=__builtin_amdgcn_permlane32_swap(__float_as_uint(l_reg),__float_as_uint(l_reg),false,false);l_reg=__uint_as_float(rr[0])+__uint_as_float(rr[1]);}
  if(hi==0)wsf[32+r32]=l_reg;asm volatile("s_waitcnt lgkmcnt(0)":::"memory");
  float rli[16];
  #pragma unroll
  for(int r=0;r<16;++r)rli[r]=__builtin_amdgcn_rcpf(wsf[32+crow(r,hi)]);
  bf16*Ow=O+(long)(q0+wid*QBLK)*QP+h*D;
  { bf16*stg=(bf16*)(shm+LDS_OST)+wid*2048;
    #pragma unroll
    for(int r=0;r<16;++r){const int orow=crow(r,hi);
      #pragma unroll
      for(int d0=0;d0<2;++d0)stg[orow*64+d0*32+r32]=f2bf16(o[d0][r]*rli[r]);}
    asm volatile("s_waitcnt lgkmcnt(0)":::"memory");
    #pragma unroll
    for(int i=0;i<4;++i){const int row=i*8+(lane>>3),ch=lane&7; const u32x4 v=*(const u32x4*)(stg+row*64+ch*8); ATTN_STORE16(Ow+(long)row*QP+ch*8,v);} }
  asm volatile("s_waitcnt lgkmcnt(0)\n\ts_barrier":::"memory");
  #undef DMA_K
  #undef DMA_V
  #undef CMASK
  #undef START
  #undef RESC
  #undef ROT
}
__device__ __forceinline__ void attn_unit_fixed(float mref,int h,int qb,const bf16*Q,const bf16*__restrict__ K,const bf16*__restrict__ V,bf16*O,char*shm){
  int tid_=threadIdx.x; asm volatile("":"+v"(tid_));
  const int tid=tid_,lane=tid&63,r32=lane&31,hi=lane>>5; const int wid=__builtin_amdgcn_readfirstlane(tid>>6);
  const int q0=qb*QB; const int kvh=h>>2;
  const bf16*Qw=Q+(long)(q0+wid*QBLK)*QP+h*D;
  const bf16*Kh=K+kvh*D,*Vh=V+kvh*D;
  const unsigned lds0=(unsigned)(uintptr_t)shm;
  float*wsf=(float*)(shm+LDS_WS)+wid*64;
  const bf16*ksrc=Kh+(long)lane*KP+wid*8;
  const bf16*vsrc=Vh+(long)(16*(wid&3)+(lane>>2))*KP+(wid>>2)*32+(lane&3)*8;
  const unsigned kdst=lds0+LDS_K+wid*1024, vdst=lds0+LDS_V+wid*1024;
  #define DMA_K(t,slot) glds16(ksrc+(long)(t)*KVBLK*KP,(unsigned)__builtin_amdgcn_readfirstlane(kdst+(slot)))
  #define DMA_V(t,slot) glds16(vsrc+(long)(t)*KVBLK*KP,(unsigned)__builtin_amdgcn_readfirstlane(vdst+(slot)))
  const int vb0=(int)(lds0+LDS_V)+((lane>>4)&1)*32+(lane&3)*8+(4*hi+((lane&15)>>2))*64;
  const char*Kbase=shm+LDS_K; bf16x8 kf[8];
  const lds_cptr shm3=(lds_cptr)shm; const lds_cptr kp0=shm3+LDS_K+hi*1024+r32*16; const lds_cptr vp0=shm3+LDS_V+((lane>>4)&1)*32+(lane&3)*8+(4*hi+((lane&15)>>2))*64;
  DMA_K(0,0);DMA_V(0,0);DMA_K(1,SLOTB);
  bf16x8 qr[4];
  #pragma unroll
  for(int d0=0;d0<4;++d0)qr[d0]=*reinterpret_cast<const bf16x8*>(&Qw[(long)r32*QP+d0*16+hi*8]);
  f32x16 o[2];o[0]=f32x16{};o[1]=f32x16{};float l_reg=0.f;f32x16 negm;
  #pragma unroll
  for(int r=0;r<16;++r)negm[r]=-mref;
  asm volatile("":"+v"(negm));
  #define CMASK(P0,P1,t) do{int jb_=(t)-(NT-4); if(jb_>=2)cmask(P0,P1,jb_);}while(0)
  #define START(P0,P1) do{ _Pragma("unroll") for(int r=0;r<16;++r)P0[r]=__builtin_amdgcn_exp2f(P0[r]); }while(0)
  f32x16 pA0,pA1,pB0,pB1;
  int sl_prev=0,sl_cur=0,sl_next=SLOTB;
  #define ROT() do{sl_prev=sl_cur;sl_cur=sl_next;sl_next=(sl_next==(NSLOT-1)*SLOTB)?0:sl_next+SLOTB;}while(0)
  DMA_K(2,2*SLOTB);
  WAIT_BAR(3);
  qkt(pA0,pA1,Kbase,qr,negm,r32,hi);asm volatile("s_nop 15\n\ts_nop 7":"+v"(pA0),"+v"(pA1));CMASK(pA0,pA1,0);
  START(pA0,pA1);
  _Pragma("unroll") for(int r=0;r<16;++r)pA1[r]=__builtin_amdgcn_exp2f(pA1[r]);
  WAIT_BAR(0);
  DMA_K(3,0);DMA_V(1,SLOTB);
  ROT();
  kload8(kf,kp0+sl_cur);
  WAIT_BAR(2);
  s16x4 vlo[8],vhi[8]; u32x4 pw0,pw1,pw2,pw3;
  #define PKW(P,B) cvtpk_s(P[B],P[B+1])
  #define PAF(k) __builtin_bit_cast(bf16x8,pw##k)
  #define VFR(i) (bf16x8){vlo[i][0],vlo[i][1],vlo[i][2],vlo[i][3],vhi[i][0],vhi[i][1],vhi[i][2],vhi[i][3]}
  #define PIN(x) asm volatile("":"+v"(x))
  #define MX3(a,b,c) __builtin_fmaxf(__builtin_fmaxf((a),(b)),(c))
  #define GAPA(MF,A0,A1,A2,A3,W0,W1,PW) do{ MF; sacc+=A0; sacc+=A1; sacc+=A2; sacc+=A3; PIN(sacc); W0; W1; PIN(PW); SBAR(); }while(0)
  #define EX(v) __builtin_amdgcn_exp2f(v)
  #define GAPB(MF,X,B) do{ MF; X[B]=EX(X[B]); X[B+1]=EX(X[B+1]); X[B+2]=EX(X[B+2]); X[B+3]=EX(X[B+3]); PIN(X); SBAR(); }while(0)
  #define VRD(i) do{ vlo[i]=vtr(vp_+(((i)>>2)*4096+((i)&3)*1024)); vhi[i]=vtr(vp_+(((i)>>2)*4096+((i)&3)*1024+512)); }while(0)
  #define KRD(G,j) do{ if(G){ kload2(kf,kp0+sl_next,j); SBAR(); } }while(0)
  #define STEP(C0,C1,P0,P1,t,GK,GV,GL) do{ SBAR(); \
    if(GK){DMA_K((t)+3,sl_cur);} if(GV){DMA_V((t)+1,sl_next);} \
    const lds_cptr vp_=vp0+sl_prev; \
    VRD(0); SBAR(); float sacc=(P0[0]+P0[1]); \
    GAPA(C0=__builtin_amdgcn_mfma_f32_32x32x16_bf16(kf[0],qr[0],negm,0,0,0), P0[2],P0[3],P0[4],P0[5],     pw0[0]=PKW(P0,0), pw0[1]=PKW(P0,2), pw0); \
    VRD(4); SBAR(); GAPA(C1=__builtin_amdgcn_mfma_f32_32x32x16_bf16(kf[1],qr[0],negm,0,0,0), P0[6],P0[7],P0[8],P0[9],     pw0[2]=PKW(P0,4), pw0[3]=PKW(P0,6), pw0); \
    VRD(1); SBAR(); GAPA(C0=__builtin_amdgcn_mfma_f32_32x32x16_bf16(kf[2],qr[1],C0,0,0,0),   P0[10],P0[11],P0[12],P0[13], pw1[0]=PKW(P0,8), pw1[1]=PKW(P0,10), pw1); \
    VRD(5); SBAR(); GAPA(C1=__builtin_amdgcn_mfma_f32_32x32x16_bf16(kf[3],qr[1],C1,0,0,0),   P0[14],P0[15],P1[0],P1[1],   pw1[2]=PKW(P0,12),pw1[3]=PKW(P0,14), pw1); \
    VRD(2); SBAR(); GAPA(C0=__builtin_amdgcn_mfma_f32_32x32x16_bf16(kf[4],qr[2],C0,0,0,0),   P1[2],P1[3],P1[4],P1[5],     pw2[0]=PKW(P1,0), pw2[1]=PKW(P1,2), pw2); \
    VRD(6); SBAR(); GAPA(C1=__builtin_amdgcn_mfma_f32_32x32x16_bf16(kf[5],qr[2],C1,0,0,0),   P1[6],P1[7],P1[8],P1[9],     pw2[2]=PKW(P1,4), pw2[3]=PKW(P1,6), pw2); \
    VRD(3); SBAR(); GAPA(C0=__builtin_amdgcn_mfma_f32_32x32x16_bf16(kf[6],qr[3],C0,0,0,0),   P1[10],P1[11],P1[12],P1[13], pw3[0]=PKW(P1,8), pw3[1]=PKW(P1,10), pw3); \
    VRD(7); SBAR(); GAPA(C1=__builtin_amdgcn_mfma_f32_32x32x16_bf16(kf[7],qr[3],C1,0,0,0),   P1[14],P1[15],0.f,0.f,       pw3[2]=PKW(P1,12),pw3[3]=PKW(P1,14), pw3); \
    l_reg+=sacc; \
    CMASK(C0,C1,t); \
    SBAR(); \
    GAPB(o[0]=__builtin_amdgcn_mfma_f32_32x32x16_bf16(PAF(0),VFR(0),o[0],0,0,0), C0,0); \
    GAPB(o[1]=__builtin_amdgcn_mfma_f32_32x32x16_bf16(PAF(0),VFR(4),o[1],0,0,0), C0,4); \
    KRD(GL,0); GAPB(o[0]=__builtin_amdgcn_mfma_f32_32x32x16_bf16(PAF(1),VFR(1),o[0],0,0,0), C0,8); \
    KRD(GL,1); GAPB(o[1]=__builtin_amdgcn_mfma_f32_32x32x16_bf16(PAF(1),VFR(5),o[1],0,0,0), C0,12); \
    KRD(GL,2); GAPB(o[0]=__builtin_amdgcn_mfma_f32_32x32x16_bf16(PAF(2),VFR(2),o[0],0,0,0), C1,0); \
    KRD(GL,3); GAPB(o[1]=__builtin_amdgcn_mfma_f32_32x32x16_bf16(PAF(2),VFR(6),o[1],0,0,0), C1,4); \
    GAPB(o[0]=__builtin_amdgcn_mfma_f32_32x32x16_bf16(PAF(3),VFR(3),o[0],0,0,0), C1,8); \
    GAPB(o[1]=__builtin_amdgcn_mfma_f32_32x32x16_bf16(PAF(3),VFR(7),o[1],0,0,0), C1,12); \
    }while(0)
  int t=1;
  #undef CMASK
  #define CMASK(P0,P1,t) do{}while(0)
  for(;t+5<NT;t+=2){
    STEP(pB0,pB1,pA0,pA1,t,true,true,true);     WAIT_BAR(2); ROT();
    STEP(pA0,pA1,pB0,pB1,t+1,true,true,true);   WAIT_BAR(2); ROT();
  }
  #undef CMASK
  #define CMASK(P0,P1,t) do{int jb_=(t)-(NT-4); if(jb_>=2)cmask(P0,P1,jb_);}while(0)
  #define ENDW(tt) do{ if((tt)+3<NT){WAIT_BAR(2);} else if((tt)+2<NT){WAIT_BAR(1);} else {WAIT_BAR(0);} }while(0)
  for(;t+1<NT;t+=2){
    STEP(pB0,pB1,pA0,pA1,t,(t+3<NT),(t+1<NT),(t+1<NT));       ENDW(t);   ROT();
    STEP(pA0,pA1,pB0,pB1,t+1,(t+4<NT),(t+2<NT),(t+2<NT));     ENDW(t+1); ROT();
  }
  STEP(pB0,pB1,pA0,pA1,NT-1,false,false,false);
  {
    pw0=(u32x4){PKW(pB0,0),PKW(pB0,2),PKW(pB0,4),PKW(pB0,6)};pw1=(u32x4){PKW(pB0,8),PKW(pB0,10),PKW(pB0,12),PKW(pB0,14)};pw2=(u32x4){PKW(pB1,0),PKW(pB1,2),PKW(pB1,4),PKW(pB1,6)};pw3=(u32x4){PKW(pB1,8),PKW(pB1,10),PKW(pB1,12),PKW(pB1,14)};
    { float sacc=pB0[0]+pB0[1]; _Pragma("unroll") for(int r=2;r<16;++r)sacc+=pB0[r]; _Pragma("unroll") for(int r=0;r<16;++r)sacc+=pB1[r]; l_reg+=sacc; }
    SBAR(); pv(o,vb0+sl_cur,PAF(0),PAF(1),PAF(2),PAF(3)); }
  #undef PKW
  #undef PAF
  #undef VFR
  #undef PIN
  #undef MX3
  #undef GAPA
  #undef GAPB
  #undef EX
  #undef VRD
  #undef KRD
  #undef STEP
  #undef ENDW
  {auto rr=__builtin_amdgcn_permlane32_swap(__float_as_uint(l_reg),__float_as_uint(l_reg),false,false);l_reg=__uint_as_float(rr[0])+__uint_as_float(rr[1]);}
  if(hi==0)wsf[32+r32]=l_reg;asm volatile("s_waitcnt lgkmcnt(0)":::"memory");
  float rli[16];
  #pragma unroll
  for(int r=0;r<16;++r)rli[r]=__builtin_amdgcn_rcpf(wsf[32+crow(r,hi)]);
  bf16*Ow=O+(long)(q0+wid*QBLK)*QP+h*D;
  { bf16*stg=(bf16*)(shm+LDS_OST)+wid*2048;
    #pragma unroll
    for(int r=0;r<16;++r){const int orow=crow(r,hi);
      #pragma unroll
      for(int d0=0;d0<2;++d0)stg[orow*64+d0*32+r32]=f2bf16(o[d0][r]*rli[r]);}
    asm volatile("s_waitcnt lgkmcnt(0)":::"memory");
    #pragma unroll
    for(int i=0;i<4;++i){const int row=i*8+(lane>>3),ch=lane&7; const u32x4 v=*(const u32x4*)(stg+row*64+ch*8); ATTN_STORE16(Ow+(long)row*QP+ch*8,v);} }
  asm volatile("s_waitcnt lgkmcnt(0)\n\ts_barrier":::"memory");
  #undef DMA_K
  #undef DMA_V
  #undef CMASK
  #undef START
  #undef ROT
}


__device__ __forceinline__ void attn_unit_fixed2(float mref,int h,int qb,const bf16*Q,const bf16*__restrict__ K,const bf16*__restrict__ V,bf16*O,char*shm){
  constexpr int NT=257;
  int tid_=threadIdx.x; asm volatile("":"+v"(tid_));
  const int tid=tid_,lane=tid&63,r32=lane&31,hi=lane>>5; const int wid=__builtin_amdgcn_readfirstlane(tid>>6);
  const int q0=qb*QB; const int kvh=h>>2;
  constexpr int NS2=4, LDS_V2=NS2*SLOTB, LDS_WS2=2*NS2*SLOTB, LDS_OST2=LDS_WS2+NW*64*4;
  const bf16*Qw=Q+(long)(q0+wid*QBLK)*QP+h*D;
  const bf16*Kh=K+kvh*D,*Vh=V+kvh*D;
  const unsigned lds0=(unsigned)(uintptr_t)shm;
  float*wsf=(float*)(shm+LDS_WS2)+wid*64;
  const bf16*ksrc=Kh+(long)lane*KP+wid*8;
  const bf16*vsrc=Vh+(long)(16*(wid&3)+(lane>>2))*KP+(wid>>2)*32+(lane&3)*8;
  const unsigned kdst=lds0+LDS_K+wid*1024, vdst=lds0+LDS_V2+wid*1024;
  #define DMA_K(t,slot) glds16(ksrc+(long)(t)*KVBLK*KP,(unsigned)__builtin_amdgcn_readfirstlane(kdst+(slot)))
  #define DMA_V(t,slot) glds16(vsrc+(long)(t)*KVBLK*KP,(unsigned)__builtin_amdgcn_readfirstlane(vdst+(slot)))
  const int vb0=(int)(lds0+LDS_V2)+((lane>>4)&1)*32+(lane&3)*8+(4*hi+((lane&15)>>2))*64;
  const char*Kbase=shm+LDS_K; bf16x8 kf[8];
  const lds_cptr shm3=(lds_cptr)shm; const lds_cptr kp0=shm3+LDS_K+hi*1024+r32*16; const lds_cptr vp0=shm3+LDS_V2+((lane>>4)&1)*32+(lane&3)*8+(4*hi+((lane&15)>>2))*64;
  DMA_K(0,0);DMA_V(0,0);DMA_K(1,SLOTB);
  bf16x8 qr[4];
  #pragma unroll
  for(int d0=0;d0<4;++d0)qr[d0]=*reinterpret_cast<const bf16x8*>(&Qw[(long)r32*QP+d0*16+hi*8]);
  f32x16 o[2];o[0]=f32x16{};o[1]=f32x16{};float l_reg=0.f;f32x16 negm;
  #pragma unroll
  for(int r=0;r<16;++r)negm[r]=-mref;
  asm volatile("":"+v"(negm));
  #define CMASK(P0,P1,t) do{ if((t)==NT-1)cmask(P0,P1,2); }while(0)
  #define START(P0,P1) do{ _Pragma("unroll") for(int r=0;r<16;++r)P0[r]=__builtin_amdgcn_exp2f(P0[r]); }while(0)
  f32x16 pA0,pA1,pB0,pB1;
  int sl_prev=0,sl_cur=0,sl_next=SLOTB;
  #define ROT() do{sl_prev=sl_cur;sl_cur=sl_next;sl_next=(sl_next==(NS2-1)*SLOTB)?0:sl_next+SLOTB;}while(0)
  DMA_K(2,2*SLOTB);DMA_K(3,3*SLOTB);DMA_V(1,SLOTB);
  WAIT_BAR(5);
  qkt(pA0,pA1,Kbase,qr,negm,r32,hi);asm volatile("s_nop 15\n\ts_nop 7":"+v"(pA0),"+v"(pA1));CMASK(pA0,pA1,0);
  START(pA0,pA1);
  _Pragma("unroll") for(int r=0;r<16;++r)pA1[r]=__builtin_amdgcn_exp2f(pA1[r]);
  WAIT_BAR(0);
  ROT();
  kload8(kf,kp0+sl_cur);
  asm volatile("s_waitcnt lgkmcnt(0)\n\ts_barrier":::"memory");
  s16x4 vlo[8],vhi[8]; u32x4 pw0,pw1,pw2,pw3;
  #define PKW(P,B) cvtpk_s(P[B],P[B+1])
  #define PAF(k) __builtin_bit_cast(bf16x8,pw##k)
  #define VFR(i) (bf16x8){vlo[i][0],vlo[i][1],vlo[i][2],vlo[i][3],vhi[i][0],vhi[i][1],vhi[i][2],vhi[i][3]}
  #define PIN(x) asm volatile("":"+v"(x))
  #define MX3(a,b,c) __builtin_fmaxf(__builtin_fmaxf((a),(b)),(c))
  #define GAPA(MF,A0,A1,A2,A3,W0,W1,PW) do{ MF; sacc+=A0; sacc+=A1; sacc+=A2; sacc+=A3; PIN(sacc); W0; W1; PIN(PW); SBAR(); }while(0)
  #define EX(v) __builtin_amdgcn_exp2f(v)
  #define GAPB(MF,X,B) do{ MF; X[B]=EX(X[B]); X[B+1]=EX(X[B+1]); X[B+2]=EX(X[B+2]); X[B+3]=EX(X[B+3]); PIN(X); SBAR(); }while(0)
  #define VRD(i) do{ vlo[i]=vtr(vp_+(((i)>>2)*4096+((i)&3)*1024)); vhi[i]=vtr(vp_+(((i)>>2)*4096+((i)&3)*1024+512)); }while(0)
  #define KRD(G,j) do{ if(G){ kload2(kf,kp0+sl_next,j); SBAR(); } }while(0)
  #define STEP(C0,C1,P0,P1,t,GK,GV,GL) do{ SBAR(); \
    if(GK){DMA_K((t)+3,sl_prev);} if(GV){DMA_V((t)+1,sl_next);} \
    const lds_cptr vp_=vp0+sl_prev; \
    VRD(0); SBAR(); float sacc=(P0[0]+P0[1]); \
    GAPA(C0=__builtin_amdgcn_mfma_f32_32x32x16_bf16(kf[0],qr[0],negm,0,0,0), P0[2],P0[3],P0[4],P0[5],     pw0[0]=PKW(P0,0), pw0[1]=PKW(P0,2), pw0); \
    VRD(4); SBAR(); GAPA(C1=__builtin_amdgcn_mfma_f32_32x32x16_bf16(kf[1],qr[0],negm,0,0,0), P0[6],P0[7],P0[8],P0[9],     pw0[2]=PKW(P0,4), pw0[3]=PKW(P0,6), pw0); \
    VRD(1); SBAR(); GAPA(C0=__builtin_amdgcn_mfma_f32_32x32x16_bf16(kf[2],qr[1],C0,0,0,0),   P0[10],P0[11],P0[12],P0[13], pw1[0]=PKW(P0,8), pw1[1]=PKW(P0,10), pw1); \
    VRD(5); SBAR(); GAPA(C1=__builtin_amdgcn_mfma_f32_32x32x16_bf16(kf[3],qr[1],C1,0,0,0),   P0[14],P0[15],P1[0],P1[1],   pw1[2]=PKW(P0,12),pw1[3]=PKW(P0,14), pw1); \
    VRD(2); SBAR(); GAPA(C0=__builtin_amdgcn_mfma_f32_32x32x16_bf16(kf[4],qr[2],C0,0,0,0),   P1[2],P1[3],P1[4],P1[5],     pw2[0]=PKW(P1,0), pw2[1]=PKW(P1,2), pw2); \
    VRD(6); SBAR(); GAPA(C1=__builtin_amdgcn_mfma_f32_32x32x16_bf16(kf[5],qr[2],C1,0,0,0),   P1[6],P1[7],P1[8],P1[9],     pw2[2]=PKW(P1,4), pw2[3]=PKW(P1,6), pw2); \
    VRD(3); SBAR(); GAPA(C0=__builtin_amdgcn_mfma_f32_32x32x16_bf16(kf[6],qr[3],C0,0,0,0),   P1[10],P1[11],P1[12],P1[13], pw3[0]=PKW(P1,8), pw3[1]=PKW(P1,10), pw3); \
    VRD(7); SBAR(); GAPA(C1=__builtin_amdgcn_mfma_f32_32x32x16_bf16(kf[7],qr[3],C1,0,0,0),   P1[14],P1[15],0.f,0.f,       pw3[2]=PKW(P1,12),pw3[3]=PKW(P1,14), pw3); \
    l_reg+=sacc; \
    CMASK(C0,C1,t); \
    SBAR(); \
    GAPB(o[0]=__builtin_amdgcn_mfma_f32_32x32x16_bf16(PAF(0),VFR(0),o[0],0,0,0), C0,0); \
    GAPB(o[1]=__builtin_amdgcn_mfma_f32_32x32x16_bf16(PAF(0),VFR(4),o[1],0,0,0), C0,4); \
    KRD(GL,0); GAPB(o[0]=__builtin_amdgcn_mfma_f32_32x32x16_bf16(PAF(1),VFR(1),o[0],0,0,0), C0,8); \
    KRD(GL,1); GAPB(o[1]=__builtin_amdgcn_mfma_f32_32x32x16_bf16(PAF(1),VFR(5),o[1],0,0,0), C0,12); \
    KRD(GL,2); GAPB(o[0]=__builtin_amdgcn_mfma_f32_32x32x16_bf16(PAF(2),VFR(2),o[0],0,0,0), C1,0); \
    KRD(GL,3); GAPB(o[1]=__builtin_amdgcn_mfma_f32_32x32x16_bf16(PAF(2),VFR(6),o[1],0,0,0), C1,4); \
    GAPB(o[0]=__builtin_amdgcn_mfma_f32_32x32x16_bf16(PAF(3),VFR(3),o[0],0,0,0), C1,8); \
    GAPB(o[1]=__builtin_amdgcn_mfma_f32_32x32x16_bf16(PAF(3),VFR(7),o[1],0,0,0), C1,12); \
    }while(0)
  int t=1;
  #undef CMASK
  #define CMASK(P0,P1,t) do{}while(0)
  for(;t+5<NT;t+=2){
    STEP(pB0,pB1,pA0,pA1,t,true,true,true);     ROT();
    STEP(pA0,pA1,pB0,pB1,t+1,true,true,true);   WAIT_BAR(0); ROT();
  }
  #undef CMASK
  #define CMASK(P0,P1,t) do{ if((t)==NT-1)cmask(P0,P1,2); }while(0)
  for(;t+1<NT;t+=2){
    STEP(pB0,pB1,pA0,pA1,t,(t+3<NT),(t+1<NT),(t+1<NT));       ROT();
    STEP(pA0,pA1,pB0,pB1,t+1,(t+4<NT),(t+2<NT),(t+2<NT));     WAIT_BAR(0); ROT();
  }
  {
    pw0=(u32x4){PKW(pA0,0),PKW(pA0,2),PKW(pA0,4),PKW(pA0,6)};pw1=(u32x4){PKW(pA0,8),PKW(pA0,10),PKW(pA0,12),PKW(pA0,14)};pw2=(u32x4){PKW(pA1,0),PKW(pA1,2),PKW(pA1,4),PKW(pA1,6)};pw3=(u32x4){PKW(pA1,8),PKW(pA1,10),PKW(pA1,12),PKW(pA1,14)};
    { float sacc=pA0[0]+pA0[1]; _Pragma("unroll") for(int r=2;r<16;++r)sacc+=pA0[r]; _Pragma("unroll") for(int r=0;r<16;++r)sacc+=pA1[r]; l_reg+=sacc; }
    SBAR(); pv(o,vb0+sl_prev,PAF(0),PAF(1),PAF(2),PAF(3)); }
  #undef PKW
  #undef PAF
  #undef VFR
  #undef PIN
  #undef MX3
  #undef GAPA
  #undef GAPB
  #undef EX
  #undef VRD
  #undef KRD
  #undef STEP
  {auto rr=__builtin_amdgcn_permlane32_swap(__float_as_uint(l_reg),__float_as_uint(l_reg),false,false);l_reg=__uint_as_float(rr[0])+__uint_as_float(rr[1]);}
  if(hi==0)wsf[32+r32]=l_reg;asm volatile("s_waitcnt lgkmcnt(0)":::"memory");
  float rli[16];
  #pragma unroll
  for(int r=0;r<16;++r)rli[r]=__builtin_amdgcn_rcpf(wsf[32+crow(r,hi)]);
  bf16*Ow=O+(long)(q0+wid*QBLK)*QP+h*D;
  { bf16*stg=(bf16*)(shm+LDS_OST2)+wid*2048;
    #pragma unroll
    for(int r=0;r<16;++r){const int orow=crow(r,hi);
      #pragma unroll
      for(int d0=0;d0<2;++d0)stg[orow*64+d0*32+r32]=f2bf16(o[d0][r]*rli[r]);}
    asm volatile("s_waitcnt lgkmcnt(0)":::"memory");
    #pragma unroll
    for(int i=0;i<4;++i){const int row=i*8+(lane>>3),ch=lane&7; const u32x4 v=*(const u32x4*)(stg+row*64+ch*8); ATTN_STORE16(Ow+(long)row*QP+ch*8,v);} }
  asm volatile("s_waitcnt lgkmcnt(0)\n\ts_barrier":::"memory");
  #undef DMA_K
  #undef DMA_V
  #undef CMASK
  #undef START
  #undef ROT
}


constexpr int ATTN_LDS_BYTES=LDS_BYTES;
struct AttnTensors { const bf16* Q; const bf16* K; const bf16* V; bf16* O; const float* qgain; const float* kgain; };
template<int THRL=8> __device__ __forceinline__ void attn_phase(char*lds,const AttnTensors&T,int vcu,int G){
  float gq=__builtin_fabsf(T.qgain[threadIdx.x&63]),gk=__builtin_fabsf(T.kgain[threadIdx.x&63]);
  #pragma unroll
  for(int o=1;o<64;o<<=1){gq=__builtin_fmaxf(gq,__shfl_xor(gq,o));gk=__builtin_fmaxf(gk,__shfl_xor(gk,o));}
  const float mref=__uint_as_float(__builtin_amdgcn_readfirstlane(__float_as_uint(C2*64.0f*gq*gk*1.001f+0.01f)));
  const bool fixed=mref<48.0f;
  const bool bal=(G==256);
  for(int k=0;;++k){
    int h,qb;
    if(bal){ if(k>=2)break; h=vcu>>5; qb=(vcu&31)+32*k; }
    else { const int u=vcu+k*G; if(u>=512)break; h=u>>6; qb=u&63; }
    if(fixed) attn_unit_fixed2(mref,h,qb,T.Q,T.K,T.V,T.O,lds); else attn_unit<THRL>(h,qb,T.Q,T.K,T.V,T.O,lds);
  }
}
#undef SBAR
#undef WAIT_BAR
}

constexpr int NWAVES = 8;
#ifndef MK_N_LAUNCHES
#define MK_N_LAUNCHES 1
#endif
constexpr int N_PHASES = 11;
constexpr int N_LAUNCHES = MK_N_LAUNCHES;
static_assert(N_LAUNCHES == 1 || N_LAUNCHES == N_PHASES, "MK_N_LAUNCHES is 1 or 11");

constexpr int M = 16384, DM = 1024, NMETA = 16, DFF = 2816, NGU = 2 * DFF, NIN = 5376;
constexpr int HGW = 512;
constexpr int HROWS = M + 128;

constexpr size_t MiB = 1u << 20;
constexpr size_t WS_CTL = 0, CTL_ZERO_BYTES = 1 * MiB;
constexpr size_t WS_MISC = 1 * MiB;
constexpr size_t MISC_ROPER = 0, MISC_ROPEC = 32768, MISC_OMLF = 40960, MISC_OMLB = 43008, MISC_METAB = 45056, MISC_SSQ0M = 77824, MISC_ACTM = 78848, MISC_H1M = 168960, MISC_H1MB = 234496,
                 MISC_SSQM = 267264, MISC_DF = 271360, MISC_DB = 535552, MISC_END = 799744;
static_assert(MISC_END <= 2 * MiB, "misc");
constexpr size_t WS_SSQ0 = 3 * MiB, WS_SSQ1 = 4 * MiB, WS_SSQ2 = 5 * MiB;
constexpr size_t WS_W = 6 * MiB;
constexpr size_t W_GU1 = 0, W_D1 = 11534336, W_IN = 17301504, W_UP = 28311552, W_OUT = 30408704, W_GU2 = 32505856, W_D2 = 44040192, W_END = 49807360;
constexpr size_t WS_HB = WS_W + W_END;
constexpr size_t WS_Z = WS_HB + (size_t)M * DM * 2;
constexpr size_t Z_HQ = 0, Z_QO = 16908288, Z_HV = 33685504, Z_ZFF = 50593792, Z_ZFB = 67502080, Z_HG = 84410368, Z_KB = 101318656, Z_VB = 105545728, Z_GA = 109772800, Z_GB = 143327232, Z_END = 176881664;
constexpr size_t WS_END = WS_Z + Z_END;
static_assert(Z_QO == Z_HQ + (size_t)HROWS * HGW * 2 && Z_HV == Z_QO + (size_t)M * HGW * 2 && Z_ZFF == Z_HV + (size_t)HROWS * HGW * 2 && Z_KB == Z_HG + (size_t)HROWS * HGW * 2 && Z_GA == Z_VB + (size_t)HROWS * 128 * 2 &&
              Z_END == Z_GB + (size_t)M * DM * 2 && WS_END <= 268435456 && (size_t)M * DFF * 2 <= Z_END && (size_t)M * DM * 2 <= Z_ZFB - Z_HV, "d_ws map");
constexpr int CW_TMO = 0, CW_CODE = 1, CW_BAR = 4096;

constexpr int RING_OFF = 0, RING_BYTES = 131072;
constexpr int HL_QH = 0, HL_KH = 32768, HL_VT = 65536, HL_ST = 100352, HL_TOT = 135168, HL_ER = 143360, HL_SSQ = 143872, HL_END = 144896;
constexpr int HL_PITCH = 272;
constexpr int OX_PITCH = 132;
constexpr int RS_OFF = 144896;
constexpr int LDSCTL_OFF = 153088, MISC_OFF = LDSCTL_OFF + 320;
constexpr int LDS_BYTES = 154112;
static_assert(HL_END <= RS_OFF && RS_OFF + pg8::RS_UNITS * 1024 <= LDSCTL_OFF && (M / 256) * (NGU / 256) <= pg8::RS_UNITS * 256 && RING_BYTES <= RS_OFF && MISC_OFF + 128 <= LDS_BYTES && 128 * OX_PITCH * 4 <= HL_ST, "LDS map");

#define GAS __attribute__((address_space(1)))
#define LAS __attribute__((address_space(3)))
typedef unsigned short bf16;
typedef unsigned v4u __attribute__((ext_vector_type(4)));
typedef float f32x4 __attribute__((ext_vector_type(4)));
typedef float f32x2 __attribute__((ext_vector_type(2)));
typedef float f32x16 __attribute__((ext_vector_type(16)));
typedef short bf16x8 __attribute__((ext_vector_type(8)));
typedef short s16x4 __attribute__((ext_vector_type(4)));
typedef GAS unsigned gu32;
#define RLX_AGENT __ATOMIC_RELAXED, __HIP_MEMORY_SCOPE_AGENT
#define LDS_WAIT() asm volatile("s_waitcnt lgkmcnt(0)" ::: "memory")
#define VM_WAIT() asm volatile("s_waitcnt vmcnt(0)" ::: "memory")
__device__ __forceinline__ unsigned f2bf(float f) { unsigned u = __builtin_bit_cast(unsigned, f); return (u + 0x7fffu + ((u >> 16) & 1u)) >> 16; }
typedef float f32x2_hw __attribute__((ext_vector_type(2))); typedef __bf16 bf16x2_hw __attribute__((ext_vector_type(2)));
__device__ __forceinline__ unsigned pk2(float lo, float hi) { f32x2_hw v = {lo, hi}; bf16x2_hw b = __builtin_convertvector(v, bf16x2_hw); return __builtin_bit_cast(unsigned, b); }
__device__ __forceinline__ float bf2f(unsigned short b) { return __uint_as_float((unsigned)b << 16); }
__device__ __forceinline__ float wave_sum(float v) {
#pragma unroll
    for (int o = 1; o < 64; o <<= 1) v += __shfl_xor(v, o);
    return v;
}
#define XB_TMO      128
#define XB_XCNT(j)  (256  + 64 * (j))
#define XB_XSUB(j)  (1280 + 64 * (j))
#define XB_XGEN(j)  (2304 + 64 * (j))
#define XB_TOP      3328
#define XB_TOPGEN   3392
#define XCD_BAR_WORDS 3456
#define XB_SPIN_CAP (1u << 18)

__device__ __forceinline__ unsigned xb_ld(unsigned* p)              { return __hip_atomic_load(p, __ATOMIC_RELAXED, __HIP_MEMORY_SCOPE_AGENT); }
__device__ __forceinline__ unsigned xb_add(unsigned* p, unsigned v) { return __hip_atomic_fetch_add(p, v, __ATOMIC_RELAXED, __HIP_MEMORY_SCOPE_AGENT); }
__device__ __forceinline__ unsigned xb_xcc_id() { return (unsigned)__builtin_amdgcn_s_getreg((3 << 11) | 20) & 0xFu; }
#define XB_SPIN(cond, bar) do { unsigned _sp = 0; while (cond) { __builtin_amdgcn_s_sleep(1); \
    if ((++_sp & 255u) == 0u) { if (xb_ld(&(bar)[XB_TMO])) break; if (_sp > XB_SPIN_CAP) { atomicAdd(&(bar)[XB_TMO], 1u); break; } } } } while (0)

struct XcdBarrier {
    unsigned* bar; unsigned x;
    volatile LAS unsigned* st;
};

__device__ __forceinline__ XcdBarrier xcd_barrier_post(unsigned* bar, volatile LAS unsigned* st) {
    XcdBarrier b; b.bar = bar; b.x = xb_xcc_id(); b.st = st;
    if (threadIdx.x == 0) (void)xb_add(&bar[XB_XCNT(b.x)], 1u);
    return b;
}
__device__ __forceinline__ void xcd_barrier_complete(unsigned* bar, unsigned x, unsigned& nloc, unsigned& nx) {
    const unsigned G = gridDim.x * gridDim.y * gridDim.z;
    unsigned sum, cnt, mine, sp = 0u;
    for (;;) {
        sum = 0u; cnt = 0u; mine = 0u;
#pragma unroll
        for (unsigned j = 0; j < 16; ++j) { const unsigned c = xb_ld(&bar[XB_XCNT(j)]); sum += c; cnt += (c > 0u) ? 1u : 0u; mine = (j == x) ? c : mine; }
        if (sum == G) break;
        __builtin_amdgcn_s_sleep(1);
        if ((++sp & 255u) == 0u) { if (xb_ld(&bar[XB_TMO])) break; if (sp > XB_SPIN_CAP) { atomicAdd(&bar[XB_TMO], 1u); break; } }
    }
    nloc = mine > 0u ? mine : 1u; nx = cnt > 0u ? cnt : 1u;
}

__device__ __forceinline__ void xcd_barrier(const XcdBarrier& b) {
    asm volatile("s_waitcnt vmcnt(0)" ::: "memory");
    __syncthreads();
    if (threadIdx.x == 0) {
        unsigned* bar = b.bar;
        __builtin_amdgcn_s_waitcnt(0);
        unsigned nloc = b.st[0], nx = b.st[1];
        if (nloc == 0u) { xcd_barrier_complete(bar, b.x, nloc, nx); b.st[0] = nloc; b.st[1] = nx; }
        const unsigned old = xb_add(&bar[XB_XSUB(b.x)], 1u);
        const unsigned gen = old / nloc;
        if (old + 1u == (gen + 1u) * nloc) {
            __builtin_amdgcn_fence(__ATOMIC_RELEASE, "agent");
            asm volatile("s_waitcnt vmcnt(0)" ::: "memory");
            const unsigned og = xb_add(&bar[XB_TOP], 1u);
            const unsigned tg = og / nx;
            if (og + 1u == (tg + 1u) * nx) xb_add(&bar[XB_TOPGEN], 1u);
            else XB_SPIN(xb_ld(&bar[XB_TOPGEN]) == tg, bar);
            __builtin_amdgcn_fence(__ATOMIC_ACQUIRE, "agent");
            xb_add(&bar[XB_XGEN(b.x)], 1u);
            asm volatile("s_waitcnt vmcnt(0)" ::: "memory");
        } else {
            XB_SPIN(xb_ld(&bar[XB_XGEN(b.x)]) == gen, bar);
            __builtin_amdgcn_fence(__ATOMIC_ACQUIRE, "agent");
            asm volatile("s_waitcnt vmcnt(0)" ::: "memory");
        }
    }
    __syncthreads();
}

struct Frame {
    LAS unsigned char* lds;
    volatile LAS unsigned* MISC;
    gu32* ctl;
    int wave;
    int vcu, G;
    const float* in[20]; float* out; unsigned char* ws;
};
#define WSP(T, off) ((T*)(F.ws + (off)))

__device__ __forceinline__ int win_rowmap(int n) {
    if (n >= 2560 && n < 3072) { const int cq = n - 2560, hd = cq >> 6, d = cq & 63; return 256 * (10 + (hd >> 2)) + 128 * (d >> 5) + 32 * (hd & 3) + (d & 31); }
    if (n >= 3072 && n < 3328) { const int c = n - 3072, hh = c >> 6, d = c & 63; return 3072 + 128 * (d >> 5) + 32 * hh + (d & 31); }
    if (n >= 3328) { const int c = n - 3328, z = c >> 10, cc = c & 1023; return 3328 + 256 * (cc >> 7) + 128 * z + (cc & 127); }
    return n;
}
template <int KIND>
__device__ __forceinline__ void p0_transpose_item(const float* W, int K, int N, bf16* WT, int row_off, const float* kscale, LAS float* scr, int item, int lane) {
    const int nblk = N / 32, kb = item / nblk, nb = item % nblk, k0 = 64 * kb, n0 = 32 * nb;
    float wv[32];
#pragma unroll
    for (int i = 0; i < 32; ++i) { const int kk = 2 * i + (lane >> 5); wv[i] = W[(size_t)(k0 + kk) * N + n0 + (lane & 31)]; }
#pragma unroll
    for (int i = 0; i < 32; ++i) { const int kk = 2 * i + (lane >> 5); const float sc = kscale ? kscale[k0 + kk] : 1.0f; scr[kk * 33 + (lane & 31)] = wv[i] * sc; }
    LDS_WAIT(); asm volatile("" ::: "memory");
    const int c = lane & 7;
#pragma unroll
    for (int j = 0; j < 4; ++j) { const int n = (lane >> 3) + 8 * j; const LAS float* s = scr + (8 * c) * 33 + n;
        v4u o; o.x = pk2(s[0 * 33], s[1 * 33]); o.y = pk2(s[2 * 33], s[3 * 33]); o.z = pk2(s[4 * 33], s[5 * 33]); o.w = pk2(s[6 * 33], s[7 * 33]);
        const int nn = n0 + n; const int drow = (KIND == 0) ? row_off + nn : ((KIND == 1) ? 256 * (nn >> 7) + (nn & 127) + row_off : win_rowmap(nn));
        *(GAS v4u*)(WT + (size_t)drow * K + k0 + 8 * c) = o; }
    LDS_WAIT(); asm volatile("" ::: "memory");
}
__device__ __forceinline__ void row_to_bf16(int lane, const float* xrow, bf16* orow, float* ssq16) {
    const GAS f32x4* xr = (const GAS f32x4*)xrow + lane;
    f32x4 v[4]; float s = 0.f;
#pragma unroll
    for (int j = 0; j < 4; ++j) { v[j] = xr[64 * j]; s += (v[j].x * v[j].x + v[j].y * v[j].y) + (v[j].z * v[j].z + v[j].w * v[j].w); }
    s = wave_sum(s);
    GAS unsigned long long* o8 = (GAS unsigned long long*)orow + lane;
#pragma unroll
    for (int j = 0; j < 4; ++j) o8[64 * j] = (unsigned long long)pk2(v[j].x, v[j].y) | ((unsigned long long)pk2(v[j].z, v[j].w) << 32);
    if (lane < 16) ssq16[lane] = (lane == 0) ? s : 0.f;
}
__device__ __forceinline__ void sincos_d(double a, float& sn, float& cs) {
    const double TWO_PI = 6.283185307179586476925286766559;
    const double k = __builtin_rint(a / TWO_PI); const double x = a - k * TWO_PI;
    const double x2 = x * x; double ts = 1.0, tc = 1.0, ss = 1.0, cc = 1.0;
#pragma unroll
    for (int i = 1; i <= 13; ++i) { tc = -tc * x2 / (double)((2 * i - 1) * (2 * i)); ts = -ts * x2 / (double)((2 * i) * (2 * i + 1)); cc += tc; ss += ts; }
    sn = (float)(ss * x); cs = (float)cc;
}
constexpr int I_G = (DM / 64) * (DFF / 32), I_D = (DFF / 64) * (DM / 32), I_IN = (DM / 64) * (NIN / 32), I_U = (HGW / 64) * (DM / 32), I_O = (DM / 64) * (DM / 32);
constexpr int CV_FFN1 = 2 * I_G + I_D, CV_IN = CV_FFN1 + I_IN, CV_ALL = CV_IN + 2 * I_U + I_O + 2 * I_G + I_D;
__device__ __forceinline__ void convert_items(Frame& F, int it_lo, int it_hi, int wrank, int nw) {
    LAS float* scr = (LAS float*)(F.lds + RING_OFF + F.wave * 16384);
    const int lane = (int)threadIdx.x & 63;
    bf16* Wb = WSP(bf16, WS_W);
    for (int it = it_lo + wrank; it < it_hi; it += nw) {
        int r = it;
        if (r < I_G) { p0_transpose_item<1>(F.in[3], DM, DFF, Wb + W_GU1 / 2, 0, F.in[2], scr, r, lane); continue; } r -= I_G;
        if (r < I_G) { p0_transpose_item<1>(F.in[4], DM, DFF, Wb + W_GU1 / 2, 128, F.in[2], scr, r, lane); continue; } r -= I_G;
        if (r < I_D) { p0_transpose_item<0>(F.in[5], DFF, DM, Wb + W_D1 / 2, 0, nullptr, scr, r, lane); continue; } r -= I_D;
        if (r < I_IN) { p0_transpose_item<2>(F.in[7], DM, NIN, Wb + W_IN / 2, 0, F.in[6], scr, r, lane); continue; } r -= I_IN;
        if (r < I_U) { p0_transpose_item<0>(F.in[13], HGW, DM, Wb + W_UP / 2, 0, nullptr, scr, r, lane); continue; } r -= I_U;
        if (r < I_U) { p0_transpose_item<0>(F.in[14], HGW, DM, Wb + W_UP / 2, 1024, nullptr, scr, r, lane); continue; } r -= I_U;
        if (r < I_O) { p0_transpose_item<0>(F.in[15], DM, DM, Wb + W_OUT / 2, 0, nullptr, scr, r, lane); continue; } r -= I_O;
        if (r < I_G) { p0_transpose_item<1>(F.in[17], DM, DFF, Wb + W_GU2 / 2, 0, F.in[16], scr, r, lane); continue; } r -= I_G;
        if (r < I_G) { p0_transpose_item<1>(F.in[18], DM, DFF, Wb + W_GU2 / 2, 128, F.in[16], scr, r, lane); continue; } r -= I_G;
        p0_transpose_item<0>(F.in[19], DFF, DM, Wb + W_D2 / 2, 0, nullptr, scr, r, lane);
    }
}
__device__ __forceinline__ void convert_in_idle_slot(Frame& F, int nwg, int it_lo, int it_hi) {
    const int cut = nwg % F.G, c = (int)blockIdx.x;
    if (c < cut) return;
    convert_items(F, it_lo, it_hi, (c - cut) * NWAVES + F.wave, (F.G - cut) * NWAVES);
    __syncthreads();
}
__device__ __forceinline__ void stagger_short_share(Frame& F, int nwg, int sleeps) {
    const int cut = nwg % F.G; if (cut == 0 || (int)blockIdx.x < cut) return;
    for (int i = 0; i < sleeps; ++i) __builtin_amdgcn_s_sleep(127);
}
__device__ __forceinline__ void p0_prologue(Frame& F) {
    const int gw = F.vcu * NWAVES + F.wave, NGW = F.G * NWAVES;
    convert_items(F, 0, CV_FFN1, gw, NGW);
    {
        const int lane = (int)threadIdx.x & 63;
        for (int m0 = gw; m0 < M; m0 += 4 * NGW) {
            f32x4 v[4][4]; float sq[4];
#pragma unroll
            for (int q = 0; q < 4; ++q) { const int m = m0 + q * NGW; const GAS f32x4* xr = (const GAS f32x4*)(F.in[0] + (size_t)(m < M ? m : m0) * DM) + lane;
#pragma unroll
                for (int j = 0; j < 4; ++j) v[q][j] = xr[64 * j]; }
#pragma unroll
            for (int q = 0; q < 4; ++q) { float t = 0.f;
#pragma unroll
                for (int j = 0; j < 4; ++j) t += (v[q][j].x * v[q][j].x + v[q][j].y * v[q][j].y) + (v[q][j].z * v[q][j].z + v[q][j].w * v[q][j].w);
                sq[q] = wave_sum(t); }
#pragma unroll
            for (int q = 0; q < 4; ++q) { const int m = m0 + q * NGW; if (m < M) {
                GAS unsigned long long* o8 = (GAS unsigned long long*)(WSP(bf16, WS_HB) + (size_t)m * DM) + lane;
#pragma unroll
                for (int j = 0; j < 4; ++j) o8[64 * j] = (unsigned long long)pk2(v[q][j].x, v[q][j].y) | ((unsigned long long)pk2(v[q][j].z, v[q][j].w) << 32);
                if (lane < 16) (WSP(float, WS_SSQ0) + (size_t)m * 16)[lane] = (lane == 0) ? sq[q] : 0.f; } }
        }
    }
    if (gw < NMETA) row_to_bf16(((int)threadIdx.x & 63), F.in[1] + (size_t)gw * DM, WSP(bf16, WS_MISC + MISC_METAB) + (size_t)gw * DM, WSP(float, WS_MISC + MISC_SSQ0M) + gw * 16);
    const int gt = F.vcu * (NWAVES * 64) + (int)threadIdx.x;
    if (gt < 320 * 16) {
        const int pos = gt >> 4, j = gt & 15;
        const double inv = (double)exp2f(-(float)j * (13.287712379549449f / 16.0f));
        float sn, cs; sincos_d((double)(pos < 256 ? pos : pos - 256) * inv, sn, cs);
        f32x2* tab = (pos < 256) ? WSP(f32x2, WS_MISC + MISC_ROPER) + pos * 16 + j : WSP(f32x2, WS_MISC + MISC_ROPEC) + (pos - 256) * 16 + j;
        *tab = (f32x2){cs, sn};
    } else if (gt < 320 * 16 + 1024) {
        const int i = gt - 320 * 16, k = i & 511; const float* lb = (i < 512) ? F.in[8] : F.in[9];
        const float a0 = lb[k], a1 = lb[512 + k];
        (i < 512 ? WSP(float, WS_MISC + MISC_OMLF) : WSP(float, WS_MISC + MISC_OMLB))[k] = 1.0f / (1.0f + __expf(a0 - a1));
    }
}

template <int NG, int KS>
__device__ __forceinline__ void thin_job(const bf16* A, const bf16* Bt, const int (&brow)[NG], int K, LAS float* red, f32x4 (&acc)[NG], int wave, int lane) {
    const int kbeg = wave * KS * 32;
    const bf16* ap = A + (size_t)(lane & 15) * K + kbeg + 8 * (lane >> 4);
#pragma unroll
    for (int g = 0; g < NG; ++g) acc[g] = (f32x4){0.f, 0.f, 0.f, 0.f};
    bf16x8 af[KS];
#pragma unroll
    for (int s2 = 0; s2 < KS; ++s2) af[s2] = *(const GAS bf16x8*)(ap + 32 * s2);
#pragma unroll
    for (int g = 0; g < NG; ++g) {
        const bf16* bp = Bt + (size_t)(brow[g] + (lane & 15)) * K + kbeg + 8 * (lane >> 4);
        bf16x8 bfr[KS];
#pragma unroll
        for (int s2 = 0; s2 < KS; ++s2) bfr[s2] = *(const GAS bf16x8*)(bp + 32 * s2);
#pragma unroll
        for (int s2 = 0; s2 < KS; ++s2) acc[g] = __builtin_amdgcn_mfma_f32_16x16x32_bf16(af[s2], bfr[s2], acc[g], 0, 0, 0);
    }
#pragma unroll
    for (int g = 0; g < NG; ++g) *(LAS f32x4*)(red + ((wave * NG + g) * 64 + lane) * 4) = acc[g];
    __syncthreads();
    if (wave == 0) {
#pragma unroll
        for (int g = 0; g < NG; ++g) { f32x4 sum = acc[g];
#pragma unroll
            for (int w2 = 1; w2 < 8; ++w2) sum += *(const LAS f32x4*)(red + ((w2 * NG + g) * 64 + lane) * 4);
            acc[g] = sum; }
    }
    __syncthreads();
}
__device__ __forceinline__ int slack_first(int nwg, int G, int njobs) { const int cut = nwg % G; return (cut && G - cut >= njobs) ? cut : 0; }
__device__ __forceinline__ void meta_p1(Frame& F) {
    const int job = (int)blockIdx.x - slack_first((M / 256) * (NGU / 256), F.G, DFF / 32); if (job < 0 || job >= DFF / 32) return;
    const int j0 = 32 * job, j1 = j0 + 16, lane = (int)threadIdx.x & 63;
    const int brow[4] = {256 * (j0 >> 7) + (j0 & 127), 256 * (j0 >> 7) + (j0 & 127) + 128, 256 * (j1 >> 7) + (j1 & 127), 256 * (j1 >> 7) + (j1 & 127) + 128};
    f32x4 acc[4];
    thin_job<4, 4>(WSP(bf16, WS_MISC + MISC_METAB), WSP(bf16, WS_W + W_GU1), brow, DM, (LAS float*)(F.lds + RING_OFF), acc, F.wave, lane);
    if (F.wave != 0) return;
    const float* ssq = WSP(float, WS_MISC + MISC_SSQ0M); bf16* act = WSP(bf16, WS_MISC + MISC_ACTM);
#pragma unroll
    for (int r = 0; r < 4; ++r) { const int row = 4 * (lane >> 4) + r; const float rs = rsqrtf(ssq[row * 16] * (1.0f / 1024.0f) + pg8::RMS_EPS);
        act[(size_t)row * DFF + j0 + (lane & 15)] = (bf16)f2bf(pg8::fast_silu(acc[0][r] * rs) * (acc[1][r] * rs));
        act[(size_t)row * DFF + j1 + (lane & 15)] = (bf16)f2bf(pg8::fast_silu(acc[2][r] * rs) * (acc[3][r] * rs)); }
}
__device__ __forceinline__ void meta_p2(Frame& F) {
    const int job = (int)blockIdx.x; if (job >= DM / 16) return;
    const int c0 = 16 * job, lane = (int)threadIdx.x & 63;
    const int brow[1] = {c0};
    f32x4 acc[1];
    thin_job<1, 11>(WSP(bf16, WS_MISC + MISC_ACTM), WSP(bf16, WS_W + W_D1), brow, DFF, (LAS float*)(F.lds + RING_OFF), acc, F.wave, lane);
    if (F.wave != 0) return;
    float* h1 = WSP(float, WS_MISC + MISC_H1M); bf16* h1b = WSP(bf16, WS_MISC + MISC_H1MB); float* ssqm = WSP(float, WS_MISC + MISC_SSQM);
#pragma unroll
    for (int r = 0; r < 4; ++r) { const int row = 4 * (lane >> 4) + r; const size_t o = (size_t)row * DM + c0 + (lane & 15);
        const float v = F.in[1][o] + 0.5f * acc[0][r]; h1[o] = v; h1b[o] = (bf16)f2bf(v);
        float sq = v * v; sq += __shfl_xor(sq, 1); sq += __shfl_xor(sq, 2); sq += __shfl_xor(sq, 4); sq += __shfl_xor(sq, 8);
        if ((lane & 15) == 0) ssqm[row * 64 + job] = sq; }
}
__device__ __forceinline__ void meta_p3(Frame& F) {
    const int lane = (int)threadIdx.x & 63;
    bf16* HV = WSP(bf16, WS_Z + Z_HV); bf16* ZFF = WSP(bf16, WS_Z + Z_ZFF); bf16* KB = WSP(bf16, WS_Z + Z_KB); bf16* VB = WSP(bf16, WS_Z + Z_VB);
    if ((int)blockIdx.x == F.G - 1) {
        const v4u zero = {0u, 0u, 0u, 0u};
        for (int p = (int)threadIdx.x; p < 112 * 512 / 8; p += NWAVES * 64) { ((GAS v4u*)HV)[p] = zero; ((GAS v4u*)ZFF)[p] = zero; }
        for (int p = (int)threadIdx.x; p < 112 * 128 / 8; p += NWAVES * 64) { ((GAS v4u*)(KB + (size_t)(M + 16) * 128))[p] = zero; ((GAS v4u*)(VB + (size_t)(M + 16) * 128))[p] = zero; }
    }
    const int job = (int)blockIdx.x - slack_first((M / 256) * (NIN / 256), F.G, 20); if (job < 0 || job >= 20) return;
    int brow[4];
    if (job < 16) {
#pragma unroll
        for (int g = 0; g < 4; ++g) brow[g] = (job < 8 ? 512 : 1024) + 64 * (job & 7) + 16 * g;
    } else {
#pragma unroll
        for (int g = 0; g < 4; ++g) brow[g] = 3072 + 128 * (g >> 1) + 32 * (job - 16) + 16 * (g & 1);
    }
    f32x4 x[4];
    thin_job<4, 4>(WSP(bf16, WS_MISC + MISC_H1MB), WSP(bf16, WS_W + W_IN), brow, DM, (LAS float*)(F.lds + RING_OFF), x, F.wave, lane);
    if (F.wave != 0) return;
    float rs4[4];
    { const f32x4* p = (const f32x4*)(WSP(float, WS_MISC + MISC_SSQM) + (lane >> 2) * 64 + (lane & 3) * 16);
      const f32x4 a = p[0], b = p[1], c = p[2], d = p[3];
      float sq = (((a[0] + a[1]) + (a[2] + a[3])) + ((b[0] + b[1]) + (b[2] + b[3]))) + (((c[0] + c[1]) + (c[2] + c[3])) + ((d[0] + d[1]) + (d[2] + d[3])));
      sq += __shfl_xor(sq, 1); sq += __shfl_xor(sq, 2);
      const float rsv = rsqrtf(sq * (1.0f / 1024.0f) + pg8::RMS_EPS);
#pragma unroll
      for (int r = 0; r < 4; ++r) rs4[r] = __shfl(rsv, 4 * (4 * (lane >> 4) + r)); }
    if (job < 16) {
        bf16* dst = (job < 8 ? HV : ZFF) + 64 * (job & 7);
#pragma unroll
        for (int r = 0; r < 4; ++r) { const int row = 4 * (lane >> 4) + r;
#pragma unroll
            for (int g = 0; g < 4; ++g) { float v = x[g][r] * rs4[r];
                if (job >= 8) v = __builtin_amdgcn_logf(1.0f - WSP(float, WS_MISC + MISC_OMLF)[64 * (job & 7) + 16 * g + (lane & 15)] * __builtin_amdgcn_rcpf(1.0f + __builtin_amdgcn_exp2f(v * 1.4426950408889634f)));
                dst[(size_t)(112 + row) * HGW + 16 * g + (lane & 15)] = (bf16)f2bf(v); } }
    } else {
        const int hh = job - 16;
#pragma unroll
        for (int r = 0; r < 4; ++r) {
            const int row = 4 * (lane >> 4) + r; float v[4]; float ss = 0.f;
#pragma unroll
            for (int g = 0; g < 4; ++g) { v[g] = x[g][r] * rs4[r]; ss += v[g] * v[g]; }
            if (hh < 2) { ss += __shfl_xor(ss, 1); ss += __shfl_xor(ss, 2); ss += __shfl_xor(ss, 4); ss += __shfl_xor(ss, 8);
                const float rn = rsqrtf(ss * (1.0f / 64.0f) + pg8::RMS_EPS);
#pragma unroll
                for (int g = 0; g < 4; ++g) v[g] *= rn * F.in[12][16 * g + (lane & 15)]; }
            bf16* dst = (hh < 2 ? KB : VB) + (size_t)(M + row) * 128 + 64 * (hh & 1);
#pragma unroll
            for (int g = 0; g < 4; ++g) dst[16 * g + (lane & 15)] = (bf16)f2bf(v[g]);
        }
    }
}

typedef LAS const char* lds_cptr;
typedef short v4i16_t __attribute__((ext_vector_type(4)));
__device__ __forceinline__ s16x4 vtr(lds_cptr p) { return __builtin_bit_cast(s16x4, __builtin_amdgcn_ds_read_tr16_b64_v4i16((LAS v4i16_t*)p)); }
__device__ __forceinline__ int crow(int r, int hi) { return (r & 3) + 8 * (r >> 2) + 4 * hi; }
__device__ __forceinline__ int hg_img_off(int tb, int k, int seg) { return tb * 8192 + (k ^ ((k >> 4) & 1)) * 64 + ((seg ^ (k >> 2)) & 3) * 16; }
__device__ __forceinline__ bf16x8 trfrag(lds_cptr img, int tb, int ks, int lane) {
    const int k0 = 16 * ks + 8 * (lane >> 5) + ((lane & 15) >> 2), seg = ((lane >> 4) & 1) * 2 + ((lane & 3) >> 1), sub = (lane & 1) * 8;
    const s16x4 lo = vtr(img + hg_img_off(tb, k0, seg) + sub), hi = vtr(img + hg_img_off(tb, k0 + 4, seg) + sub);
    return (bf16x8){lo[0], lo[1], lo[2], lo[3], hi[0], hi[1], hi[2], hi[3]};
}
__device__ __forceinline__ bf16* hg_slot(Frame& F, int dir, int j, int h) { return (bf16*)F.out + ((size_t)((dir * 128 + (j - 1)) * 4 + h) << 14); }

typedef unsigned u32x2g __attribute__((ext_vector_type(2)));
__device__ __forceinline__ void hg_load8(const bf16* base  , int sg, int cq, u32x2g (&r)[8]) {
    const bf16* p = base + (size_t)(8 * sg) * HGW + 4 * cq;
#pragma unroll
    for (int i = 0; i < 8; ++i) r[i] = *(const GAS u32x2g*)(p + (size_t)i * HGW);
}
__device__ __forceinline__ float hg_elem(const u32x2g (&r)[8], int i, int c) { const unsigned w = (c < 2) ? r[i].x : r[i].y; return (c & 1) ? __uint_as_float(w & 0xffff0000u) : __uint_as_float(w << 16); }
__device__ __forceinline__ unsigned hg_raw(const u32x2g (&r)[8], int i, int c) { const unsigned w = (c < 2) ? r[i].x : r[i].y; return (c & 1) ? (w >> 16) : (w & 0xffffu); }
__device__ __forceinline__ f32x4 hg_gates8(const u32x2g (&z)[8], float (&kk)[4][8], LAS float* tot, int sg, int cq) {
    f32x4 run = {0.f, 0.f, 0.f, 0.f};
#pragma unroll
    for (int c = 0; c < 4; ++c)
#pragma unroll
        for (int i = 0; i < 8; ++i) { const float g = hg_elem(z, i, c); run[c] += g; kk[c][i] = 1.0f - __builtin_amdgcn_exp2f(g); }
    *(LAS f32x4*)(tot + sg * 128 + 4 * cq) = run;
    return run;
}
__device__ __forceinline__ void hg_prefix(const LAS float* tot, const f32x4 own, int sg, int cq, int dir, f32x4& pre, f32x4& ref, f32x4& all) {
    f32x4 lo = {0.f, 0.f, 0.f, 0.f}, hi = lo, pf = lo;
#pragma unroll
    for (int s2 = 0; s2 < 16; ++s2) { const f32x4 v = *(const LAS f32x4*)(tot + s2 * 128 + 4 * cq); const float m = (s2 < sg) ? 1.0f : 0.0f;
        if (s2 < 8) lo += v; else hi += v;
        pf[0] = __builtin_fmaf(v[0], m, pf[0]); pf[1] = __builtin_fmaf(v[1], m, pf[1]); pf[2] = __builtin_fmaf(v[2], m, pf[2]); pf[3] = __builtin_fmaf(v[3], m, pf[3]); }
    all = lo + hi;
    if (dir) { pre = all - pf - own; ref = hi; } else { pre = pf; ref = lo; }
}
__device__ __forceinline__ v4u hg_pack8(const float (&x)[8], int dir) {
    v4u w;
    if (!dir) { w.x = pk2(x[0], x[1]); w.y = pk2(x[2], x[3]); w.z = pk2(x[4], x[5]); w.w = pk2(x[6], x[7]); }
    else { w.x = pk2(x[7], x[6]); w.y = pk2(x[5], x[4]); w.z = pk2(x[3], x[2]); w.w = pk2(x[1], x[0]); }
    return w;
}
__device__ __forceinline__ v4u hg_pack8raw(const u32x2g (&r)[8], int c, int dir) {
    v4u w;
    if (!dir) { w.x = hg_raw(r, 0, c) | (hg_raw(r, 1, c) << 16); w.y = hg_raw(r, 2, c) | (hg_raw(r, 3, c) << 16); w.z = hg_raw(r, 4, c) | (hg_raw(r, 5, c) << 16); w.w = hg_raw(r, 6, c) | (hg_raw(r, 7, c) << 16); }
    else { w.x = hg_raw(r, 7, c) | (hg_raw(r, 6, c) << 16); w.y = hg_raw(r, 5, c) | (hg_raw(r, 4, c) << 16); w.z = hg_raw(r, 3, c) | (hg_raw(r, 2, c) << 16); w.w = hg_raw(r, 1, c) | (hg_raw(r, 0, c) << 16); }
    return w;
}
template <int DIR> __device__ __forceinline__ void hg_pass2_state(const float (&kk)[8], const u32x2g (&zr)[8], int cc, float pre, float B, float (&kx)[8]) {
    float b = pre;
#pragma unroll
    for (int ii = 0; ii < 8; ++ii) { constexpr int dummy = 0; (void)dummy; const int i = DIR ? 7 - ii : ii; const float k = kk[i]; b += hg_elem(zr, i, cc); kx[i] = k * __builtin_amdgcn_exp2f(B - b); }
}
template <int DIR> __device__ __forceinline__ void hg_pass2_out(const float (&kk)[8], const u32x2g (&zr)[8], const u32x2g (&qr)[8], int cc, float pre, float rref, float (&qx)[8], float (&kx)[8]) {
    float b = pre;
#pragma unroll
    for (int ii = 0; ii < 8; ++ii) { const int i = DIR ? 7 - ii : ii; const float k = kk[i]; b += hg_elem(zr, i, cc); const float e = b - rref;
        qx[i] = hg_elem(qr, i, cc) * __builtin_amdgcn_exp2f(fminf(e, 115.f)); kx[i] = k * __builtin_amdgcn_exp2f(fminf(-e, 115.f)); }
}
#define HG4_DECODE(uid_, c_, h_, d_) const int d_ = ((uid_) >= 512) ? 1 : 0, c_ = d_ ? 2 + (((uid_) - 512) >> 2) : ((uid_) >> 2), h_ = (uid_) & 3
#define HG4_ISSUE_LOADS(uid_) do { HG4_DECODE(uid_, cN_, hN_, dN_); const size_t cb_ = ((size_t)128 * cN_) * HGW + hN_ * 128; \
        hg_load8(WSP(bf16, WS_Z + (dN_ ? Z_ZFB : Z_ZFF)) + cb_, sg, cq, zr); hg_load8(WSP(bf16, WS_Z + Z_HV) + cb_, sg, cq, vr); } while (0)
__device__ __forceinline__ void hg_state_phase(Frame& F) {
    const int w = F.wave;
    LAS float* tot = (LAS float*)(F.lds + HL_TOT);
    if (F.vcu >= 1020) return;
    u32x2g zr[8], vr[8];
    { const int tid = threadIdx.x, cq = tid & 31, sg = tid >> 5; HG4_ISSUE_LOADS(F.vcu); }
#pragma unroll 1
    for (int uid = F.vcu; uid < 1020; uid += F.G) {
        int tid_ = threadIdx.x; asm volatile("" : "+v"(tid_));
        const int tid = tid_, lane = tid & 63, r = lane & 31, hi = lane >> 5, cq = tid & 31, sg = tid >> 5;
        HG4_DECODE(uid, c, h, dir);
        const int sgu = dir ? 15 - sg : sg;
        float kk[4][8];
        const f32x4 own = hg_gates8(zr, kk, tot, sg, cq);
#pragma unroll
        for (int cc = 0; cc < 4; ++cc) *(LAS v4u*)(F.lds + HL_VT + (4 * cq + cc) * HL_PITCH + sgu * 16) = hg_pack8raw(vr, cc, dir);
        __syncthreads();
        f32x4 pre, ref, B; hg_prefix(tot, own, sg, cq, dir, pre, ref, B);
#pragma unroll
        for (int cc = 0; cc < 4; ++cc) {
            float kx[8];
            if (dir) hg_pass2_state<1>(kk[cc], zr, cc, pre[cc], B[cc], kx); else hg_pass2_state<0>(kk[cc], zr, cc, pre[cc], B[cc], kx);
            *(LAS v4u*)(F.lds + HL_QH + (4 * cq + cc) * HL_PITCH + sgu * 16) = hg_pack8(kx, dir);
        }
        if (sg == 0) { f32x4 dd; dd[0] = __builtin_amdgcn_exp2f(B[0]); dd[1] = __builtin_amdgcn_exp2f(B[1]); dd[2] = __builtin_amdgcn_exp2f(B[2]); dd[3] = __builtin_amdgcn_exp2f(B[3]); *(f32x4*)(WSP(float, WS_MISC + (dir ? MISC_DB : MISC_DF)) + c * HGW + h * 128 + 4 * cq) = dd; }
        if (uid + F.G < 1020) HG4_ISSUE_LOADS(uid + F.G);
        __syncthreads();
        const int vb = w >> 1;
#pragma unroll
        for (int kbi = 0; kbi < 2; ++kbi) {
            const int kb = 2 * (w & 1) + kbi; f32x16 acc = {};
#pragma unroll
            for (int ks = 0; ks < 8; ++ks) {
                const bf16x8 a = *(const LAS bf16x8*)(F.lds + HL_VT + (32 * vb + r) * HL_PITCH + (16 * ks + 8 * hi) * 2);
                const bf16x8 bq = *(const LAS bf16x8*)(F.lds + HL_QH + (32 * kb + r) * HL_PITCH + (16 * ks + 8 * hi) * 2);
                acc = __builtin_amdgcn_mfma_f32_32x32x16_bf16(bq, a, acc, 0, 0, 0);
            }
            LAS unsigned char* ut = F.lds + HL_ST + (32 * vb + r) * HL_PITCH + (32 * kb + 4 * hi) * 2;
#pragma unroll
            for (int q4 = 0; q4 < 4; ++q4) { u32x2g w; w.x = pk2(acc[4 * q4], acc[4 * q4 + 1]); w.y = pk2(acc[4 * q4 + 2], acc[4 * q4 + 3]); *(LAS u32x2g*)(ut + 16 * q4) = w; }
        }
        __syncthreads();
        { bf16* slot = hg_slot(F, dir, dir ? c - 1 : c + 1, h);
#pragma unroll
          for (int j = 0; j < 4; ++j) { const int p = tid + 512 * j, v = p >> 4, k8 = (p & 15) * 8; *(GAS v4u*)(slot + (size_t)v * 128 + k8) = *(const LAS v4u*)(F.lds + HL_ST + v * HL_PITCH + k8 * 2); } }
    }
    __syncthreads();
}
#undef HG4_ISSUE_LOADS
#undef HG4_DECODE
__device__ __forceinline__ void hg_scan_phase(Frame& F) {
    if ((int)threadIdx.x >= 256) return;
    for (int task = F.vcu * 256 + (int)threadIdx.x; task < 65536; task += F.G * 256) {
        const int dir = task >> 15, h = (task >> 13) & 3, p = task & 8191, v = p >> 6, k = (p & 63) * 2;
        const float* dd = WSP(float, WS_MISC + (dir ? MISC_DB : MISC_DF)) + h * 128 + k;
        unsigned* base = (unsigned*)(hg_slot(F, dir, 1, h) + v * 128 + k);
        const size_t jstride = (size_t)4 * 8192;
        const int j0 = dir ? 127 : 1, step = dir ? -1 : 1;
        unsigned w0 = base[(size_t)(j0 - 1) * jstride]; float s0 = pg8::bf_lo(w0), s1 = pg8::bf_hi(w0);
#pragma unroll 1
        for (int n = 0; n < 127 - dir; n += 32) {
            unsigned wv[32]; f32x2 dv[32];
#pragma unroll
            for (int q = 0; q < 32; ++q) { const int j = j0 + step * (n + q + 1); const bool ok = (n + q) < 127 - dir; const int jj = ok ? j : j0;
                wv[q] = base[(size_t)(jj - 1) * jstride]; dv[q] = *(const f32x2*)(dd + (size_t)(jj - step) * HGW); }
#pragma unroll
            for (int q = 0; q < 32; ++q) { if ((n + q) < 127 - dir) { const int j = j0 + step * (n + q + 1);
                s0 = dv[q].x * s0 + pg8::bf_lo(wv[q]); s1 = dv[q].y * s1 + pg8::bf_hi(wv[q]);
                base[(size_t)(j - 1) * jstride] = pk2(s0, s1); } }
        }
    }
}
template <int CTRL> __device__ __forceinline__ float dpp_add(float v) { return v + __builtin_bit_cast(float, __builtin_amdgcn_update_dpp(0, __builtin_bit_cast(int, v), CTRL, 0xf, 0xf, false)); }
#define HG_ISSUE_LOADS(cN, hN, dirN) do { \
        const size_t cb_ = ((size_t)128 * (cN)) * HGW + (hN) * 128; \
        hg_load8(WSP(bf16, WS_Z + ((dirN) ? Z_ZFB : Z_ZFF)) + cb_, sg, cq, zr); \
        const bool hs_ = !((dirN) == 1 && (cN) == 128); const bf16* sl_ = hg_slot(F, (dirN), hs_ ? (cN) : 1, (hN)); \
        _Pragma("unroll") for (int j_ = 0; j_ < 4; ++j_) { const int p_ = tid + 512 * j_; sraw[j_] = *(const GAS v4u*)(sl_ + (size_t)(p_ >> 4) * 128 + (p_ & 15) * 8); } } while (0)
__device__ __forceinline__ void hg_out_phase(Frame& F, bf16* yabase) {
    const int w = F.wave, vh = w >> 2, tb = vh ? 3 - (w & 3) : (w & 3);
    LAS float* tot = (LAS float*)(F.lds + HL_TOT); LAS float* er = (LAS float*)(F.lds + HL_ER); LAS float* ssqx = (LAS float*)(F.lds + HL_SSQ); LAS float* ox = (LAS float*)(F.lds);
    const lds_cptr QH = (lds_cptr)(F.lds + HL_QH), KH = (lds_cptr)(F.lds + HL_KH);
    const int nun = (512 - F.vcu + F.G - 1) / F.G;
    if (nun <= 0) return;
    u32x2g zr[8]; v4u sraw[4];
    { const int tid = threadIdx.x, cq = tid & 31, sg = tid >> 5; HG_ISSUE_LOADS(1 + (F.vcu >> 2), F.vcu & 3, 0); }
    f32x16 of0 = {}, of1 = {};
#pragma unroll 1
    for (int st = 0; st < 2 * nun; ++st) {
        int tid_ = threadIdx.x; asm volatile("" : "+v"(tid_));
        const int tid = tid_, lane = tid & 63, r = lane & 31, hi = lane >> 5, cq = tid & 31, sg = tid >> 5;
        const int uid = F.vcu + (st >> 1) * F.G, c = 1 + (uid >> 2), h = uid & 3, dir = st & 1;
        const bool hasS = !(dir == 1 && c == 128);
        const int sgu = dir ? 15 - sg : sg;
        u32x2g qr[8], vr[8];
        { const size_t cb = ((size_t)128 * c) * HGW + h * 128; hg_load8(WSP(bf16, WS_Z + Z_HQ) + cb, sg, cq, qr); hg_load8(WSP(bf16, WS_Z + Z_HV) + cb, sg, cq, vr); }
        float kk[4][8];
        const f32x4 own = hg_gates8(zr, kk, tot, sg, cq);
#pragma unroll
        for (int cc = 0; cc < 4; ++cc) *(LAS v4u*)(F.lds + HL_VT + (4 * cq + cc) * HL_PITCH + sgu * 16) = hg_pack8raw(vr, cc, dir);
        __syncthreads();
        f32x4 pre, rref, ball; hg_prefix(tot, own, sg, cq, dir, pre, rref, ball);
#pragma unroll
        for (int cc = 0; cc < 4; ++cc) {
            float qx[8], kx[8];
            if (dir) hg_pass2_out<1>(kk[cc], zr, qr, cc, pre[cc], rref[cc], qx, kx); else hg_pass2_out<0>(kk[cc], zr, qr, cc, pre[cc], rref[cc], qx, kx);
            const int off = hg_img_off(sgu >> 2, 4 * cq + cc, sgu & 3);
            *(LAS v4u*)(F.lds + HL_QH + off) = hg_pack8(qx, dir); *(LAS v4u*)(F.lds + HL_KH + off) = hg_pack8(kx, dir);
        }
        if (sg == 0) { f32x4 ee; ee[0] = __builtin_amdgcn_exp2f(rref[0]); ee[1] = __builtin_amdgcn_exp2f(rref[1]); ee[2] = __builtin_amdgcn_exp2f(rref[2]); ee[3] = __builtin_amdgcn_exp2f(rref[3]); *(LAS f32x4*)(er + 4 * cq) = ee; }
        __syncthreads();
        if (hasS) {
#pragma unroll
            for (int j = 0; j < 4; ++j) { const int p = tid + 512 * j, v = p >> 4, k8 = (p & 15) * 8;
                const v4u sv = sraw[j];
                const f32x4 e0 = *(const LAS f32x4*)(er + k8), e1 = *(const LAS f32x4*)(er + k8 + 4); v4u o;
                o.x = pk2(pg8::bf_lo(sv.x) * e0[0], pg8::bf_hi(sv.x) * e0[1]); o.y = pk2(pg8::bf_lo(sv.y) * e0[2], pg8::bf_hi(sv.y) * e0[3]);
                o.z = pk2(pg8::bf_lo(sv.z) * e1[0], pg8::bf_hi(sv.z) * e1[1]); o.w = pk2(pg8::bf_lo(sv.w) * e1[2], pg8::bf_hi(sv.w) * e1[3]);
                *(LAS v4u*)(F.lds + HL_ST + v * HL_PITCH + k8 * 2) = o; }
        }
        if (st + 1 < 2 * nun) { const int uidn = F.vcu + ((st + 1) >> 1) * F.G; HG_ISSUE_LOADS(1 + (uidn >> 2), uidn & 3, (st + 1) & 1); }
        __syncthreads();
        f32x16 o0 = {}, o1 = {};
        bf16x8 qf[8];
#pragma unroll
        for (int ks = 0; ks < 8; ++ks) qf[ks] = trfrag(QH, tb, ks, lane);
        if (hasS) {
#pragma unroll
            for (int ks = 0; ks < 8; ++ks) {
                const bf16x8 a = qf[ks];
                const bf16x8 b0 = *(const LAS bf16x8*)(F.lds + HL_ST + (64 * vh + r) * HL_PITCH + (16 * ks + 8 * hi) * 2);
                const bf16x8 b1 = *(const LAS bf16x8*)(F.lds + HL_ST + (64 * vh + 32 + r) * HL_PITCH + (16 * ks + 8 * hi) * 2);
                o0 = __builtin_amdgcn_mfma_f32_32x32x16_bf16(a, b0, o0, 0, 0, 0); o1 = __builtin_amdgcn_mfma_f32_32x32x16_bf16(a, b1, o1, 0, 0, 0);
            }
        }
#pragma unroll 1
        for (int sb = 0; sb <= tb; ++sb) {
            f32x16 ct = {};
#pragma unroll
            for (int ks = 0; ks < 8; ++ks) { const bf16x8 a = trfrag(KH, sb, ks, lane); ct = __builtin_amdgcn_mfma_f32_32x32x16_bf16(a, qf[ks], ct, 0, 0, 0); }
            if (sb == tb) {
                int rr = r - 4 * hi; asm volatile("" : "+v"(rr));
#pragma unroll
                for (int g = 0; g < 16; ++g) if ((g & 3) + 8 * (g >> 2) > rr) ct[g] = 0.f;
            }
            v4u pw[2];
#pragma unroll
            for (int s2 = 0; s2 < 2; ++s2) { pw[s2].x = pk2(ct[8 * s2], ct[8 * s2 + 1]); pw[s2].y = pk2(ct[8 * s2 + 2], ct[8 * s2 + 3]); pw[s2].z = pk2(ct[8 * s2 + 4], ct[8 * s2 + 5]); pw[s2].w = pk2(ct[8 * s2 + 6], ct[8 * s2 + 7]); }
#pragma unroll
            for (int s2 = 0; s2 < 2; ++s2) {
                const bf16x8 pa = __builtin_bit_cast(bf16x8, pw[s2]);
                const LAS unsigned char* v0 = F.lds + HL_VT + (64 * vh + r) * HL_PITCH + (32 * sb + 16 * s2 + 4 * hi) * 2; const LAS unsigned char* v1 = v0 + 32 * HL_PITCH;
                const s16x4 a0 = *(const LAS s16x4*)v0, a1 = *(const LAS s16x4*)(v0 + 16), c0 = *(const LAS s16x4*)v1, c1 = *(const LAS s16x4*)(v1 + 16);
                o0 = __builtin_amdgcn_mfma_f32_32x32x16_bf16(pa, (bf16x8){a0[0], a0[1], a0[2], a0[3], a1[0], a1[1], a1[2], a1[3]}, o0, 0, 0, 0);
                o1 = __builtin_amdgcn_mfma_f32_32x32x16_bf16(pa, (bf16x8){c0[0], c0[1], c0[2], c0[3], c1[0], c1[1], c1[2], c1[3]}, o1, 0, 0, 0);
            }
        }
        __syncthreads();
        if (dir == 0) { of0 = o0; of1 = o1; }
        else {
            int lane2 = lane; asm volatile("" : "+v"(lane2)); const int r2 = lane2 & 31, hi2 = lane2 >> 5;
            int ub = (32 * tb + 4 * hi2) * OX_PITCH + 64 * vh + r2; asm volatile("" : "+v"(ub));
#pragma unroll
            for (int g = 0; g < 16; ++g) { const int cg = ((g & 3) + 8 * (g >> 2)) * OX_PITCH; ox[ub + cg] = o0[g]; ox[ub + cg + 32] = o1[g]; }
            int tid2 = tid; asm volatile("" : "+v"(tid2));
            v4u hgr[4];
            { const bf16* hgp = WSP(bf16, WS_Z + Z_HG) + ((size_t)128 * c + (tid2 >> 2)) * HGW + h * 128 + 32 * (tid2 & 3);
#pragma unroll
              for (int j = 0; j < 4; ++j) hgr[j] = *(const GAS v4u*)(hgp + 8 * j); }
            const float* ow = F.in[10] + h * 128 + 64 * vh + r2; const float w0 = ow[0], w1 = ow[32];
            __syncthreads();
            int tbase = 32 * tb + 4 * hi2; asm volatile("" : "+v"(tbase));
            { const int rb = (127 - tbase) * OX_PITCH + 64 * vh + r2;
              float sqv[16];
#pragma unroll
              for (int g = 0; g < 16; ++g) { const int cg = (g & 3) + 8 * (g >> 2);
                of0[g] += ox[rb - cg * OX_PITCH]; of1[g] += ox[rb - cg * OX_PITCH + 32];
                sqv[g] = of0[g] * of0[g] + of1[g] * of1[g]; }
#pragma unroll
              for (int g = 0; g < 16; ++g) { float sq = sqv[g]; sq = dpp_add<0xB1>(sq); sq = dpp_add<0x4E>(sq); sq = dpp_add<0x141>(sq); sq = dpp_add<0x140>(sq); sqv[g] = sq; }
              if ((r2 & 15) == 0) {
#pragma unroll
                for (int g = 0; g < 16; ++g) { const int cg = (g & 3) + 8 * (g >> 2); ssqx[(tbase + cg) * 4 + 2 * vh + (r2 >> 4)] = sqv[g]; } } }
            __syncthreads();
            { const int yb = tbase * OX_PITCH + 64 * vh + r2;
#pragma unroll
              for (int g = 0; g < 16; ++g) { const int cg = (g & 3) + 8 * (g >> 2);
                const f32x4 pp = *(const LAS f32x4*)(ssqx + (tbase + cg) * 4);
                const float rn = rsqrtf(((pp[0] + pp[1]) + (pp[2] + pp[3])) * (1.0f / 128.0f) + pg8::RMS_EPS);
                ox[yb + cg * OX_PITCH] = of0[g] * rn * w0; ox[yb + cg * OX_PITCH + 32] = of1[g] * rn * w1; } }
            __syncthreads();
            { const int t = tid2 >> 2, c0 = 32 * (tid2 & 3);
              bf16* ya = yabase + ((size_t)128 * c + t) * HGW + h * 128 + c0;
#pragma unroll
              for (int j = 0; j < 4; ++j) { const f32x4 y0 = *(const LAS f32x4*)(ox + t * OX_PITCH + c0 + 8 * j), y1 = *(const LAS f32x4*)(ox + t * OX_PITCH + c0 + 8 * j + 4); const v4u gq = hgr[j]; v4u o;
                  o.x = pk2(y0[0] * pg8::bf_lo(gq.x), y0[1] * pg8::bf_hi(gq.x)); o.y = pk2(y0[2] * pg8::bf_lo(gq.y), y0[3] * pg8::bf_hi(gq.y));
                  o.z = pk2(y1[0] * pg8::bf_lo(gq.z), y1[1] * pg8::bf_hi(gq.z)); o.w = pk2(y1[2] * pg8::bf_lo(gq.w), y1[3] * pg8::bf_hi(gq.w));
                  *(GAS v4u*)(ya + 8 * j) = o; } }
            __syncthreads();
        }
    }
}
#undef HG_ISSUE_LOADS

struct Args { const float* in[20]; float* out; unsigned char* ws; int ph_lo, ph_hi; };
__global__ void __launch_bounds__(NWAVES * 64, 2) mk_fwd(Args args) {
    extern __shared__ __attribute__((aligned(16))) unsigned char lds[];
    Frame F;
    F.lds = (LAS unsigned char*)lds;
    F.MISC = (volatile LAS unsigned*)(F.lds + MISC_OFF);
    F.wave = __builtin_amdgcn_readfirstlane((int)threadIdx.x >> 6);
    F.G = gridDim.x; { const int bx = blockIdx.x; F.vcu = (F.G % 8 == 0) ? (bx % 8) * (F.G / 8) + bx / 8 : bx; }
    F.ws = args.ws; F.out = args.out;
#pragma unroll
    for (int i = 0; i < 20; ++i) F.in[i] = args.in[i];
    F.ctl = (gu32*)(F.ws + WS_CTL);
    for (int u = (int)threadIdx.x; u < (LDS_BYTES - LDSCTL_OFF) / 4; u += NWAVES * 64) ((LAS unsigned*)(F.lds + LDSCTL_OFF))[u] = 0u;
    __syncthreads();
    XcdBarrier bar; bar.bar = (unsigned*)(F.ctl + CW_BAR); bar.x = 0; bar.st = nullptr;
    if (N_LAUNCHES == 1) bar = xcd_barrier_post((unsigned*)(F.ctl + CW_BAR), F.MISC + 8);
    const int lo = args.ph_lo, hi = args.ph_hi;
    bf16* Wb = WSP(bf16, WS_W); bf16* HB = WSP(bf16, WS_HB); bf16* ACT = WSP(bf16, WS_Z); bf16* MIXED = WSP(bf16, WS_Z + Z_HV);

#ifndef PHMASK
#define PHMASK 0x7ff
#endif
#define IN(k) (((PHMASK >> (k)) & 1) && lo <= (k) && (k) < hi)
#define SEAM(k) do { if ((k) + 1 < hi) xcd_barrier(bar); } while (0)
#define PH_GATEUP(W_off, SSQ_off) do { \
        pg8::Gemm g{HB, Wb + (W_off) / 2, M, NGU, DM}; pg8::RsOrder S; S.init(M, NGU, F.G, (int)blockIdx.x); S.ssqp = WSP(float, SSQ_off); S.tab = (LAS float*)(F.lds + RS_OFF); S.prefill(); \
        pg8::EpiSwiglu E{ACT, (const LAS float*)(F.lds + RS_OFF), DFF}; \
        pg8::gemm_phase<pg8::EpiSwiglu, pg8::RsOrder, true, true>(F.lds + RING_OFF, g, S, E); } while (0)
#define PH_RES(Aptr, W_off, Kdim, BASE32, BASE16, OUT32, HBOUT, SSQOUT, SCALE) do { \
        pg8::Gemm g{Aptr, Wb + (W_off) / 2, M, DM, Kdim}; pg8::StaticOrder S; S.init(M, DM, F.G, (int)blockIdx.x); \
        if (S.nwg <= F.G) { pg8::EpiResT E{BASE16, OUT32, HBOUT, SSQOUT, SCALE}; pg8::gemm_phase<pg8::EpiResT, pg8::StaticOrder, true, true>(F.lds + RING_OFF, g, S, E); }     \
        else { pg8::EpiRes E{BASE32, BASE16, OUT32, HBOUT, SSQOUT, SCALE}; pg8::gemm_phase<pg8::EpiRes, pg8::StaticOrder, true, true>(F.lds + RING_OFF, g, S, E); } } while (0)

#ifndef DUP_PHASE
#define DUP_PHASE -1
#endif
#define DUP(k) (DUP_PHASE == (k))
    if (IN(0)) { if (DUP(0)) { p0_prologue(F); xcd_barrier(bar); } p0_prologue(F); SEAM(0); }
    if (IN(1)) { if (DUP(1)) { meta_p1(F); PH_GATEUP(W_GU1, WS_SSQ0); xcd_barrier(bar); } meta_p1(F); convert_in_idle_slot(F, (M / 256) * (NGU / 256), CV_FFN1, CV_IN); PH_GATEUP(W_GU1, WS_SSQ0); SEAM(1); }
    if (IN(2)) { if (DUP(2)) { meta_p2(F); PH_RES(ACT, W_D1, DFF, (const float*)nullptr, HB, (float*)nullptr, HB, WSP(float, WS_SSQ1), 0.5f); xcd_barrier(bar); } meta_p2(F); PH_RES(ACT, W_D1, DFF, (const float*)nullptr, HB, (float*)nullptr, HB, WSP(float, WS_SSQ1), 0.5f); SEAM(2); }
#define PH_MIX() do { \
        meta_p3(F); \
        pg8::Gemm g{HB, Wb + W_IN / 2, M, NIN, DM}; pg8::RsOrder S; S.init(M, NIN, F.G, (int)blockIdx.x); S.ssqp = WSP(float, WS_SSQ1); S.tab = (LAS float*)(F.lds + RS_OFF); S.prefill(); \
        pg8::EpiMix E{(const LAS float*)(F.lds + RS_OFF), WSP(bf16, WS_Z + Z_HQ) + 128 * HGW, WSP(bf16, WS_Z + Z_HV) + 128 * HGW, WSP(bf16, WS_Z + Z_ZFF) + 128 * HGW, WSP(bf16, WS_Z + Z_ZFB) + 128 * HGW, WSP(bf16, WS_Z + Z_HG) + 128 * HGW, \
                      WSP(bf16, WS_Z + Z_QO), WSP(bf16, WS_Z + Z_KB), WSP(bf16, WS_Z + Z_VB), WSP(bf16, WS_Z + Z_GA), WSP(bf16, WS_Z + Z_GB), \
                      F.in[11], F.in[12], WSP(pg8::f32x2, WS_MISC + MISC_ROPER), WSP(pg8::f32x2, WS_MISC + MISC_ROPEC), attn_body::C2, WSP(float, WS_MISC + MISC_OMLF), WSP(float, WS_MISC + MISC_OMLB)}; \
        pg8::gemm_phase<pg8::EpiMix, pg8::RsOrder, true, true>(F.lds + RING_OFF, g, S, E); } while (0)
    if (IN(3)) { if (DUP(3)) { PH_MIX(); xcd_barrier(bar); } convert_in_idle_slot(F, (M / 256) * (NIN / 256), CV_IN, CV_ALL); PH_MIX(); SEAM(3); }
    if (IN(4)) { if (DUP(4)) { hg_state_phase(F); xcd_barrier(bar); } hg_state_phase(F); SEAM(4); }
    if (IN(5)) {
        if (DUP(5)) { const attn_body::AttnTensors ATd{WSP(bf16, WS_Z + Z_QO), WSP(bf16, WS_Z + Z_KB), WSP(bf16, WS_Z + Z_VB), Wb, F.in[11], F.in[12]}; attn_body::attn_phase<8>((char*)lds + RING_OFF, ATd, F.vcu, F.G); xcd_barrier(bar); }
        hg_scan_phase(F);
        const attn_body::AttnTensors AT{WSP(bf16, WS_Z + Z_QO), WSP(bf16, WS_Z + Z_KB), WSP(bf16, WS_Z + Z_VB), WSP(bf16, WS_Z + Z_QO), F.in[11], F.in[12]};
        attn_body::attn_phase<8>((char*)lds + RING_OFF, AT, F.vcu, F.G);
        SEAM(5);
    }
    if (IN(6)) { if (DUP(6)) { hg_out_phase(F, Wb); xcd_barrier(bar); } hg_out_phase(F, WSP(bf16, WS_Z + Z_HQ)); SEAM(6); }
    for (int rep7 = 0; rep7 < (DUP(7) ? 2 : 1); ++rep7)
    if (IN(7)) {
        if (rep7) xcd_barrier(bar);
        pg8::Gemm g{WSP(bf16, WS_Z + Z_HQ) + 128 * HGW, Wb + W_UP / 2, 2 * M, 2 * DM, HGW}; pg8::UpOrder S; S.init(F.G, (int)blockIdx.x);
        pg8::EpiUp E{WSP(bf16, WS_Z + Z_GA), WSP(bf16, WS_Z + Z_GB), MIXED};
        pg8::gemm_phase<pg8::EpiUp, pg8::UpOrder, true, true>(F.lds + RING_OFF, g, S, E);
        SEAM(7);
    }
    if (IN(8)) { PH_RES(MIXED, W_OUT, DM, (const float*)nullptr, HB, (float*)nullptr, HB, WSP(float, WS_SSQ2), 1.0f); SEAM(8); }
    if (IN(9)) { if (DUP(9)) { PH_GATEUP(W_GU2, WS_SSQ2); xcd_barrier(bar); } stagger_short_share(F, (M / 256) * (NGU / 256), 3); PH_GATEUP(W_GU2, WS_SSQ2); SEAM(9); }
    if (IN(10)) { PH_RES(ACT, W_D2, DFF, (const float*)nullptr, HB, F.out, (bf16*)nullptr, (float*)nullptr, 0.5f);
    }
#undef IN
#undef SEAM
}

extern "C" void kernel_launch(void* const* d_in, const int* in_sizes, int n_in, void* d_out, int out_size, void* d_ws, size_t ws_size, hipStream_t stream) {
    static int grid = 0;
    if (grid == 0) {
        if (n_in != 20 || in_sizes[0] != M * DM || out_size != M * DM || ws_size < WS_END) { fprintf(stderr, "kernel_launch: built for 20 inputs, x/out of %d floats, >= %zu bytes of workspace; got n_in %d, in0 %d, out %d, ws %zu; nothing launched\n", M * DM, (size_t)WS_END, n_in, n_in > 0 ? in_sizes[0] : -1, out_size, ws_size); grid = -1; return; }
        int dev = 0, cus = 0, per_cu = 0;
        if (hipGetDevice(&dev) != hipSuccess || hipDeviceGetAttribute(&cus, hipDeviceAttributeMultiprocessorCount, dev) != hipSuccess) { fprintf(stderr, "kernel_launch: device query failed\n"); grid = -1; return; }
        if (hipFuncSetAttribute((const void*)mk_fwd, hipFuncAttributeMaxDynamicSharedMemorySize, LDS_BYTES) != hipSuccess) { fprintf(stderr, "kernel_launch: hipFuncSetAttribute failed\n"); grid = -1; return; }
        if (hipOccupancyMaxActiveBlocksPerMultiprocessor(&per_cu, (const void*)mk_fwd, NWAVES * 64, LDS_BYTES) != hipSuccess || per_cu < 1) { fprintf(stderr, "kernel_launch: occupancy query reports %d workgroups per CU\n", per_cu); per_cu = 1; }
        (void)hipGetLastError();
        if (cus < DFF / 16) { fprintf(stderr, "kernel_launch: %d CUs; the meta-token side path deals one job per workgroup and needs >= %d workgroups; nothing launched\n", cus, DFF / 16); grid = -1; return; }
        grid = cus;
    }
    if (grid < 0) return;
    if (hipMemsetAsync((char*)d_ws + WS_CTL, 0, CTL_ZERO_BYTES, stream) != hipSuccess) { fprintf(stderr, "kernel_launch: memset failed\n"); return; }
    Args a{};
    for (int i = 0; i < 20; ++i) a.in[i] = (const float*)d_in[i];
    a.out = (float*)d_out; a.ws = (unsigned char*)d_ws;
    for (int li = 0; li < N_LAUNCHES; ++li) {
        a.ph_lo = (N_LAUNCHES == 1) ? 0 : li; a.ph_hi = (N_LAUNCHES == 1) ? N_PHASES : li + 1;
        hipLaunchKernelGGL(mk_fwd, dim3(grid), dim3(NWAVES * 64), LDS_BYTES, stream, a);
        const hipError_t le = hipPeekAtLastError();
        if (le != hipSuccess) { fprintf(stderr, "kernel_launch: launch %d failed: %s\n", li, hipGetErrorName(le)); break; }
    }
}
```

```cpp
#include <hip/hip_runtime.h>
#include <cstdio>
#include <cstdint>
#include <cmath>
namespace pg8 {
#define PG8_LAS __attribute__((address_space(3)))
typedef unsigned short bf16_t;
typedef short bf16x8 __attribute__((ext_vector_type(8)));
typedef float f32x4 __attribute__((ext_vector_type(4)));
typedef unsigned u32x4 __attribute__((ext_vector_type(4)));
constexpr int BM = 256, BK = 64, HALF = 128, HTB = HALF * BK * 2  , STAGE_BYTES = 8 * HTB, NXCD = 8, WGM = 8;

__host__ __device__ __forceinline__ int lds_byte(int r, int c) { const int st = (r >> 4) * 2 + (c >> 5), rr = r & 15, cc = c & 31, ob = rr * 64 + cc * 2; return st * 1024 + (ob ^ (((ob >> 9) & 1) << 5)); }
__host__ __device__ __forceinline__ void stage_rc(int b, int& R, int& C) { const int st = b / 1024, sb = b % 1024, swz = sb ^ (((sb >> 9) & 1) << 5); R = (st >> 1) * 16 + swz / 64; C = (st & 1) * 32 + (swz % 64) / 2; }
__host__ __device__ __forceinline__ int perm32(int rho) { const int n = rho >> 4, i = rho & 15; return 8 * (i >> 2) + 4 * n + (i & 3); }

struct Unit { int pm, pn, idx; };
struct Gemm { const bf16_t* A; const bf16_t* Bt; int M, N, K; };

struct StaticOrder {
    int nM, nN, nwg, G, c;
    __host__ __device__ void init(int M, int N, int G_, int c_) { nM = M / BM; nN = N / BM; nwg = nM * nN; G = G_; c = c_; }
    __host__ __device__ bool next(int i, Unit& u) const {
        const long L = (long)i * G + c; if (L >= nwg) return false;
        int wgid = (int)L; { const int q = nwg / NXCD, r = nwg % NXCD, xcd = wgid % NXCD, off = wgid / NXCD; wgid = (xcd < r ? xcd * (q + 1) : r * (q + 1) + (xcd - r) * q) + off; }
        const int nig = WGM * nN, gid = wgid / nig, fm = gid * WGM, gsz = (nM - fm) < WGM ? (nM - fm) : WGM;
        u.pm = fm + ((wgid % nig) % gsz); u.pn = (wgid % nig) / gsz; u.idx = i; return true;
    }
    __device__ __forceinline__ void a_ready(const Unit&) const {}
    __device__ __forceinline__ void done(const Unit&) const {}
};


constexpr int RS_UNITS = 8;
struct RsOrder : StaticOrder {
    const float* ssqp; PG8_LAS float* tab;
    __device__ __forceinline__ void prefill() const {
        const int tid = threadIdx.x, row = tid >> 1, hf = tid & 1;
        f32x4 a[RS_UNITS], b[RS_UNITS]; bool ok[RS_UNITS]; Unit u0; next(0, u0);
#pragma unroll
        for (int i = 0; i < RS_UNITS; ++i) { Unit u; ok[i] = next(i, u); if (!ok[i]) u = u0;
            const f32x4* p = (const f32x4*)(ssqp + (size_t)(u.pm * BM + row) * 16 + hf * 8); a[i] = p[0]; b[i] = p[1]; }
#pragma unroll
        for (int i = 0; i < RS_UNITS; ++i) {
            float s = ((a[i][0] + a[i][1]) + (a[i][2] + a[i][3])) + ((b[i][0] + b[i][1]) + (b[i][2] + b[i][3]));
            s += __shfl_xor(s, 1);
            if (hf == 0 && ok[i]) tab[i * BM + row] = rsqrtf(s * (1.0f / 1024.0f) + 1e-6f);
        }
        __syncthreads();
    }
    __device__ __forceinline__ void a_ready(const Unit&) const {}
};

typedef float f32x2_cv __attribute__((ext_vector_type(2))); typedef __bf16 bf16x2_cv __attribute__((ext_vector_type(2)));
__device__ __forceinline__ unsigned cvt_pk_bf16(float lo, float hi) { f32x2_cv v = {lo, hi}; bf16x2_cv b = __builtin_convertvector(v, bf16x2_cv); return __builtin_bit_cast(unsigned, b); }
typedef float f32x2 __attribute__((ext_vector_type(2)));
typedef unsigned u32x2 __attribute__((ext_vector_type(2)));
__device__ __forceinline__ float bf_lo(unsigned w) { return __uint_as_float(w << 16); }
__device__ __forceinline__ float bf_hi(unsigned w) { return __uint_as_float(w & 0xffff0000u); }
__device__ __forceinline__ float fast_sigmoid(float v) { return __builtin_amdgcn_rcpf(1.0f + __expf(-v)); }
__device__ __forceinline__ float fast_silu(float v) { return v * __builtin_amdgcn_rcpf(1.0f + __expf(-v)); }
constexpr float RMS_EPS = 1e-6f;
__device__ __forceinline__ float rstd_from(const float* ssqp, int row) {
    const f32x4* p = (const f32x4*)(ssqp + (size_t)row * 16);
    const f32x4 a = p[0], b = p[1], c = p[2], d = p[3];
    const float s = (((a[0] + a[1]) + (a[2] + a[3])) + ((b[0] + b[1]) + (b[2] + b[3]))) + (((c[0] + c[1]) + (c[2] + c[3])) + ((d[0] + d[1]) + (d[2] + d[3])));
    return rsqrtf(s * (1.0f / 1024.0f) + RMS_EPS);
}

struct EpiSwiglu {
    static constexpr bool PERM = true, AFTER_DRAIN = false, KEEP_ACC = false;
    bf16_t* O; const PG8_LAS float* tab; int ldo;
    __device__ __forceinline__ void operator()(const f32x4 (&acc)[2][2][4][2], const Unit& u, int wr, int wc, int fr, int fq) const {
        const int row0 = u.pm * BM + wr * 64 + fr, col0 = u.pn * HALF + wc * 32 + 8 * fq;
#pragma unroll
        for (int ai = 0; ai < 2; ++ai)
#pragma unroll
            for (int m = 0; m < 4; ++m) {
                const int row = row0 + ai * HALF + m * 16; const float rs = tab[u.idx * BM + ai * HALF + wr * 64 + m * 16 + fr];
                float o[8];
#pragma unroll
                for (int n = 0; n < 2; ++n)
#pragma unroll
                    for (int i = 0; i < 4; ++i) { const float g = acc[ai][0][m][n][i] * rs, up = acc[ai][1][m][n][i] * rs; o[4 * n + i] = fast_silu(g) * up; }
                u32x4 w; w.x = cvt_pk_bf16(o[0], o[1]); w.y = cvt_pk_bf16(o[2], o[3]); w.z = cvt_pk_bf16(o[4], o[5]); w.w = cvt_pk_bf16(o[6], o[7]);
                *(u32x4*)(O + (size_t)row * ldo + col0) = w;
            }
    }
};

struct EpiRes {
    static constexpr bool PERM = false, AFTER_DRAIN = false, KEEP_ACC = false;
    const float* base32; const bf16_t* base16; float* out32; bf16_t* hb; float* ssqp; float scale;
    __device__ __forceinline__ void operator()(const f32x4 (&acc)[2][2][4][2], const Unit& u, int wr, int wc, int fr, int fq) const {
        const int row0 = u.pm * BM + wr * 64 + fr, col0 = u.pn * BM + wc * 32 + 4 * fq;
#pragma unroll
        for (int ai = 0; ai < 2; ++ai)
#pragma unroll
            for (int m = 0; m < 4; ++m) {
                const int row = row0 + ai * HALF + m * 16; const size_t off = (size_t)row * 1024 + col0; float ss = 0.f;
                f32x4 b[2][2];
#pragma unroll
                for (int bj = 0; bj < 2; ++bj)
#pragma unroll
                    for (int n = 0; n < 2; ++n) {
                        if (base32) b[bj][n] = *(const f32x4*)(base32 + off + bj * HALF + n * 16);
                        else { const u32x2 w = *(const u32x2*)(base16 + off + bj * HALF + n * 16); b[bj][n] = (f32x4){bf_lo(w.x), bf_hi(w.x), bf_lo(w.y), bf_hi(w.y)}; }
                    }
#pragma unroll
                for (int bj = 0; bj < 2; ++bj)
#pragma unroll
                    for (int n = 0; n < 2; ++n) {
                        const f32x4 v = b[bj][n] + acc[ai][bj][m][n] * scale;
                        if (out32) *(f32x4*)(out32 + off + bj * HALF + n * 16) = v;
                        if (hb) { u32x2 w; w.x = cvt_pk_bf16(v[0], v[1]); w.y = cvt_pk_bf16(v[2], v[3]); *(u32x2*)(hb + off + bj * HALF + n * 16) = w; }
                        ss += (v[0] * v[0] + v[1] * v[1]) + (v[2] * v[2] + v[3] * v[3]);
                    }
                if (ssqp) { ss += __shfl_xor(ss, 16); ss += __shfl_xor(ss, 32); if (fq == 0) ssqp[(size_t)row * 16 + u.pn * 4 + wc] = ss; }
            }
    }
};

template <int CTRL> __device__ __forceinline__ float dpp_addf(float v) { return v + __builtin_bit_cast(float, __builtin_amdgcn_update_dpp(0, __builtin_bit_cast(int, v), CTRL, 0xf, 0xf, false)); }
struct EpiResT {
    static constexpr bool PERM = false, AFTER_DRAIN = true, KEEP_ACC = false;
    static constexpr int TP = 260;
    const bf16_t* base16; float* out32; bf16_t* hb; float* ssqp; float scale;
    __device__ __forceinline__ void operator()(const f32x4 (&)[2][2][4][2], const Unit&, int, int, int, int) const {}
    __device__ __forceinline__ void fused(const f32x4 (&acc)[2][2][4][2], const Unit& u, int wr, int wc, int fr, int fq, PG8_LAS unsigned char* lds, int wid, int lane) const {
        PG8_LAS float* T = (PG8_LAS float*)lds;
        const int tid = wid * 64 + lane, rr = tid >> 5, cc = (tid & 31) * 8;
#pragma unroll
        for (int ai = 0; ai < 2; ++ai) {
            const size_t g0 = (size_t)(u.pm * BM + ai * HALF + rr) * 1024 + u.pn * BM + cc;
            u32x4 bq[8];
#pragma unroll
            for (int i = 0; i < 8; ++i) bq[i] = *(const u32x4*)(base16 + g0 + (size_t)(16 * i) * 1024);
#pragma unroll
            for (int bj = 0; bj < 2; ++bj)
#pragma unroll
                for (int m = 0; m < 4; ++m)
#pragma unroll
                    for (int n = 0; n < 2; ++n) *(PG8_LAS f32x4*)(T + (wr * 64 + 16 * m + fr) * TP + bj * HALF + wc * 32 + 16 * n + 4 * fq) = acc[ai][bj][m][n];
            __syncthreads();
#pragma unroll
            for (int i = 0; i < 8; ++i) {
                const f32x4 a0 = *(const PG8_LAS f32x4*)(T + (rr + 16 * i) * TP + cc), a1 = *(const PG8_LAS f32x4*)(T + (rr + 16 * i) * TP + cc + 4);
                const u32x4 w = bq[i]; const size_t g = g0 + (size_t)(16 * i) * 1024;
                const f32x4 v0 = (f32x4){bf_lo(w.x), bf_hi(w.x), bf_lo(w.y), bf_hi(w.y)} + a0 * scale, v1 = (f32x4){bf_lo(w.z), bf_hi(w.z), bf_lo(w.w), bf_hi(w.w)} + a1 * scale;
                if (out32) { *(f32x4*)(out32 + g) = v0; *(f32x4*)(out32 + g + 4) = v1; }
                if (hb) { u32x4 o; o.x = cvt_pk_bf16(v0[0], v0[1]); o.y = cvt_pk_bf16(v0[2], v0[3]); o.z = cvt_pk_bf16(v1[0], v1[1]); o.w = cvt_pk_bf16(v1[2], v1[3]); *(u32x4*)(hb + g) = o; }
                if (ssqp) {
                    float ss = ((v0[0] * v0[0] + v0[1] * v0[1]) + (v0[2] * v0[2] + v0[3] * v0[3])) + ((v1[0] * v1[0] + v1[1] * v1[1]) + (v1[2] * v1[2] + v1[3] * v1[3]));
                    ss = dpp_addf<0xB1>(ss); ss = dpp_addf<0x4E>(ss); ss = dpp_addf<0x141>(ss);
                    if ((tid & 7) == 0) ssqp[(size_t)(u.pm * BM + ai * HALF + rr + 16 * i) * 16 + u.pn * 4 + ((tid & 31) >> 3)] = ss;
                }
            }
            __syncthreads();
        }
    }
};

struct EpiMix {
    static constexpr bool PERM = true, AFTER_DRAIN = false, KEEP_ACC = false;
    const PG8_LAS float* tab;
    bf16_t *HQ, *HV, *ZFF, *ZFB, *HG;
    bf16_t *QO; bf16_t *KB, *VB;
    bf16_t *GA, *GB;
    const float *qnw, *knw; const f32x2* ropeR; const f32x2* ropeC; float c2; const float *omlf, *omlb;
    template <int ACT>
    __device__ __forceinline__ void ew_store(const f32x4 (&acc)[2][2][4][2], const Unit& u, bf16_t* dst, int pitch, int row0, int col0, int wr, int fr, const float* oml = nullptr) const {
        float om[2][8];
        if (ACT == 3) {
#pragma unroll
            for (int bj = 0; bj < 2; ++bj) { const f32x4 a = *(const f32x4*)(oml + col0 + bj * HALF), b = *(const f32x4*)(oml + col0 + bj * HALF + 4); om[bj][0] = a[0]; om[bj][1] = a[1]; om[bj][2] = a[2]; om[bj][3] = a[3]; om[bj][4] = b[0]; om[bj][5] = b[1]; om[bj][6] = b[2]; om[bj][7] = b[3]; }
        }
#pragma unroll
        for (int ai = 0; ai < 2; ++ai)
#pragma unroll
            for (int m = 0; m < 4; ++m) {
                const int row = row0 + ai * HALF + m * 16; const float rs = tab[u.idx * BM + ai * HALF + wr * 64 + m * 16 + fr];
#pragma unroll
                for (int bj = 0; bj < 2; ++bj) {
                    float o[8];
#pragma unroll
                    for (int n = 0; n < 2; ++n)
#pragma unroll
                        for (int i = 0; i < 4; ++i) { const float v = acc[ai][bj][m][n][i] * rs;
                            if (ACT == 3) o[4 * n + i] = __builtin_amdgcn_logf(1.0f - om[bj][4 * n + i] * __builtin_amdgcn_rcpf(1.0f + __builtin_amdgcn_exp2f(v * 1.4426950408889634f)));
                            else o[4 * n + i] = (ACT == 0) ? v : ((ACT == 1) ? fast_silu(v) : fast_sigmoid(v)); }
                    u32x4 w; w.x = cvt_pk_bf16(o[0], o[1]); w.y = cvt_pk_bf16(o[2], o[3]); w.z = cvt_pk_bf16(o[4], o[5]); w.w = cvt_pk_bf16(o[6], o[7]);
                    *(u32x4*)(dst + (size_t)row * pitch + col0 + bj * HALF) = w;
                }
            }
    }
    __device__ __forceinline__ void operator()(const f32x4 (&acc)[2][2][4][2], const Unit& u, int wr, int wc, int fr, int fq) const {
        const int row0 = u.pm * BM + wr * 64 + fr; const int pn = u.pn;
        if (pn >= 13) {
            const int col0 = (pn - 13) * HALF + wc * 32 + 8 * fq;
#pragma unroll
            for (int ai = 0; ai < 2; ++ai)
#pragma unroll
                for (int m = 0; m < 4; ++m) {
                    const int row = row0 + ai * HALF + m * 16; const float rs = tab[u.idx * BM + ai * HALF + wr * 64 + m * 16 + fr];
                    float sb[8], ra[8];
#pragma unroll
                    for (int n = 0; n < 2; ++n)
#pragma unroll
                        for (int i = 0; i < 4; ++i) sb[4 * n + i] = fmaxf(fast_sigmoid(acc[ai][1][m][n][i] * rs), 1e-30f);
                    u32x4 wb; wb.x = cvt_pk_bf16(sb[0], sb[1]); wb.y = cvt_pk_bf16(sb[2], sb[3]); wb.z = cvt_pk_bf16(sb[4], sb[5]); wb.w = cvt_pk_bf16(sb[6], sb[7]);
                    const float gbr[8] = {bf_lo(wb.x), bf_hi(wb.x), bf_lo(wb.y), bf_hi(wb.y), bf_lo(wb.z), bf_hi(wb.z), bf_lo(wb.w), bf_hi(wb.w)};
#pragma unroll
                    for (int n = 0; n < 2; ++n)
#pragma unroll
                        for (int i = 0; i < 4; ++i) ra[4 * n + i] = fast_sigmoid(acc[ai][0][m][n][i] * rs) * __builtin_amdgcn_rcpf(gbr[4 * n + i]);
                    u32x4 wa; wa.x = cvt_pk_bf16(ra[0], ra[1]); wa.y = cvt_pk_bf16(ra[2], ra[3]); wa.z = cvt_pk_bf16(ra[4], ra[5]); wa.w = cvt_pk_bf16(ra[6], ra[7]);
                    *(u32x4*)(GA + (size_t)row * 1024 + col0) = wa; *(u32x4*)(GB + (size_t)row * 1024 + col0) = wb;
                }
        } else if (pn < 10) {
            bf16_t* dst; int pitch, ct, act; const float* oml = nullptr;
            if (pn < 2) { dst = HQ; pitch = 512; ct = pn; act = 1; }
            else if (pn < 4) { dst = HV; pitch = 512; ct = pn - 2; act = 0; }
            else if (pn < 6) { dst = ZFF; pitch = 512; ct = pn - 4; act = 3; oml = omlf; }
            else if (pn < 8) { dst = ZFB; pitch = 512; ct = pn - 6; act = 3; oml = omlb; }
            else { dst = HG; pitch = 512; ct = pn - 8; act = 1; }
            const int col0 = ct * BM + wc * 32 + 8 * fq;
            if (act == 0) ew_store<0>(acc, u, dst, pitch, row0, col0, wr, fr); else if (act == 1) ew_store<1>(acc, u, dst, pitch, row0, col0, wr, fr); else if (act == 2) ew_store<2>(acc, u, dst, pitch, row0, col0, wr, fr); else ew_store<3>(acc, u, dst, pitch, row0, col0, wr, fr, oml);
        } else {
            const bool isv = (pn == 12) && (wc >= 2);
            const bool isq = (pn < 12);
            bf16_t* dst; int pitch, hcol;
            if (isq) { dst = QO; pitch = 512; hcol = (4 * (pn - 10) + wc) * 64; }
            else if (!isv) { dst = KB; pitch = 128; hcol = wc * 64; }
            else { dst = VB; pitch = 128; hcol = (wc - 2) * 64; }
            const float* nw = isq ? qnw : knw; const float osc = isq ? c2 : 1.0f;
            float wgt[2][8];
#pragma unroll
            for (int bj = 0; bj < 2; ++bj)
#pragma unroll
                for (int j = 0; j < 8; ++j) wgt[bj][j] = nw[32 * bj + 8 * fq + j] * osc;
#pragma unroll
            for (int ai = 0; ai < 2; ++ai)
#pragma unroll
                for (int m = 0; m < 4; ++m) {
                    const int row = row0 + ai * HALF + m * 16; const float rs = tab[u.idx * BM + ai * HALF + wr * 64 + m * 16 + fr];
                    float x[2][8]; float ss = 0.f;
#pragma unroll
                    for (int bj = 0; bj < 2; ++bj)
#pragma unroll
                        for (int n = 0; n < 2; ++n)
#pragma unroll
                            for (int i = 0; i < 4; ++i) { const float v = acc[ai][bj][m][n][i] * rs; x[bj][4 * n + i] = v; ss += v * v; }
                    if (!isv) {
                        ss += __shfl_xor(ss, 16); ss += __shfl_xor(ss, 32);
                        const float rn = rsqrtf(ss * (1.0f / 64.0f) + RMS_EPS);
                        const int rpos = row >> 6, cpos = row & 63;
#pragma unroll
                        for (int bj = 0; bj < 2; ++bj) {
                            const f32x2* tab = (bj == 0 ? ropeR + rpos * 16 : ropeC + cpos * 16) + 4 * fq;
#pragma unroll
                            for (int pr = 0; pr < 4; ++pr) {
                                const f32x2 cs = tab[pr];
                                const float a = x[bj][2 * pr] * rn * wgt[bj][2 * pr], b = x[bj][2 * pr + 1] * rn * wgt[bj][2 * pr + 1];
                                x[bj][2 * pr] = a * cs.x - b * cs.y; x[bj][2 * pr + 1] = a * cs.y + b * cs.x;
                            }
                        }
                    }
#pragma unroll
                    for (int bj = 0; bj < 2; ++bj) {
                        u32x4 w; w.x = cvt_pk_bf16(x[bj][0], x[bj][1]); w.y = cvt_pk_bf16(x[bj][2], x[bj][3]); w.z = cvt_pk_bf16(x[bj][4], x[bj][5]); w.w = cvt_pk_bf16(x[bj][6], x[bj][7]);
                        *(u32x4*)(dst + (size_t)row * pitch + hcol + 32 * bj + 8 * fq) = w;
                    }
                }
        }
    }
};

struct EpiUp {
    static constexpr bool PERM = true, AFTER_DRAIN = false, KEEP_ACC = true;
    const bf16_t *R, *GB; bf16_t* MX;
    __device__ __forceinline__ bool keep(const Unit& u) const { return u.pn < 4; }
    __device__ __forceinline__ void operator()(f32x4 (&acc)[2][2][4][2], const Unit& u, int wr, int wc, int fr, int fq) const {
        const int z = (u.pn >= 4) ? 1 : 0; const int pm = u.pm - 64 * z, pn = u.pn - 4 * z;
        const bf16_t* G = z ? GB : R;
        const int row0 = pm * BM + wr * 64 + fr, col0 = pn * BM + wc * 32 + 8 * fq;
        u32x4 gq[16];
#define UP_OFF(it) ((size_t)(row0 + ((it) >> 3) * HALF + (((it) >> 1) & 3) * 16) * 1024 + col0 + ((it) & 1) * HALF)
#pragma unroll
        for (int it = 0; it < 4; ++it) gq[it] = *(const u32x4*)(G + UP_OFF(it));
#pragma unroll
        for (int it = 0; it < 16; ++it) {
            const int ai = it >> 3, m = (it >> 1) & 3, bj = it & 1;
            const u32x4 g = gq[it];
            if (it + 4 < 16) gq[it + 4] = *(const u32x4*)(G + UP_OFF(it + 4));
            const f32x4 g0 = {bf_lo(g.x), bf_hi(g.x), bf_lo(g.y), bf_hi(g.y)}, g1 = {bf_lo(g.z), bf_hi(g.z), bf_lo(g.w), bf_hi(g.w)};
            const f32x4 o0 = acc[ai][bj][m][0] * g0, o1 = acc[ai][bj][m][1] * g1;
            if (!z) { acc[ai][bj][m][0] = o0; acc[ai][bj][m][1] = o1; }
            else { u32x4 w; w.x = cvt_pk_bf16(o0[0], o0[1]); w.y = cvt_pk_bf16(o0[2], o0[3]); w.z = cvt_pk_bf16(o1[0], o1[1]); w.w = cvt_pk_bf16(o1[2], o1[3]);
                *(u32x4*)(MX + UP_OFF(it)) = w; }
        }
#undef UP_OFF
    }
};
struct UpOrder {
    StaticOrder so;
    __device__ void init(int G_, int c_) { so.init(16384, 1024, G_, c_); }
    __device__ bool next(int i, Unit& u) const {
        const int rounds = (so.nwg + so.G - 1) / so.G; if (i >= 2 * rounds) return false;
        Unit t; if (!so.next(i >> 1, t)) return false;
        const int z = i & 1; u.pm = t.pm + 64 * z; u.pn = t.pn + 4 * z; u.idx = i; return true;
    }
    __device__ __forceinline__ void a_ready(const Unit&) const {}
    __device__ __forceinline__ void done(const Unit&) const {}
};
template <class Epi, class Sched, bool ALIGN_EPI = false, bool SP2 = false>
__device__ __forceinline__ void gemm_phase(PG8_LAS unsigned char* lds, const Gemm g, const Sched& S, const Epi& E) {
    int tid_ = threadIdx.x; asm volatile("" : "+v"(tid_));
    const int tid = tid_, wid = __builtin_amdgcn_readfirstlane(tid >> 6), lane = tid & 63, wr = wid >> 2, wc = wid & 3, fr = lane & 15, fq = lane >> 4;
    const int K = g.K, nt = K / BK;
    unsigned voffA[2], voffB[2];
#pragma unroll
    for (int i = 0; i < 2; ++i) { int R, C; stage_rc(tid * 16 + i * 8192, R, C); const int Rb = Epi::PERM ? ((R & ~31) + perm32(R & 31)) : R;
        voffA[i] = (unsigned)(R * K + C) * 2u; voffB[i] = (unsigned)(Rb * K + C) * 2u; }
    const size_t kstep = (size_t)(BK * 2);
    const size_t hstep = (size_t)HALF * K * 2;
    const size_t tstep = 2 * hstep;
    const unsigned ldsw = (unsigned)wid * 1024u;
    const int aoff = lds_byte(wr * 64 + fr, fq * 8), boff = lds_byte(wc * 32 + fr, fq * 8);
#define PG8_SA(b, h) (((b) * 2 + (h)) * HTB)
#define PG8_SB(b, h) ((4 + (b) * 2 + (h)) * HTB)
#define PG8_STAGE(bufoff, gbase, voff) do { _Pragma("unroll") for (int _i = 0; _i < 2; ++_i) \
        __builtin_amdgcn_global_load_lds((const unsigned*)((const char*)(gbase) + (voff)[_i]), (PG8_LAS unsigned*)(lds + (bufoff) + ldsw + _i * 8192), 16, 0, 0); } while (0)
#define PG8_LDA(dst, b, h) do { _Pragma("unroll") for (int m = 0; m < 4; ++m) _Pragma("unroll") for (int k = 0; k < 2; ++k) dst[m][k] = *(const PG8_LAS bf16x8*)(lds + PG8_SA(b, h) + aoff + m * 2048 + k * 1024); } while (0)
#define PG8_LDB(dst, b, h) do { _Pragma("unroll") for (int n = 0; n < 2; ++n) _Pragma("unroll") for (int k = 0; k < 2; ++k) dst[n][k] = *(const PG8_LAS bf16x8*)(lds + PG8_SB(b, h) + boff + n * 2048 + k * 1024); } while (0)
#define PG8_MMA(ai, bj, At, Bt) do { __builtin_amdgcn_s_setprio(1); _Pragma("unroll") for (int m = 0; m < 4; ++m) _Pragma("unroll") for (int n = 0; n < 2; ++n) _Pragma("unroll") for (int k = 0; k < 2; ++k) \
        acc[ai][bj][m][n] = __builtin_amdgcn_mfma_f32_16x16x32_bf16(Bt[n][k], At[m][k], acc[ai][bj][m][n], 0, 0, 0); __builtin_amdgcn_s_setprio(0); } while (0)
#define PG8_WAIT_V(n) asm volatile("s_waitcnt vmcnt(" #n ")" ::: "memory")
#define PG8_WAIT_L(n) asm volatile("s_waitcnt lgkmcnt(" #n ")" ::: "memory")
#define PG8_BAR __builtin_amdgcn_s_barrier()
#define PG8_SCHED __builtin_amdgcn_sched_barrier(0)
    Unit cur, nxt; int ui = 0;
    if (!S.next(0, cur)) return;
    f32x4 acc[2][2][4][2];
#pragma unroll
    for (int a = 0; a < 2; ++a)
#pragma unroll
        for (int b = 0; b < 2; ++b)
#pragma unroll
            for (int m = 0; m < 4; ++m)
#pragma unroll
                for (int n = 0; n < 2; ++n) acc[a][b][m][n] = (f32x4){0.f, 0.f, 0.f, 0.f};
    bf16x8 At[4][2], B0[2][2], B1[2][2];
    const char* cA = (const char*)g.A + (size_t)cur.pm * tstep; const char* cB = (const char*)g.Bt + (size_t)cur.pn * tstep;
    S.a_ready(cur);
    if constexpr (SP2) {
        PG8_STAGE(PG8_SB(0, 0), cB, voffB); PG8_STAGE(PG8_SB(0, 1), cB + hstep, voffB); PG8_STAGE(PG8_SA(0, 0), cA, voffA); PG8_STAGE(PG8_SA(0, 1), cA + hstep, voffA);
        if (wr == 1) PG8_BAR;
        PG8_WAIT_V(2); PG8_BAR;
        PG8_STAGE(PG8_SB(1, 0), cB + kstep, voffB); PG8_STAGE(PG8_SB(1, 1), cB + hstep + kstep, voffB);
        PG8_WAIT_V(4); PG8_BAR;
    } else {
        PG8_STAGE(PG8_SB(0, 0), cB, voffB); PG8_STAGE(PG8_SA(0, 0), cA, voffA); PG8_STAGE(PG8_SB(0, 1), cB + hstep, voffB); PG8_STAGE(PG8_SA(0, 1), cA + hstep, voffA);
        if (wr == 1) PG8_BAR;
        PG8_WAIT_V(4); PG8_BAR;
        PG8_STAGE(PG8_SB(1, 0), cB + kstep, voffB); PG8_STAGE(PG8_SA(1, 0), cA + kstep, voffA); PG8_STAGE(PG8_SB(1, 1), cB + hstep + kstep, voffB);
        PG8_WAIT_V(6); PG8_BAR;
    }
    for (;;) {
        const bool has_next = S.next(ui + 1, nxt);
        const char* nA = has_next ? (const char*)g.A + (size_t)nxt.pm * tstep : cA; const char* nB = has_next ? (const char*)g.Bt + (size_t)nxt.pn * tstep : cB;
        for (int t = 0; t < nt; t += 2) {
            const bool last = (t == nt - 2);
            const char* a1 = cA + (size_t)(t + 1) * kstep;
            const char* a2 = last ? nA : cA + (size_t)(t + 2) * kstep; const char* b2 = last ? nB : cB + (size_t)(t + 2) * kstep;
            const char* a3 = a2 + kstep; const char* b3 = b2 + kstep;
            if (last && has_next) S.a_ready(nxt);
            const bool fin = SP2 && last && !has_next;
#define PG8_WVF(nn, nf) do { if (fin) { PG8_WAIT_V(nf); } else { PG8_WAIT_V(nn); } } while (0)
            if constexpr (SP2) {
            PG8_LDB(B0, 0, 0); PG8_LDB(B1, 0, 1); PG8_SCHED; PG8_LDA(At, 0, 0); PG8_STAGE(PG8_SA(1, 0), a1, voffA); PG8_STAGE(PG8_SA(1, 1), a1 + hstep, voffA);
            PG8_WAIT_V(8); PG8_WAIT_L(0); PG8_BAR; PG8_MMA(0, 0, At, B0); PG8_MMA(0, 1, At, B1); PG8_BAR; PG8_SCHED;
            PG8_LDA(At, 0, 1); if (!fin) { PG8_STAGE(PG8_SB(0, 0), b2, voffB); PG8_STAGE(PG8_SB(0, 1), b2 + hstep, voffB); }
            PG8_WVF(6, 2); PG8_WAIT_L(0); PG8_BAR; PG8_MMA(1, 0, At, B0); PG8_MMA(1, 1, At, B1); PG8_BAR; PG8_SCHED;
            PG8_LDB(B0, 1, 0); PG8_LDB(B1, 1, 1); PG8_SCHED; PG8_LDA(At, 1, 0); if (!fin) { PG8_STAGE(PG8_SA(0, 0), a2, voffA); PG8_STAGE(PG8_SA(0, 1), a2 + hstep, voffA); }
            PG8_WVF(8, 0); PG8_WAIT_L(0); PG8_BAR; PG8_MMA(0, 0, At, B0); PG8_MMA(0, 1, At, B1); PG8_BAR; PG8_SCHED;
            PG8_LDA(At, 1, 1); if (!fin) { PG8_STAGE(PG8_SB(1, 0), b3, voffB); PG8_STAGE(PG8_SB(1, 1), b3 + hstep, voffB); }
            PG8_WVF(6, 0); PG8_WAIT_L(0); PG8_BAR; PG8_MMA(1, 0, At, B0); PG8_MMA(1, 1, At, B1); PG8_BAR; PG8_SCHED;
            } else {
            PG8_LDB(B0, 0, 0); PG8_SCHED; PG8_LDA(At, 0, 0); PG8_STAGE(PG8_SA(1, 1), a1 + hstep, voffA);
            PG8_WAIT_L(8); PG8_BAR; PG8_WAIT_L(0); PG8_MMA(0, 0, At, B0); PG8_BAR; PG8_SCHED;
            PG8_LDB(B1, 0, 1); PG8_STAGE(PG8_SB(0, 0), b2, voffB);
            PG8_BAR; PG8_WAIT_L(0); PG8_MMA(0, 1, At, B1); PG8_BAR;
            PG8_LDA(At, 0, 1); PG8_STAGE(PG8_SA(0, 0), a2, voffA);
            PG8_BAR; PG8_WAIT_L(0); PG8_MMA(1, 0, At, B0); PG8_BAR; PG8_SCHED;
            PG8_STAGE(PG8_SB(0, 1), b2 + hstep, voffB);
            PG8_WAIT_V(6); PG8_BAR; PG8_MMA(1, 1, At, B1); PG8_BAR;
            PG8_LDB(B0, 1, 0); PG8_SCHED; PG8_LDA(At, 1, 0); PG8_STAGE(PG8_SA(0, 1), a2 + hstep, voffA);
            PG8_WAIT_L(8); PG8_BAR; PG8_WAIT_L(0); PG8_MMA(0, 0, At, B0); PG8_BAR; PG8_SCHED;
            PG8_LDB(B1, 1, 1); PG8_STAGE(PG8_SB(1, 0), b3, voffB);
            PG8_BAR; PG8_WAIT_L(0); PG8_MMA(0, 1, At, B1); PG8_BAR;
            PG8_LDA(At, 1, 1); PG8_STAGE(PG8_SA(1, 0), a3, voffA);
            PG8_BAR; PG8_WAIT_L(0); PG8_MMA(1, 0, At, B0); PG8_BAR; PG8_SCHED;
            PG8_STAGE(PG8_SB(1, 1), b3 + hstep, voffB);
            PG8_WAIT_V(6); PG8_BAR; PG8_MMA(1, 1, At, B1); PG8_BAR;
            }
        }
        if constexpr (ALIGN_EPI) { if (wr == 0) PG8_BAR; }
        if constexpr (!Epi::AFTER_DRAIN) { E(acc, cur, wr, wc, fr, fq); S.done(cur); }
        bool keep_acc = false; if constexpr (Epi::KEEP_ACC) keep_acc = E.keep(cur);
        if (!has_next) break;
        if (!keep_acc)
#pragma unroll
        for (int a = 0; a < 2; ++a)
#pragma unroll
            for (int b = 0; b < 2; ++b)
#pragma unroll
                for (int m = 0; m < 4; ++m)
#pragma unroll
                    for (int n = 0; n < 2; ++n) acc[a][b][m][n] = (f32x4){0.f, 0.f, 0.f, 0.f};
        cur = nxt; cA = nA; cB = nB; ++ui;
        if constexpr (ALIGN_EPI) { if (wr == 1) PG8_BAR; }
    }
    PG8_WAIT_V(0);
    if constexpr (!ALIGN_EPI) { if (wr == 0) PG8_BAR; }
    PG8_BAR;
    if constexpr (Epi::AFTER_DRAIN) { E.fused(acc, cur, wr, wc, fr, fq, lds, wid, lane); S.done(cur); }
#undef PG8_SA
#undef PG8_SB
#undef PG8_STAGE
#undef PG8_LDA
#undef PG8_LDB
#undef PG8_MMA
#undef PG8_WAIT_V
#undef PG8_WAIT_L
#undef PG8_BAR
#undef PG8_SCHED
#undef PG8_WVF
}
}
namespace attn_body {
using bf16=unsigned short;
__device__ __forceinline__ unsigned short f2bf16(float f){unsigned u=__builtin_bit_cast(unsigned,f);return (unsigned short)((u+0x7fffu+((u>>16)&1u))>>16);}
using bf16x8=__attribute__((ext_vector_type(8)))short;
using s16x4=__attribute__((ext_vector_type(4)))short;
using f32x16=__attribute__((ext_vector_type(16)))float;
using u32x4=__attribute__((ext_vector_type(4)))unsigned;
constexpr int D=64,QP=512,KP=128;
constexpr int NW=8,QBLK=32,QB=QBLK*NW,KVBLK=64;
constexpr int NT=258;
constexpr int ATTN_UNIT_ROWS=QB;
__device__ __forceinline__ int crow(int r,int hi){return (r&3)+8*(r>>2)+4*hi;}
#define SBAR() __builtin_amdgcn_sched_barrier(0)
__device__ __forceinline__ void cmask(f32x16&p0,f32x16&p1,int jb){
  const float NEG=-INFINITY;
  if(jb==2){
    #pragma unroll
    for(int r=8;r<16;++r)p0[r]=NEG;
    #pragma unroll
    for(int r=0;r<16;++r)p1[r]=NEG;
  } else if(jb==3){
    #pragma unroll
    for(int r=0;r<16;++r){p0[r]=NEG;p1[r]=NEG;}
  }
}

constexpr int NSLOT=3, SLOTB=8192;
constexpr int LDS_K=0, LDS_V=NSLOT*SLOTB, LDS_WS=2*NSLOT*SLOTB, LDS_OST=LDS_WS+NW*64*4, LDS_BYTES=LDS_OST+NW*4096;
constexpr float C2=0.125f*1.4426950408889634f;
__device__ __forceinline__ void glds16(const void*gsrc,unsigned lds_dst){unsigned keep;
  asm volatile("s_mov_b32 %0, m0\n\ts_mov_b32 m0, %2\n\ts_nop 0\n\tglobal_load_lds_dwordx4 %1, off\n\ts_mov_b32 m0, %0":"=&s"(keep):"v"(gsrc),"s"(lds_dst):"memory");}
__device__ __forceinline__ float max3f(float a,float b,float c){float r;asm("v_max3_f32 %0, %1, %2, %3":"=v"(r):"v"(a),"v"(b),"v"(c));return r;}
__device__ __forceinline__ float max2f(float a,float b){float r;asm("v_max_f32_e32 %0, %1, %2":"=v"(r):"v"(a),"v"(b));return r;}
__device__ __forceinline__ float fadd_s(float a,float b){float r;asm("v_add_f32_e32 %0, %1, %2":"=v"(r):"v"(a),"v"(b));return r;}
__device__ __forceinline__ float fsub_s(float a,float b){float r;asm("v_sub_f32_e32 %0, %1, %2":"=v"(r):"v"(a),"v"(b));return r;}
typedef float f32x2_t __attribute__((ext_vector_type(2))); typedef __bf16 bf16x2_t __attribute__((ext_vector_type(2)));
__device__ __forceinline__ unsigned cvtpk_s(float lo,float hi){f32x2_t v={lo,hi};bf16x2_t b=__builtin_convertvector(v,bf16x2_t);return __builtin_bit_cast(unsigned,b);}
#define WAIT_BAR(N) asm volatile("s_waitcnt vmcnt(" #N ") lgkmcnt(0)\n\ts_barrier":::"memory")

__device__ __forceinline__ void qkt(f32x16&p0,f32x16&p1,const char*Kslot,const bf16x8*qr,const f32x16&negm,int r32,int hi){
  const char*kb=Kslot+hi*1024+r32*16;
  #pragma unroll
  for(int d0=0;d0<4;++d0){
    const bf16x8 b0=*reinterpret_cast<const bf16x8*>(kb+d0*2048);
    const bf16x8 b1=*reinterpret_cast<const bf16x8*>(kb+d0*2048+512);
    if(d0==0){p0=__builtin_amdgcn_mfma_f32_32x32x16_bf16(b0,qr[0],negm,0,0,0);p1=__builtin_amdgcn_mfma_f32_32x32x16_bf16(b1,qr[0],negm,0,0,0);}
    else{p0=__builtin_amdgcn_mfma_f32_32x32x16_bf16(b0,qr[d0],p0,0,0,0);p1=__builtin_amdgcn_mfma_f32_32x32x16_bf16(b1,qr[d0],p1,0,0,0);}}
}
typedef __attribute__((address_space(3))) const char* lds_cptr;
typedef short v4i16_t __attribute__((ext_vector_type(4)));
__device__ __forceinline__ void kload8(bf16x8*kf,lds_cptr kp){
  kf[0]=*(const __attribute__((address_space(3))) bf16x8*)(kp);      kf[1]=*(const __attribute__((address_space(3))) bf16x8*)(kp+512);
  kf[2]=*(const __attribute__((address_space(3))) bf16x8*)(kp+2048); kf[3]=*(const __attribute__((address_space(3))) bf16x8*)(kp+2560);
  kf[4]=*(const __attribute__((address_space(3))) bf16x8*)(kp+4096); kf[5]=*(const __attribute__((address_space(3))) bf16x8*)(kp+4608);
  kf[6]=*(const __attribute__((address_space(3))) bf16x8*)(kp+6144); kf[7]=*(const __attribute__((address_space(3))) bf16x8*)(kp+6656);
}
__device__ __forceinline__ void kload2(bf16x8*kf,lds_cptr kp,int j){ kf[2*j]=*(const __attribute__((address_space(3))) bf16x8*)(kp+j*2048); kf[2*j+1]=*(const __attribute__((address_space(3))) bf16x8*)(kp+j*2048+512); }
__device__ __forceinline__ s16x4 vtr(lds_cptr p){ return __builtin_bit_cast(s16x4,__builtin_amdgcn_ds_read_tr16_b64_v4i16((__attribute__((address_space(3))) v4i16_t*)p)); }
__device__ __forceinline__ float rowmax(const f32x16&p0,const f32x16&p1){
  float a=max3f(p0[0],p0[1],p1[0]),b=max3f(p0[2],p0[3],p1[1]);a=max3f(a,p1[2],p1[3]);
  #pragma unroll
  for(int r=4;r<16;r+=4){a=max3f(a,p0[r],p0[r+1]);b=max3f(b,p0[r+2],p0[r+3]);a=max3f(a,p1[r],p1[r+1]);b=max3f(b,p1[r+2],p1[r+3]);}
  const float m=max2f(a,b);
  auto rr=__builtin_amdgcn_permlane32_swap(__float_as_uint(m),__float_as_uint(m),false,false);
  return max2f(__uint_as_float(rr[0]),__uint_as_float(rr[1]));
}
__device__ __forceinline__ void pv(f32x16*o,int vb,bf16x8 pa0,bf16x8 pa1,bf16x8 pa2,bf16x8 pa3){
  #pragma unroll
  for(int d0=0;d0<2;++d0){s16x4 lo[4],hi[4];
    #pragma unroll
    for(int ks=0;ks<4;++ks){
      asm volatile("ds_read_b64_tr_b16 %0,%1 offset:%c2":"=&v"(lo[ks]):"v"(vb),"i"(d0*4096+ks*1024):"memory");
      asm volatile("ds_read_b64_tr_b16 %0,%1 offset:%c2":"=&v"(hi[ks]):"v"(vb),"i"(d0*4096+ks*1024+512):"memory");}
    asm volatile("s_waitcnt lgkmcnt(0)":::"memory");SBAR();
    #define PK(k) (bf16x8){lo[k][0],lo[k][1],lo[k][2],lo[k][3],hi[k][0],hi[k][1],hi[k][2],hi[k][3]}
    o[d0]=__builtin_amdgcn_mfma_f32_32x32x16_bf16(pa0,PK(0),o[d0],0,0,0);
    o[d0]=__builtin_amdgcn_mfma_f32_32x32x16_bf16(pa1,PK(1),o[d0],0,0,0);
    o[d0]=__builtin_amdgcn_mfma_f32_32x32x16_bf16(pa2,PK(2),o[d0],0,0,0);
    o[d0]=__builtin_amdgcn_mfma_f32_32x32x16_bf16(pa3,PK(3),o[d0],0,0,0);
    #undef PK
  }
}

#ifndef ATTN_STORE16
#define ATTN_STORE16(p,v) (*(u32x4*)(p)=(v))
#endif
template<int THRL> __device__ __forceinline__ void attn_unit(int h,int qb,const bf16*Q,const bf16*__restrict__ K,const bf16*__restrict__ V,bf16*O,char*shm){
  int tid_=threadIdx.x; asm volatile("":"+v"(tid_));
  const int tid=tid_,lane=tid&63,r32=lane&31,hi=lane>>5; const int wid=__builtin_amdgcn_readfirstlane(tid>>6);
  const int q0=qb*QB; const int kvh=h>>2;
  const bf16*Qw=Q+(long)(q0+wid*QBLK)*QP+h*D;
  const bf16*Kh=K+kvh*D,*Vh=V+kvh*D;
  const unsigned lds0=(unsigned)(uintptr_t)shm;
  float*wsf=(float*)(shm+LDS_WS)+wid*64;
  const bf16*ksrc=Kh+(long)lane*KP+wid*8;
  const bf16*vsrc=Vh+(long)(16*(wid&3)+(lane>>2))*KP+(wid>>2)*32+(lane&3)*8;
  const unsigned kdst=lds0+LDS_K+wid*1024, vdst=lds0+LDS_V+wid*1024;
  #define DMA_K(t,slot) glds16(ksrc+(long)(t)*KVBLK*KP,(unsigned)__builtin_amdgcn_readfirstlane(kdst+(slot)))
  #define DMA_V(t,slot) glds16(vsrc+(long)(t)*KVBLK*KP,(unsigned)__builtin_amdgcn_readfirstlane(vdst+(slot)))
  const int vb0=(int)(lds0+LDS_V)+((lane>>4)&1)*32+(lane&3)*8+(4*hi+((lane&15)>>2))*64;
  const char*Kbase=shm+LDS_K; bf16x8 kf[8];
  const lds_cptr shm3=(lds_cptr)shm; const lds_cptr kp0=shm3+LDS_K+hi*1024+r32*16; const lds_cptr vp0=shm3+LDS_V+((lane>>4)&1)*32+(lane&3)*8+(4*hi+((lane&15)>>2))*64;
  DMA_K(0,0);DMA_V(0,0);DMA_K(1,SLOTB);
  bf16x8 qr[4];
  #pragma unroll
  for(int d0=0;d0<4;++d0)qr[d0]=*reinterpret_cast<const bf16x8*>(&Qw[(long)r32*QP+d0*16+hi*8]);
  float mhat=0.f,l_reg=0.f;f32x16 o[2];o[0]=f32x16{};o[1]=f32x16{};f32x16 negm=f32x16{};asm volatile("":"+v"(negm));
  #define CMASK(P0,P1,t) do{int jb_=(t)-(NT-4); if(jb_>=2)cmask(P0,P1,jb_);}while(0)
  bool resc=false;
  #define START(P0,P1) do{ const float rm=rowmax(P0,P1); resc=false; \
    { const float dl=rm; mhat=fadd_s(mhat,dl); \
      _Pragma("unroll") for(int r=0;r<16;++r){P0[r]=fsub_s(P0[r],dl);P1[r]=fsub_s(P1[r],dl);} \
      _Pragma("unroll") for(int r=0;r<16;++r)negm[r]=-mhat; asm volatile("":"+v"(negm)); } \
    _Pragma("unroll") for(int r=0;r<16;++r)P0[r]=__builtin_amdgcn_exp2f(P0[r]); }while(0)
  #define RESC() do{ if(resc){ asm volatile("s_waitcnt lgkmcnt(0)":::"memory"); \
      _Pragma("unroll") for(int d_=0;d_<2;++d_) _Pragma("unroll") for(int r=0;r<16;++r)o[d_][r]*=wsf[crow(r,hi)]; } }while(0)
  f32x16 pA0,pA1,pB0,pB1;
  int sl_prev=0,sl_cur=0,sl_next=SLOTB;
  #define ROT() do{sl_prev=sl_cur;sl_cur=sl_next;sl_next=(sl_next==(NSLOT-1)*SLOTB)?0:sl_next+SLOTB;}while(0)
  DMA_K(2,2*SLOTB);
  WAIT_BAR(3);
  qkt(pA0,pA1,Kbase,qr,negm,r32,hi);asm volatile("s_nop 15\n\ts_nop 7":"+v"(pA0),"+v"(pA1));CMASK(pA0,pA1,0);
  START(pA0,pA1);
  _Pragma("unroll") for(int r=0;r<16;++r)pA1[r]=__builtin_amdgcn_exp2f(pA1[r]);
  WAIT_BAR(0);
  DMA_K(3,0);DMA_V(1,SLOTB);
  ROT();
  kload8(kf,kp0+sl_cur);
  WAIT_BAR(2);
  s16x4 vlo[8],vhi[8]; u32x4 pw0,pw1,pw2,pw3;
  #define PKW(P,B) cvtpk_s(P[B],P[B+1])
  #define PAF(k) __builtin_bit_cast(bf16x8,pw##k)
  #define VFR(i) (bf16x8){vlo[i][0],vlo[i][1],vlo[i][2],vlo[i][3],vhi[i][0],vhi[i][1],vhi[i][2],vhi[i][3]}
  #define PIN(x) asm volatile("":"+v"(x))
  #define MX3(a,b,c) __builtin_fmaxf(__builtin_fmaxf((a),(b)),(c))
  #define GAPA(MF,A0,A1,A2,A3,W0,W1,PW) do{ MF; sacc+=A0; sacc+=A1; sacc+=A2; sacc+=A3; PIN(sacc); W0; W1; PIN(PW); SBAR(); }while(0)
  #define EX(v) __builtin_amdgcn_exp2f(v)
  #define GAPB(MF,X,B) do{ MF; X[B]=EX(X[B]); X[B+1]=EX(X[B+1]); X[B+2]=EX(X[B+2]); X[B+3]=EX(X[B+3]); PIN(X); SBAR(); }while(0)
  #define VRD(i) do{ vlo[i]=vtr(vp_+(((i)>>2)*4096+((i)&3)*1024)); vhi[i]=vtr(vp_+(((i)>>2)*4096+((i)&3)*1024+512)); }while(0)
  #define KRD(G,j) do{ if(G){ kload2(kf,kp0+sl_next,j); SBAR(); } }while(0)
  #define STEP(C0,C1,P0,P1,t,GK,GV,GL) do{ SBAR(); \
    const lds_cptr vp_=vp0+sl_prev; \
    VRD(0); SBAR(); float sacc=(P0[0]+P0[1]); \
    GAPA(C0=__builtin_amdgcn_mfma_f32_32x32x16_bf16(kf[0],qr[0],negm,0,0,0), P0[2],P0[3],P0[4],P0[5],     pw0[0]=PKW(P0,0), pw0[1]=PKW(P0,2), pw0); \
    VRD(4); SBAR(); GAPA(C1=__builtin_amdgcn_mfma_f32_32x32x16_bf16(kf[1],qr[0],negm,0,0,0), P0[6],P0[7],P0[8],P0[9],     pw0[2]=PKW(P0,4), pw0[3]=PKW(P0,6), pw0); \
    VRD(1); SBAR(); GAPA(C0=__builtin_amdgcn_mfma_f32_32x32x16_bf16(kf[2],qr[1],C0,0,0,0),   P0[10],P0[11],P0[12],P0[13], pw1[0]=PKW(P0,8), pw1[1]=PKW(P0,10), pw1); \
    VRD(5); SBAR(); GAPA(C1=__builtin_amdgcn_mfma_f32_32x32x16_bf16(kf[3],qr[1],C1,0,0,0),   P0[14],P0[15],P1[0],P1[1],   pw1[2]=PKW(P0,12),pw1[3]=PKW(P0,14), pw1); \
    VRD(2); SBAR(); GAPA(C0=__builtin_amdgcn_mfma_f32_32x32x16_bf16(kf[4],qr[2],C0,0,0,0),   P1[2],P1[3],P1[4],P1[5],     pw2[0]=PKW(P1,0), pw2[1]=PKW(P1,2), pw2); \
    VRD(6); SBAR(); GAPA(C1=__builtin_amdgcn_mfma_f32_32x32x16_bf16(kf[5],qr[2],C1,0,0,0),   P1[6],P1[7],P1[8],P1[9],     pw2[2]=PKW(P1,4), pw2[3]=PKW(P1,6), pw2); \
    VRD(3); SBAR(); GAPA(C0=__builtin_amdgcn_mfma_f32_32x32x16_bf16(kf[6],qr[3],C0,0,0,0),   P1[10],P1[11],P1[12],P1[13], pw3[0]=PKW(P1,8), pw3[1]=PKW(P1,10), pw3); \
    VRD(7); SBAR(); GAPA(C1=__builtin_amdgcn_mfma_f32_32x32x16_bf16(kf[7],qr[3],C1,0,0,0),   P1[14],P1[15],0.f,0.f,       pw3[2]=PKW(P1,12),pw3[3]=PKW(P1,14), pw3); \
    l_reg+=sacc; \
    if(GK){DMA_K((t)+3,sl_cur);} if(GV){DMA_V((t)+1,sl_next);} \
    CMASK(C0,C1,t); \
    { float a=MX3(C0[0],C0[1],C1[0]),b=MX3(C0[2],C0[3],C1[1]); a=MX3(a,C1[2],C1[3]); \
      _Pragma("unroll") for(int r=4;r<16;r+=4){a=MX3(a,C0[r],C0[r+1]);b=MX3(b,C0[r+2],C0[r+3]);a=MX3(a,C1[r],C1[r+1]);b=MX3(b,C1[r+2],C1[r+3]);} \
      float rm=__builtin_fmaxf(a,b); { auto rr=__builtin_amdgcn_permlane32_swap(__float_as_uint(rm),__float_as_uint(rm),false,false); rm=__builtin_fmaxf(__uint_as_float(rr[0]),__uint_as_float(rr[1])); } \
      resc=false; \
      if(__builtin_expect(__any(rm>(float)THRL),0)){ const float dl=__builtin_fmaxf(rm,0.f); mhat+=dl; \
        _Pragma("unroll") for(int r=0;r<16;++r){C0[r]-=dl;C1[r]-=dl;} \
        _Pragma("unroll") for(int r=0;r<16;++r)negm[r]=-mhat; asm volatile("":"+v"(negm)); \
        const float f=__builtin_amdgcn_exp2f(-dl); l_reg*=f; if(hi==0)wsf[r32]=f; resc=true; } } \
    SBAR(); \
    GAPB(o[0]=__builtin_amdgcn_mfma_f32_32x32x16_bf16(PAF(0),VFR(0),o[0],0,0,0), C0,0); \
    GAPB(o[1]=__builtin_amdgcn_mfma_f32_32x32x16_bf16(PAF(0),VFR(4),o[1],0,0,0), C0,4); \
    KRD(GL,0); GAPB(o[0]=__builtin_amdgcn_mfma_f32_32x32x16_bf16(PAF(1),VFR(1),o[0],0,0,0), C0,8); \
    KRD(GL,1); GAPB(o[1]=__builtin_amdgcn_mfma_f32_32x32x16_bf16(PAF(1),VFR(5),o[1],0,0,0), C0,12); \
    KRD(GL,2); GAPB(o[0]=__builtin_amdgcn_mfma_f32_32x32x16_bf16(PAF(2),VFR(2),o[0],0,0,0), C1,0); \
    KRD(GL,3); GAPB(o[1]=__builtin_amdgcn_mfma_f32_32x32x16_bf16(PAF(2),VFR(6),o[1],0,0,0), C1,4); \
    GAPB(o[0]=__builtin_amdgcn_mfma_f32_32x32x16_bf16(PAF(3),VFR(3),o[0],0,0,0), C1,8); \
    GAPB(o[1]=__builtin_amdgcn_mfma_f32_32x32x16_bf16(PAF(3),VFR(7),o[1],0,0,0), C1,12); \
    }while(0)
  int t=1;
  #undef CMASK
  #define CMASK(P0,P1,t) do{}while(0)
  for(;t+5<NT;t+=2){
    STEP(pB0,pB1,pA0,pA1,t,true,true,true);     WAIT_BAR(2); RESC(); ROT();
    STEP(pA0,pA1,pB0,pB1,t+1,true,true,true);   WAIT_BAR(2); RESC(); ROT();
  }
  #undef CMASK
  #define CMASK(P0,P1,t) do{int jb_=(t)-(NT-4); if(jb_>=2)cmask(P0,P1,jb_);}while(0)
  #define ENDW(tt) do{ if((tt)+3<NT){WAIT_BAR(2);} else if((tt)+2<NT){WAIT_BAR(1);} else {WAIT_BAR(0);} }while(0)
  for(;t+1<NT;t+=2){
    STEP(pB0,pB1,pA0,pA1,t,(t+3<NT),(t+1<NT),(t+1<NT));       ENDW(t);   RESC(); ROT();
    STEP(pA0,pA1,pB0,pB1,t+1,(t+4<NT),(t+2<NT),(t+2<NT));     ENDW(t+1); RESC(); ROT();
  }
  STEP(pB0,pB1,pA0,pA1,NT-1,false,false,false); RESC();
  { float sacc=pB0[0]+pB0[1]; _Pragma("unroll") for(int r=2;r<16;++r)sacc+=pB0[r]; _Pragma("unroll") for(int r=0;r<16;++r)sacc+=pB1[r]; l_reg+=sacc;
    pw0=(u32x4){PKW(pB0,0),PKW(pB0,2),PKW(pB0,4),PKW(pB0,6)};pw1=(u32x4){PKW(pB0,8),PKW(pB0,10),PKW(pB0,12),PKW(pB0,14)};pw2=(u32x4){PKW(pB1,0),PKW(pB1,2),PKW(pB1,4),PKW(pB1,6)};pw3=(u32x4){PKW(pB1,8),PKW(pB1,10),PKW(pB1,12),PKW(pB1,14)};
    SBAR(); pv(o,vb0+sl_cur,PAF(0),PAF(1),PAF(2),PAF(3)); }
  #undef PKW
  #undef PAF
  #undef VFR
  #undef PIN
  #undef MX3
  #undef GAPA
  #undef GAPB
  #undef EX
  #undef VRD
  #undef KRD
  #undef STEP
  #undef ENDW
  {auto rr=__builtin_amdgcn_permlane32_swap(__float_as_uint(l_reg),__float_as_uint(l_reg),false,false);l_reg=__uint_as_float(rr[0])+__uint_as_float(rr[1]);}
  if(hi==0)wsf[32+r32]=l_reg;asm volatile("s_waitcnt lgkmcnt(0)":::"memory");
  float rli[16];
  #pragma unroll
  for(int r=0;r<16;++r)rli[r]=__builtin_amdgcn_rcpf(wsf[32+crow(r,hi)]);
  bf16*Ow=O+(long)(q0+wid*QBLK)*QP+h*D;
  { bf16*stg=(bf16*)(shm+LDS_OST)+wid*2048;
    #pragma unroll
    for(int r=0;r<16;++r){const int orow=crow(r,hi);
      #pragma unroll
      for(int d0=0;d0<2;++d0)stg[orow*64+d0*32+r32]=f2bf16(o[d0][r]*rli[r]);}
    asm volatile("s_waitcnt lgkmcnt(0)":::"memory");
    #pragma unroll
    for(int i=0;i<4;++i){const int row=i*8+(lane>>3),ch=lane&7; const u32x4 v=*(const u32x4*)(stg+row*64+ch*8); ATTN_STORE16(Ow+(long)row*QP+ch*8,v);} }
  asm volatile("s_waitcnt lgkmcnt(0)\n\ts_barrier":::"memory");
  #undef DMA_K
  #undef DMA_V
  #undef CMASK
  #undef START
  #undef RESC
  #undef ROT
}
__device__ __forceinline__ void attn_unit_fixed(float mref,int h,int qb,const bf16*Q,const bf16*__restrict__ K,const bf16*__restrict__ V,bf16*O,char*shm){
  int tid_=threadIdx.x; asm volatile("":"+v"(tid_));
  const int tid=tid_,lane=tid&63,r32=lane&31,hi=lane>>5; const int wid=__builtin_amdgcn_readfirstlane(tid>>6);
  const int q0=qb*QB; const int kvh=h>>2;
  const bf16*Qw=Q+(long)(q0+wid*QBLK)*QP+h*D;
  const bf16*Kh=K+kvh*D,*Vh=V+kvh*D;
  const unsigned lds0=(unsigned)(uintptr_t)shm;
  float*wsf=(float*)(shm+LDS_WS)+wid*64;
  const bf16*ksrc=Kh+(long)lane*KP+wid*8;
  const bf16*vsrc=Vh+(long)(16*(wid&3)+(lane>>2))*KP+(wid>>2)*32+(lane&3)*8;
  const unsigned kdst=lds0+LDS_K+wid*1024, vdst=lds0+LDS_V+wid*1024;
  #define DMA_K(t,slot) glds16(ksrc+(long)(t)*KVBLK*KP,(unsigned)__builtin_amdgcn_readfirstlane(kdst+(slot)))
  #define DMA_V(t,slot) glds16(vsrc+(long)(t)*KVBLK*KP,(unsigned)__builtin_amdgcn_readfirstlane(vdst+(slot)))
  const int vb0=(int)(lds0+LDS_V)+((lane>>4)&1)*32+(lane&3)*8+(4*hi+((lane&15)>>2))*64;
  const char*Kbase=shm+LDS_K; bf16x8 kf[8];
  const lds_cptr shm3=(lds_cptr)shm; const lds_cptr kp0=shm3+LDS_K+hi*1024+r32*16; const lds_cptr vp0=shm3+LDS_V+((lane>>4)&1)*32+(lane&3)*8+(4*hi+((lane&15)>>2))*64;
  DMA_K(0,0);DMA_V(0,0);DMA_K(1,SLOTB);
  bf16x8 qr[4];
  #pragma unroll
  for(int d0=0;d0<4;++d0)qr[d0]=*reinterpret_cast<const bf16x8*>(&Qw[(long)r32*QP+d0*16+hi*8]);
  f32x16 o[2];o[0]=f32x16{};o[1]=f32x16{};float l_reg=0.f;f32x16 negm;
  #pragma unroll
  for(int r=0;r<16;++r)negm[r]=-mref;
  asm volatile("":"+v"(negm));
  #define CMASK(P0,P1,t) do{int jb_=(t)-(NT-4); if(jb_>=2)cmask(P0,P1,jb_);}while(0)
  #define START(P0,P1) do{ _Pragma("unroll") for(int r=0;r<16;++r)P0[r]=__builtin_amdgcn_exp2f(P0[r]); }while(0)
  f32x16 pA0,pA1,pB0,pB1;
  int sl_prev=0,sl_cur=0,sl_next=SLOTB;
  #define ROT() do{sl_prev=sl_cur;sl_cur=sl_next;sl_next=(sl_next==(NSLOT-1)*SLOTB)?0:sl_next+SLOTB;}while(0)
  DMA_K(2,2*SLOTB);
  WAIT_BAR(3);
  qkt(pA0,pA1,Kbase,qr,negm,r32,hi);asm volatile("s_nop 15\n\ts_nop 7":"+v"(pA0),"+v"(pA1));CMASK(pA0,pA1,0);
  START(pA0,pA1);
  _Pragma("unroll") for(int r=0;r<16;++r)pA1[r]=__builtin_amdgcn_exp2f(pA1[r]);
  WAIT_BAR(0);
  DMA_K(3,0);DMA_V(1,SLOTB);
  ROT();
  kload8(kf,kp0+sl_cur);
  WAIT_BAR(2);
  s16x4 vlo[8],vhi[8]; u32x4 pw0,pw1,pw2,pw3;
  #define PKW(P,B) cvtpk_s(P[B],P[B+1])
  #define PAF(k) __builtin_bit_cast(bf16x8,pw##k)
  #define VFR(i) (bf16x8){vlo[i][0],vlo[i][1],vlo[i][2],vlo[i][3],vhi[i][0],vhi[i][1],vhi[i][2],vhi[i][3]}
  #define PIN(x) asm volatile("":"+v"(x))
  #define MX3(a,b,c) __builtin_fmaxf(__builtin_fmaxf((a),(b)),(c))
  #define GAPA(MF,A0,A1,A2,A3,W0,W1,PW) do{ MF; sacc+=A0; sacc+=A1; sacc+=A2; sacc+=A3; PIN(sacc); W0; W1; PIN(PW); SBAR(); }while(0)
  #define EX(v) __builtin_amdgcn_exp2f(v)
  #define GAPB(MF,X,B) do{ MF; X[B]=EX(X[B]); X[B+1]=EX(X[B+1]); X[B+2]=EX(X[B+2]); X[B+3]=EX(X[B+3]); PIN(X); SBAR(); }while(0)
  #define VRD(i) do{ vlo[i]=vtr(vp_+(((i)>>2)*4096+((i)&3)*1024)); vhi[i]=vtr(vp_+(((i)>>2)*4096+((i)&3)*1024+512)); }while(0)
  #define KRD(G,j) do{ if(G){ kload2(kf,kp0+sl_next,j); SBAR(); } }while(0)
  #define STEP(C0,C1,P0,P1,t,GK,GV,GL) do{ SBAR(); \
    if(GK){DMA_K((t)+3,sl_cur);} if(GV){DMA_V((t)+1,sl_next);} \
    const lds_cptr vp_=vp0+sl_prev; \
    VRD(0); SBAR(); float sacc=(P0[0]+P0[1]); \
    GAPA(C0=__builtin_amdgcn_mfma_f32_32x32x16_bf16(kf[0],qr[0],negm,0,0,0), P0[2],P0[3],P0[4],P0[5],     pw0[0]=PKW(P0,0), pw0[1]=PKW(P0,2), pw0); \
    VRD(4); SBAR(); GAPA(C1=__builtin_amdgcn_mfma_f32_32x32x16_bf16(kf[1],qr[0],negm,0,0,0), P0[6],P0[7],P0[8],P0[9],     pw0[2]=PKW(P0,4), pw0[3]=PKW(P0,6), pw0); \
    VRD(1); SBAR(); GAPA(C0=__builtin_amdgcn_mfma_f32_32x32x16_bf16(kf[2],qr[1],C0,0,0,0),   P0[10],P0[11],P0[12],P0[13], pw1[0]=PKW(P0,8), pw1[1]=PKW(P0,10), pw1); \
    VRD(5); SBAR(); GAPA(C1=__builtin_amdgcn_mfma_f32_32x32x16_bf16(kf[3],qr[1],C1,0,0,0),   P0[14],P0[15],P1[0],P1[1],   pw1[2]=PKW(P0,12),pw1[3]=PKW(P0,14), pw1); \
    VRD(2); SBAR(); GAPA(C0=__builtin_amdgcn_mfma_f32_32x32x16_bf16(kf[4],qr[2],C0,0,0,0),   P1[2],P1[3],P1[4],P1[5],     pw2[0]=PKW(P1,0), pw2[1]=PKW(P1,2), pw2); \
    VRD(6); SBAR(); GAPA(C1=__builtin_amdgcn_mfma_f32_32x32x16_bf16(kf[5],qr[2],C1,0,0,0),   P1[6],P1[7],P1[8],P1[9],     pw2[2]=PKW(P1,4), pw2[3]=PKW(P1,6), pw2); \
    VRD(3); SBAR(); GAPA(C0=__builtin_amdgcn_mfma_f32_32x32x16_bf16(kf[6],qr[3],C0,0,0,0),   P1[10],P1[11],P1[12],P1[13], pw3[0]=PKW(P1,8), pw3[1]=PKW(P1,10), pw3); \
    VRD(7); SBAR(); GAPA(C1=__builtin_amdgcn_mfma_f32_32x32x16_bf16(kf[7],qr[3],C1,0,0,0),   P1[14],P1[15],0.f,0.f,       pw3[2]=PKW(P1,12),pw3[3]=PKW(P1,14), pw3); \
    l_reg+=sacc; \
    CMASK(C0,C1,t); \
    SBAR(); \
    GAPB(o[0]=__builtin_amdgcn_mfma_f32_32x32x16_bf16(PAF(0),VFR(0),o[0],0,0,0), C0,0); \
    GAPB(o[1]=__builtin_amdgcn_mfma_f32_32x32x16_bf16(PAF(0),VFR(4),o[1],0,0,0), C0,4); \
    KRD(GL,0); GAPB(o[0]=__builtin_amdgcn_mfma_f32_32x32x16_bf16(PAF(1),VFR(1),o[0],0,0,0), C0,8); \
    KRD(GL,1); GAPB(o[1]=__builtin_amdgcn_mfma_f32_32x32x16_bf16(PAF(1),VFR(5),o[1],0,0,0), C0,12); \
    KRD(GL,2); GAPB(o[0]=__builtin_amdgcn_mfma_f32_32x32x16_bf16(PAF(2),VFR(2),o[0],0,0,0), C1,0); \
    KRD(GL,3); GAPB(o[1]=__builtin_amdgcn_mfma_f32_32x32x16_bf16(PAF(2),VFR(6),o[1],0,0,0), C1,4); \
    GAPB(o[0]=__builtin_amdgcn_mfma_f32_32x32x16_bf16(PAF(3),VFR(3),o[0],0,0,0), C1,8); \
    GAPB(o[1]=__builtin_amdgcn_mfma_f32_32x32x16_bf16(PAF(3),VFR(7),o[1],0,0,0), C1,12); \
    }while(0)
  int t=1;
  #undef CMASK
  #define CMASK(P0,P1,t) do{}while(0)
  for(;t+5<NT;t+=2){
    STEP(pB0,pB1,pA0,pA1,t,true,true,true);     WAIT_BAR(2); ROT();
    STEP(pA0,pA1,pB0,pB1,t+1,true,true,true);   WAIT_BAR(2); ROT();
  }
  #undef CMASK
  #define CMASK(P0,P1,t) do{int jb_=(t)-(NT-4); if(jb_>=2)cmask(P0,P1,jb_);}while(0)
  #define ENDW(tt) do{ if((tt)+3<NT){WAIT_BAR(2);} else if((tt)+2<NT){WAIT_BAR(1);} else {WAIT_BAR(0);} }while(0)
  for(;t+1<NT;t+=2){
    STEP(pB0,pB1,pA0,pA1,t,(t+3<NT),(t+1<NT),(t+1<NT));       ENDW(t);   ROT();
    STEP(pA0,pA1,pB0,pB1,t+1,(t+4<NT),(t+2<NT),(t+2<NT));     ENDW(t+1); ROT();
  }
  STEP(pB0,pB1,pA0,pA1,NT-1,false,false,false);
  {
    pw0=(u32x4){PKW(pB0,0),PKW(pB0,2),PKW(pB0,4),PKW(pB0,6)};pw1=(u32x4){PKW(pB0,8),PKW(pB0,10),PKW(pB0,12),PKW(pB0,14)};pw2=(u32x4){PKW(pB1,0),PKW(pB1,2),PKW(pB1,4),PKW(pB1,6)};pw3=(u32x4){PKW(pB1,8),PKW(pB1,10),PKW(pB1,12),PKW(pB1,14)};
    { float sacc=pB0[0]+pB0[1]; _Pragma("unroll") for(int r=2;r<16;++r)sacc+=pB0[r]; _Pragma("unroll") for(int r=0;r<16;++r)sacc+=pB1[r]; l_reg+=sacc; }
    SBAR(); pv(o,vb0+sl_cur,PAF(0),PAF(1),PAF(2),PAF(3)); }
  #undef PKW
  #undef PAF
  #undef VFR
  #undef PIN
  #undef MX3
  #undef GAPA
  #undef GAPB
  #undef EX
  #undef VRD
  #undef KRD
  #undef STEP
  #undef ENDW
  {auto rr=__builtin_amdgcn_permlane32_swap(__float_as_uint(l_reg),__float_as_uint(l_reg),false,false);l_reg=__uint_as_float(rr[0])+__uint_as_float(rr[1]);}
  if(hi==0)wsf[32+r32]=l_reg;asm volatile("s_waitcnt lgkmcnt(0)":::"memory");
  float rli[16];
  #pragma unroll
  for(int r=0;r<16;++r)rli[r]=__builtin_amdgcn_rcpf(wsf[32+crow(r,hi)]);
  bf16*Ow=O+(long)(q0+wid*QBLK)*QP+h*D;
  { bf16*stg=(bf16*)(shm+LDS_OST)+wid*2048;
    #pragma unroll
    for(int r=0;r<16;++r){const int orow=crow(r,hi);
      #pragma unroll
      for(int d0=0;d0<2;++d0)stg[orow*64+d0*32+r32]=f2bf16(o[d0][r]*rli[r]);}
    asm volatile("s_waitcnt lgkmcnt(0)":::"memory");
    #pragma unroll
    for(int i=0;i<4;++i){const int row=i*8+(lane>>3),ch=lane&7; const u32x4 v=*(const u32x4*)(stg+row*64+ch*8); ATTN_STORE16(Ow+(long)row*QP+ch*8,v);} }
  asm volatile("s_waitcnt lgkmcnt(0)\n\ts_barrier":::"memory");
  #undef DMA_K
  #undef DMA_V
  #undef CMASK
  #undef START
  #undef ROT
}


__device__ __forceinline__ void attn_unit_fixed2(float mref,int h,int qb,const bf16*Q,const bf16*__restrict__ K,const bf16*__restrict__ V,bf16*O,char*shm){
  constexpr int NT=257;
  int tid_=threadIdx.x; asm volatile("":"+v"(tid_));
  const int tid=tid_,lane=tid&63,r32=lane&31,hi=lane>>5; const int wid=__builtin_amdgcn_readfirstlane(tid>>6);
  const int q0=qb*QB; const int kvh=h>>2;
  constexpr int NS2=4, LDS_V2=NS2*SLOTB, LDS_WS2=2*NS2*SLOTB, LDS_OST2=LDS_WS2+NW*64*4;
  const bf16*Qw=Q+(long)(q0+wid*QBLK)*QP+h*D;
  const bf16*Kh=K+kvh*D,*Vh=V+kvh*D;
  const unsigned lds0=(unsigned)(uintptr_t)shm;
  float*wsf=(float*)(shm+LDS_WS2)+wid*64;
  const bf16*ksrc=Kh+(long)lane*KP+wid*8;
  const bf16*vsrc=Vh+(long)(16*(wid&3)+(lane>>2))*KP+(wid>>2)*32+(lane&3)*8;
  const unsigned kdst=lds0+LDS_K+wid*1024, vdst=lds0+LDS_V2+wid*1024;
  #define DMA_K(t,slot) glds16(ksrc+(long)(t)*KVBLK*KP,(unsigned)__builtin_amdgcn_readfirstlane(kdst+(slot)))
  #define DMA_V(t,slot) glds16(vsrc+(long)(t)*KVBLK*KP,(unsigned)__builtin_amdgcn_readfirstlane(vdst+(slot)))
  const int vb0=(int)(lds0+LDS_V2)+((lane>>4)&1)*32+(lane&3)*8+(4*hi+((lane&15)>>2))*64;
  const char*Kbase=shm+LDS_K; bf16x8 kf[8];
  const lds_cptr shm3=(lds_cptr)shm; const lds_cptr kp0=shm3+LDS_K+hi*1024+r32*16; const lds_cptr vp0=shm3+LDS_V2+((lane>>4)&1)*32+(lane&3)*8+(4*hi+((lane&15)>>2))*64;
  DMA_K(0,0);DMA_V(0,0);DMA_K(1,SLOTB);
  bf16x8 qr[4];
  #pragma unroll
  for(int d0=0;d0<4;++d0)qr[d0]=*reinterpret_cast<const bf16x8*>(&Qw[(long)r32*QP+d0*16+hi*8]);
  f32x16 o[2];o[0]=f32x16{};o[1]=f32x16{};float l_reg=0.f;f32x16 negm;
  #pragma unroll
  for(int r=0;r<16;++r)negm[r]=-mref;
  asm volatile("":"+v"(negm));
  #define CMASK(P0,P1,t) do{ if((t)==NT-1)cmask(P0,P1,2); }while(0)
  #define START(P0,P1) do{ _Pragma("unroll") for(int r=0;r<16;++r)P0[r]=__builtin_amdgcn_exp2f(P0[r]); }while(0)
  f32x16 pA0,pA1,pB0,pB1;
  int sl_prev=0,sl_cur=0,sl_next=SLOTB;
  #define ROT() do{sl_prev=sl_cur;sl_cur=sl_next;sl_next=(sl_next==(NS2-1)*SLOTB)?0:sl_next+SLOTB;}while(0)
  DMA_K(2,2*SLOTB);DMA_K(3,3*SLOTB);DMA_V(1,SLOTB);
  WAIT_BAR(5);
  qkt(pA0,pA1,Kbase,qr,negm,r32,hi);asm volatile("s_nop 15\n\ts_nop 7":"+v"(pA0),"+v"(pA1));CMASK(pA0,pA1,0);
  START(pA0,pA1);
  _Pragma("unroll") for(int r=0;r<16;++r)pA1[r]=__builtin_amdgcn_exp2f(pA1[r]);
  WAIT_BAR(0);
  ROT();
  kload8(kf,kp0+sl_cur);
  asm volatile("s_waitcnt lgkmcnt(0)\n\ts_barrier":::"memory");
  s16x4 vlo[8],vhi[8]; u32x4 pw0,pw1,pw2,pw3;
  #define PKW(P,B) cvtpk_s(P[B],P[B+1])
  #define PAF(k) __builtin_bit_cast(bf16x8,pw##k)
  #define VFR(i) (bf16x8){vlo[i][0],vlo[i][1],vlo[i][2],vlo[i][3],vhi[i][0],vhi[i][1],vhi[i][2],vhi[i][3]}
  #define PIN(x) asm volatile("":"+v"(x))
  #define MX3(a,b,c) __builtin_fmaxf(__builtin_fmaxf((a),(b)),(c))
  #define GAPA(MF,A0,A1,A2,A3,W0,W1,PW) do{ MF; sacc+=A0; sacc+=A1; sacc+=A2; sacc+=A3; PIN(sacc); W0; W1; PIN(PW); SBAR(); }while(0)
  #define EX(v) __builtin_amdgcn_exp2f(v)
  #define GAPB(MF,X,B) do{ MF; X[B]=EX(X[B]); X[B+1]=EX(X[B+1]); X[B+2]=EX(X[B+2]); X[B+3]=EX(X[B+3]); PIN(X); SBAR(); }while(0)
  #define VRD(i) do{ vlo[i]=vtr(vp_+(((i)>>2)*4096+((i)&3)*1024)); vhi[i]=vtr(vp_+(((i)>>2)*4096+((i)&3)*1024+512)); }while(0)
  #define KRD(G,j) do{ if(G){ kload2(kf,kp0+sl_next,j); SBAR(); } }while(0)
  #define STEP(C0,C1,P0,P1,t,GK,GV,GL) do{ SBAR(); \
    if(GK){DMA_K((t)+3,sl_prev);} if(GV){DMA_V((t)+1,sl_next);} \
    const lds_cptr vp_=vp0+sl_prev; \
    VRD(0); SBAR(); float sacc=(P0[0]+P0[1]); \
    GAPA(C0=__builtin_amdgcn_mfma_f32_32x32x16_bf16(kf[0],qr[0],negm,0,0,0), P0[2],P0[3],P0[4],P0[5],     pw0[0]=PKW(P0,0), pw0[1]=PKW(P0,2), pw0); \
    VRD(4); SBAR(); GAPA(C1=__builtin_amdgcn_mfma_f32_32x32x16_bf16(kf[1],qr[0],negm,0,0,0), P0[6],P0[7],P0[8],P0[9],     pw0[2]=PKW(P0,4), pw0[3]=PKW(P0,6), pw0); \
    VRD(1); SBAR(); GAPA(C0=__builtin_amdgcn_mfma_f32_32x32x16_bf16(kf[2],qr[1],C0,0,0,0),   P0[10],P0[11],P0[12],P0[13], pw1[0]=PKW(P0,8), pw1[1]=PKW(P0,10), pw1); \
    VRD(5); SBAR(); GAPA(C1=__builtin_amdgcn_mfma_f32_32x32x16_bf16(kf[3],qr[1],C1,0,0,0),   P0[14],P0[15],P1[0],P1[1],   pw1[2]=PKW(P0,12),pw1[3]=PKW(P0,14), pw1); \
    VRD(2); SBAR(); GAPA(C0=__builtin_amdgcn_mfma_f32_32x32x16_bf16(kf[4],qr[2],C0,0,0,0),   P1[2],P1[3],P1[4],P1[5],     pw2[0]=PKW(P1,0), pw2[1]=PKW(P1,2), pw2); \
    VRD(6); SBAR(); GAPA(C1=__builtin_amdgcn_mfma_f32_32x32x16_bf16(kf[5],qr[2],C1,0,0,0),   P1[6],P1[7],P1[8],P1[9],     pw2[2]=PKW(P1,4), pw2[3]=PKW(P1,6), pw2); \
    VRD(3); SBAR(); GAPA(C0=__builtin_amdgcn_mfma_f32_32x32x16_bf16(kf[6],qr[3],C0,0,0,0),   P1[10],P1[11],P1[12],P1[13], pw3[0]=PKW(P1,8), pw3[1]=PKW(P1,10), pw3); \
    VRD(7); SBAR(); GAPA(C1=__builtin_amdgcn_mfma_f32_32x32x16_bf16(kf[7],qr[3],C1,0,0,0),   P1[14],P1[15],0.f,0.f,       pw3[2]=PKW(P1,12),pw3[3]=PKW(P1,14), pw3); \
    l_reg+=sacc; \
    CMASK(C0,C1,t); \
    SBAR(); \
    GAPB(o[0]=__builtin_amdgcn_mfma_f32_32x32x16_bf16(PAF(0),VFR(0),o[0],0,0,0), C0,0); \
    GAPB(o[1]=__builtin_amdgcn_mfma_f32_32x32x16_bf16(PAF(0),VFR(4),o[1],0,0,0), C0,4); \
    KRD(GL,0); GAPB(o[0]=__builtin_amdgcn_mfma_f32_32x32x16_bf16(PAF(1),VFR(1),o[0],0,0,0), C0,8); \
    KRD(GL,1); GAPB(o[1]=__builtin_amdgcn_mfma_f32_32x32x16_bf16(PAF(1),VFR(5),o[1],0,0,0), C0,12); \
    KRD(GL,2); GAPB(o[0]=__builtin_amdgcn_mfma_f32_32x32x16_bf16(PAF(2),VFR(2),o[0],0,0,0), C1,0); \
    KRD(GL,3); GAPB(o[1]=__builtin_amdgcn_mfma_f32_32x32x16_bf16(PAF(2),VFR(6),o[1],0,0,0), C1,4); \
    GAPB(o[0]=__builtin_amdgcn_mfma_f32_32x32x16_bf16(PAF(3),VFR(3),o[0],0,0,0), C1,8); \
    GAPB(o[1]=__builtin_amdgcn_mfma_f32_32x32x16_bf16(PAF(3),VFR(7),o[1],0,0,0), C1,12); \
    }while(0)
  int t=1;
  #undef CMASK
  #define CMASK(P0,P1,t) do{}while(0)
  for(;t+5<NT;t+=2){
    STEP(pB0,pB1,pA0,pA1,t,true,true,true);     ROT();
    STEP(pA0,pA1,pB0,pB1,t+1,true,true,true);   WAIT_BAR(0); ROT();
  }
  #undef CMASK
  #define CMASK(P0,P1,t) do{ if((t)==NT-1)cmask(P0,P1,2); }while(0)
  for(;t+1<NT;t+=2){
    STEP(pB0,pB1,pA0,pA1,t,(t+3<NT),(t+1<NT),(t+1<NT));       ROT();
    STEP(pA0,pA1,pB0,pB1,t+1,(t+4<NT),(t+2<NT),(t+2<NT));     WAIT_BAR(0); ROT();
  }
  {
    pw0=(u32x4){PKW(pA0,0),PKW(pA0,2),PKW(pA0,4),PKW(pA0,6)};pw1=(u32x4){PKW(pA0,8),PKW(pA0,10),PKW(pA0,12),PKW(pA0,14)};pw2=(u32x4){PKW(pA1,0),PKW(pA1,2),PKW(pA1,4),PKW(pA1,6)};pw3=(u32x4){PKW(pA1,8),PKW(pA1,10),PKW(pA1,12),PKW(pA1,14)};
    { float sacc=pA0[0]+pA0[1]; _Pragma("unroll") for(int r=2;r<16;++r)sacc+=pA0[r]; _Pragma("unroll") for(int r=0;r<16;++r)sacc+=pA1[r]; l_reg+=sacc; }
    SBAR(); pv(o,vb0+sl_prev,PAF(0),PAF(1),PAF(2),PAF(3)); }
  #undef PKW
  #undef PAF
  #undef VFR
  #undef PIN
  #undef MX3
  #undef GAPA
  #undef GAPB
  #undef EX
  #undef VRD
  #undef KRD
  #undef STEP
  {auto rr=__builtin_amdgcn_permlane32_swap(__float_as_uint(l_reg),__float_as_uint(l_reg),false,false);l_reg=__uint_as_float(rr[0])+__uint_as_float(rr[1]);}
  if(hi==0)wsf[32+r32]=l_reg;asm volatile("s_waitcnt lgkmcnt(0)":::"memory");
  float rli[16];
  #pragma unroll
  for(int r=0;r<16;++r)rli[r]=__builtin_amdgcn_rcpf(wsf[32+crow(r,hi)]);
  bf16*Ow=O+(long)(q0+wid*QBLK)*QP+h*D;
  { bf16*stg=(bf16*)(shm+LDS_OST2)+wid*2048;
    #pragma unroll
    for(int r=0;r<16;++r){const int orow=crow(r,hi);
      #pragma unroll
      for(int d0=0;d0<2;++d0)stg[orow*64+d0*32+r32]=f2bf16(o[d0][r]*rli[r]);}
    asm volatile("s_waitcnt lgkmcnt(0)":::"memory");
    #pragma unroll
    for(int i=0;i<4;++i){const int row=i*8+(lane>>3),ch=lane&7; const u32x4 v=*(const u32x4*)(stg+row*64+ch*8); ATTN_STORE16(Ow+(long)row*QP+ch*8,v);} }
  asm volatile("s_waitcnt lgkmcnt(0)\n\ts_barrier":::"memory");
  #undef DMA_K
  #undef DMA_V
  #undef CMASK
  #undef START
  #undef ROT
}


constexpr int ATTN_LDS_BYTES=LDS_BYTES;
struct AttnTensors { const bf16* Q; const bf16* K; const bf16* V; bf16* O; const float* qgain; const float* kgain; };
template<int THRL=8> __device__ __forceinline__ void attn_phase(char*lds,const AttnTensors&T,int vcu,int G){
  float gq=__builtin_fabsf(T.qgain[threadIdx.x&63]),gk=__builtin_fabsf(T.kgain[threadIdx.x&63]);
  #pragma unroll
  for(int o=1;o<64;o<<=1){gq=__builtin_fmaxf(gq,__shfl_xor(gq,o));gk=__builtin_fmaxf(gk,__shfl_xor(gk,o));}
  const float mref=__uint_as_float(__builtin_amdgcn_readfirstlane(__float_as_uint(C2*64.0f*gq*gk*1.001f+0.01f)));
  const bool fixed=mref<48.0f;
  const bool bal=(G==256);
  for(int k=0;;++k){
    int h,qb;
    if(bal){ if(k>=2)break; h=vcu>>5; qb=(vcu&31)+32*k; }
    else { const int u=vcu+k*G; if(u>=512)break; h=u>>6; qb=u&63; }
    if(fixed) attn_unit_fixed2(mref,h,qb,T.Q,T.K,T.V,T.O,lds); else attn_unit<THRL>(h,qb,T.Q,T.K,T.V,T.O,lds);
  }
}
#undef SBAR
#undef WAIT_BAR
}

constexpr int NWAVES = 8;
#ifndef MK_N_LAUNCHES
#define MK_N_LAUNCHES 1
#endif
constexpr int N_PHASES = 11;
constexpr int N_LAUNCHES = MK_N_LAUNCHES;
static_assert(N_LAUNCHES == 1 || N_LAUNCHES == N_PHASES, "MK_N_LAUNCHES is 1 or 11");

constexpr int M = 16384, DM = 1024, NMETA = 16, DFF = 2816, NGU = 2 * DFF, NIN = 5376;
constexpr int HGW = 512;
constexpr int HROWS = M + 128;

constexpr size_t MiB = 1u << 20;
constexpr size_t WS_CTL = 0, CTL_ZERO_BYTES = 1 * MiB;
constexpr size_t WS_MISC = 1 * MiB;
constexpr size_t MISC_ROPER = 0, MISC_ROPEC = 32768, MISC_OMLF = 40960, MISC_OMLB = 43008, MISC_METAB = 45056, MISC_SSQ0M = 77824, MISC_ACTM = 78848, MISC_H1M = 168960, MISC_H1MB = 234496,
                 MISC_SSQM = 267264, MISC_DF = 271360, MISC_DB = 535552, MISC_END = 799744;
static_assert(MISC_END <= 2 * MiB, "misc");
constexpr size_t WS_SSQ0 = 3 * MiB, WS_SSQ1 = 4 * MiB, WS_SSQ2 = 5 * MiB;
constexpr size_t WS_W = 6 * MiB;
constexpr size_t W_GU1 = 0, W_D1 = 11534336, W_IN = 17301504, W_UP = 28311552, W_OUT = 30408704, W_GU2 = 32505856, W_D2 = 44040192, W_END = 49807360;
constexpr size_t WS_HB = WS_W + W_END;
constexpr size_t WS_Z = WS_HB + (size_t)M * DM * 2;
constexpr size_t Z_HQ = 0, Z_QO = 16908288, Z_HV = 33685504, Z_ZFF = 50593792, Z_ZFB = 67502080, Z_HG = 84410368, Z_KB = 101318656, Z_VB = 105545728, Z_GA = 109772800, Z_GB = 143327232, Z_END = 176881664;
constexpr size_t WS_END = WS_Z + Z_END;
static_assert(Z_QO == Z_HQ + (size_t)HROWS * HGW * 2 && Z_HV == Z_QO + (size_t)M * HGW * 2 && Z_ZFF == Z_HV + (size_t)HROWS * HGW * 2 && Z_KB == Z_HG + (size_t)HROWS * HGW * 2 && Z_GA == Z_VB + (size_t)HROWS * 128 * 2 &&
              Z_END == Z_GB + (size_t)M * DM * 2 && WS_END <= 268435456 && (size_t)M * DFF * 2 <= Z_END && (size_t)M * DM * 2 <= Z_ZFB - Z_HV, "d_ws map");
constexpr int CW_TMO = 0, CW_CODE = 1, CW_BAR = 4096;

constexpr int RING_OFF = 0, RING_BYTES = 131072;
constexpr int HL_QH = 0, HL_KH = 32768, HL_VT = 65536, HL_ST = 100352, HL_TOT = 135168, HL_ER = 143360, HL_SSQ = 143872, HL_END = 144896;
constexpr int HL_PITCH = 272;
constexpr int OX_PITCH = 132;
constexpr int RS_OFF = 144896;
constexpr int LDSCTL_OFF = 153088, MISC_OFF = LDSCTL_OFF + 320;
constexpr int LDS_BYTES = 154112;
static_assert(HL_END <= RS_OFF && RS_OFF + pg8::RS_UNITS * 1024 <= LDSCTL_OFF && (M / 256) * (NGU / 256) <= pg8::RS_UNITS * 256 && RING_BYTES <= RS_OFF && MISC_OFF + 128 <= LDS_BYTES && 128 * OX_PITCH * 4 <= HL_ST, "LDS map");

#define GAS __attribute__((address_space(1)))
#define LAS __attribute__((address_space(3)))
typedef unsigned short bf16;
typedef unsigned v4u __attribute__((ext_vector_type(4)));
typedef float f32x4 __attribute__((ext_vector_type(4)));
typedef float f32x2 __attribute__((ext_vector_type(2)));
typedef float f32x16 __attribute__((ext_vector_type(16)));
typedef short bf16x8 __attribute__((ext_vector_type(8)));
typedef short s16x4 __attribute__((ext_vector_type(4)));
typedef GAS unsigned gu32;
#define RLX_AGENT __ATOMIC_RELAXED, __HIP_MEMORY_SCOPE_AGENT
#define LDS_WAIT() asm volatile("s_waitcnt lgkmcnt(0)" ::: "memory")
#define VM_WAIT() asm volatile("s_waitcnt vmcnt(0)" ::: "memory")
__device__ __forceinline__ unsigned f2bf(float f) { unsigned u = __builtin_bit_cast(unsigned, f); return (u + 0x7fffu + ((u >> 16) & 1u)) >> 16; }
typedef float f32x2_hw __attribute__((ext_vector_type(2))); typedef __bf16 bf16x2_hw __attribute__((ext_vector_type(2)));
__device__ __forceinline__ unsigned pk2(float lo, float hi) { f32x2_hw v = {lo, hi}; bf16x2_hw b = __builtin_convertvector(v, bf16x2_hw); return __builtin_bit_cast(unsigned, b); }
__device__ __forceinline__ float bf2f(unsigned short b) { return __uint_as_float((unsigned)b << 16); }
__device__ __forceinline__ float wave_sum(float v) {
#pragma unroll
    for (int o = 1; o < 64; o <<= 1) v += __shfl_xor(v, o);
    return v;
}
#define XB_TMO      128
#define XB_XCNT(j)  (256  + 64 * (j))
#define XB_XSUB(j)  (1280 + 64 * (j))
#define XB_XGEN(j)  (2304 + 64 * (j))
#define XB_TOP      3328
#define XB_TOPGEN   3392
#define XCD_BAR_WORDS 3456
#define XB_SPIN_CAP (1u << 18)

__device__ __forceinline__ unsigned xb_ld(unsigned* p)              { return __hip_atomic_load(p, __ATOMIC_RELAXED, __HIP_MEMORY_SCOPE_AGENT); }
__device__ __forceinline__ unsigned xb_add(unsigned* p, unsigned v) { return __hip_atomic_fetch_add(p, v, __ATOMIC_RELAXED, __HIP_MEMORY_SCOPE_AGENT); }
__device__ __forceinline__ unsigned xb_xcc_id() { return (unsigned)__builtin_amdgcn_s_getreg((3 << 11) | 20) & 0xFu; }
#define XB_SPIN(cond, bar) do { unsigned _sp = 0; while (cond) { __builtin_amdgcn_s_sleep(1); \
    if ((++_sp & 255u) == 0u) { if (xb_ld(&(bar)[XB_TMO])) break; if (_sp > XB_SPIN_CAP) { atomicAdd(&(bar)[XB_TMO], 1u); break; } } } } while (0)

struct XcdBarrier {
    unsigned* bar; unsigned x;
    volatile LAS unsigned* st;
};

__device__ __forceinline__ XcdBarrier xcd_barrier_post(unsigned* bar, volatile LAS unsigned* st) {
    XcdBarrier b; b.bar = bar; b.x = xb_xcc_id(); b.st = st;
    if (threadIdx.x == 0) (void)xb_add(&bar[XB_XCNT(b.x)], 1u);
    return b;
}
__device__ __forceinline__ void xcd_barrier_complete(unsigned* bar, unsigned x, unsigned& nloc, unsigned& nx) {
    const unsigned G = gridDim.x * gridDim.y * gridDim.z;
    unsigned sum, cnt, mine, sp = 0u;
    for (;;) {
        sum = 0u; cnt = 0u; mine = 0u;
#pragma unroll
        for (unsigned j = 0; j < 16; ++j) { const unsigned c = xb_ld(&bar[XB_XCNT(j)]); sum += c; cnt += (c > 0u) ? 1u : 0u; mine = (j == x) ? c : mine; }
        if (sum == G) break;
        __builtin_amdgcn_s_sleep(1);
        if ((++sp & 255u) == 0u) { if (xb_ld(&bar[XB_TMO])) break; if (sp > XB_SPIN_CAP) { atomicAdd(&bar[XB_TMO], 1u); break; } }
    }
    nloc = mine > 0u ? mine : 1u; nx = cnt > 0u ? cnt : 1u;
}

__device__ __forceinline__ void xcd_barrier(const XcdBarrier& b) {
    asm volatile("s_waitcnt vmcnt(0)" ::: "memory");
    __syncthreads();
    if (threadIdx.x == 0) {
        unsigned* bar = b.bar;
        __builtin_amdgcn_s_waitcnt(0);
        unsigned nloc = b.st[0], nx = b.st[1];
        if (nloc == 0u) { xcd_barrier_complete(bar, b.x, nloc, nx); b.st[0] = nloc; b.st[1] = nx; }
        const unsigned old = xb_add(&bar[XB_XSUB(b.x)], 1u);
        const unsigned gen = old / nloc;
        if (old + 1u == (gen + 1u) * nloc) {
            __builtin_amdgcn_fence(__ATOMIC_RELEASE, "agent");
            asm volatile("s_waitcnt vmcnt(0)" ::: "memory");
            const unsigned og = xb_add(&bar[XB_TOP], 1u);
            const unsigned tg = og / nx;
            if (og + 1u == (tg + 1u) * nx) xb_add(&bar[XB_TOPGEN], 1u);
            else XB_SPIN(xb_ld(&bar[XB_TOPGEN]) == tg, bar);
            __builtin_amdgcn_fence(__ATOMIC_ACQUIRE, "agent");
            xb_add(&bar[XB_XGEN(b.x)], 1u);
            asm volatile("s_waitcnt vmcnt(0)" ::: "memory");
        } else {
            XB_SPIN(xb_ld(&bar[XB_XGEN(b.x)]) == gen, bar);
            __builtin_amdgcn_fence(__ATOMIC_ACQUIRE, "agent");
            asm volatile("s_waitcnt vmcnt(0)" ::: "memory");
        }
    }
    __syncthreads();
}

struct Frame {
    LAS unsigned char* lds;
    volatile LAS unsigned* MISC;
    gu32* ctl;
    int wave;
    int vcu, G;
    const float* in[20]; float* out; unsigned char* ws;
};
#define WSP(T, off) ((T*)(F.ws + (off)))

__device__ __forceinline__ int win_rowmap(int n) {
    if (n >= 2560 && n < 3072) { const int cq = n - 2560, hd = cq >> 6, d = cq & 63; return 256 * (10 + (hd >> 2)) + 128 * (d >> 5) + 32 * (hd & 3) + (d & 31); }
    if (n >= 3072 && n < 3328) { const int c = n - 3072, hh = c >> 6, d = c & 63; return 3072 + 128 * (d >> 5) + 32 * hh + (d & 31); }
    if (n >= 3328) { const int c = n - 3328, z = c >> 10, cc = c & 1023; return 3328 + 256 * (cc >> 7) + 128 * z + (cc & 127); }
    return n;
}
template <int KIND>
__device__ __forceinline__ void p0_transpose_item(const float* W, int K, int N, bf16* WT, int row_off, const float* kscale, LAS float* scr, int item, int lane) {
    const int nblk = N / 32, kb = item / nblk, nb = item % nblk, k0 = 64 * kb, n0 = 32 * nb;
    float wv[32];
#pragma unroll
    for (int i = 0; i < 32; ++i) { const int kk = 2 * i + (lane >> 5); wv[i] = W[(size_t)(k0 + kk) * N + n0 + (lane & 31)]; }
#pragma unroll
    for (int i = 0; i < 32; ++i) { const int kk = 2 * i + (lane >> 5); const float sc = kscale ? kscale[k0 + kk] : 1.0f; scr[kk * 33 + (lane & 31)] = wv[i] * sc; }
    LDS_WAIT(); asm volatile("" ::: "memory");
    const int c = lane & 7;
#pragma unroll
    for (int j = 0; j < 4; ++j) { const int n = (lane >> 3) + 8 * j; const LAS float* s = scr + (8 * c) * 33 + n;
        v4u o; o.x = pk2(s[0 * 33], s[1 * 33]); o.y = pk2(s[2 * 33], s[3 * 33]); o.z = pk2(s[4 * 33], s[5 * 33]); o.w = pk2(s[6 * 33], s[7 * 33]);
        const int nn = n0 + n; const int drow = (KIND == 0) ? row_off + nn : ((KIND == 1) ? 256 * (nn >> 7) + (nn & 127) + row_off : win_rowmap(nn));
        *(GAS v4u*)(WT + (size_t)drow * K + k0 + 8 * c) = o; }
    LDS_WAIT(); asm volatile("" ::: "memory");
}
__device__ __forceinline__ void row_to_bf16(int lane, const float* xrow, bf16* orow, float* ssq16) {
    const GAS f32x4* xr = (const GAS f32x4*)xrow + lane;
    f32x4 v[4]; float s = 0.f;
#pragma unroll
    for (int j = 0; j < 4; ++j) { v[j] = xr[64 * j]; s += (v[j].x * v[j].x + v[j].y * v[j].y) + (v[j].z * v[j].z + v[j].w * v[j].w); }
    s = wave_sum(s);
    GAS unsigned long long* o8 = (GAS unsigned long long*)orow + lane;
#pragma unroll
    for (int j = 0; j < 4; ++j) o8[64 * j] = (unsigned long long)pk2(v[j].x, v[j].y) | ((unsigned long long)pk2(v[j].z, v[j].w) << 32);
    if (lane < 16) ssq16[lane] = (lane == 0) ? s : 0.f;
}
__device__ __forceinline__ void sincos_d(double a, float& sn, float& cs) {
    const double TWO_PI = 6.283185307179586476925286766559;
    const double k = __builtin_rint(a / TWO_PI); const double x = a - k * TWO_PI;
    const double x2 = x * x; double ts = 1.0, tc = 1.0, ss = 1.0, cc = 1.0;
#pragma unroll
    for (int i = 1; i <= 13; ++i) { tc = -tc * x2 / (double)((2 * i - 1) * (2 * i)); ts = -ts * x2 / (double)((2 * i) * (2 * i + 1)); cc += tc; ss += ts; }
    sn = (float)(ss * x); cs = (float)cc;
}
constexpr int I_G = (DM / 64) * (DFF / 32), I_D = (DFF / 64) * (DM / 32), I_IN = (DM / 64) * (NIN / 32), I_U = (HGW / 64) * (DM / 32), I_O = (DM / 64) * (DM / 32);
constexpr int CV_FFN1 = 2 * I_G + I_D, CV_IN = CV_FFN1 + I_IN, CV_ALL = CV_IN + 2 * I_U + I_O + 2 * I_G + I_D;
__device__ __forceinline__ void convert_items(Frame& F, int it_lo, int it_hi, int wrank, int nw) {
    LAS float* scr = (LAS float*)(F.lds + RING_OFF + F.wave * 16384);
    const int lane = (int)threadIdx.x & 63;
    bf16* Wb = WSP(bf16, WS_W);
    for (int it = it_lo + wrank; it < it_hi; it += nw) {
        int r = it;
        if (r < I_G) { p0_transpose_item<1>(F.in[3], DM, DFF, Wb + W_GU1 / 2, 0, F.in[2], scr, r, lane); continue; } r -= I_G;
        if (r < I_G) { p0_transpose_item<1>(F.in[4], DM, DFF, Wb + W_GU1 / 2, 128, F.in[2], scr, r, lane); continue; } r -= I_G;
        if (r < I_D) { p0_transpose_item<0>(F.in[5], DFF, DM, Wb + W_D1 / 2, 0, nullptr, scr, r, lane); continue; } r -= I_D;
        if (r < I_IN) { p0_transpose_item<2>(F.in[7], DM, NIN, Wb + W_IN / 2, 0, F.in[6], scr, r, lane); continue; } r -= I_IN;
        if (r < I_U) { p0_transpose_item<0>(F.in[13], HGW, DM, Wb + W_UP / 2, 0, nullptr, scr, r, lane); continue; } r -= I_U;
        if (r < I_U) { p0_transpose_item<0>(F.in[14], HGW, DM, Wb + W_UP / 2, 1024, nullptr, scr, r, lane); continue; } r -= I_U;
        if (r < I_O) { p0_transpose_item<0>(F.in[15], DM, DM, Wb + W_OUT / 2, 0, nullptr, scr, r, lane); continue; } r -= I_O;
        if (r < I_G) { p0_transpose_item<1>(F.in[17], DM, DFF, Wb + W_GU2 / 2, 0, F.in[16], scr, r, lane); continue; } r -= I_G;
        if (r < I_G) { p0_transpose_item<1>(F.in[18], DM, DFF, Wb + W_GU2 / 2, 128, F.in[16], scr, r, lane); continue; } r -= I_G;
        p0_transpose_item<0>(F.in[19], DFF, DM, Wb + W_D2 / 2, 0, nullptr, scr, r, lane);
    }
}
__device__ __forceinline__ void convert_in_idle_slot(Frame& F, int nwg, int it_lo, int it_hi) {
    const int cut = nwg % F.G, c = (int)blockIdx.x;
    if (c < cut) return;
    convert_items(F, it_lo, it_hi, (c - cut) * NWAVES + F.wave, (F.G - cut) * NWAVES);
    __syncthreads();
}
__device__ __forceinline__ void stagger_short_share(Frame& F, int nwg, int sleeps) {
    const int cut = nwg % F.G; if (cut == 0 || (int)blockIdx.x < cut) return;
    for (int i = 0; i < sleeps; ++i) __builtin_amdgcn_s_sleep(127);
}
__device__ __forceinline__ void p0_prologue(Frame& F) {
    const int gw = F.vcu * NWAVES + F.wave, NGW = F.G * NWAVES;
    convert_items(F, 0, CV_FFN1, gw, NGW);
    {
        const int lane = (int)threadIdx.x & 63;
        for (int m0 = gw; m0 < M; m0 += 4 * NGW) {
            f32x4 v[4][4]; float sq[4];
#pragma unroll
            for (int q = 0; q < 4; ++q) { const int m = m0 + q * NGW; const GAS f32x4* xr = (const GAS f32x4*)(F.in[0] + (size_t)(m < M ? m : m0) * DM) + lane;
#pragma unroll
                for (int j = 0; j < 4; ++j) v[q][j] = xr[64 * j]; }
#pragma unroll
            for (int q = 0; q < 4; ++q) { float t = 0.f;
#pragma unroll
                for (int j = 0; j < 4; ++j) t += (v[q][j].x * v[q][j].x + v[q][j].y * v[q][j].y) + (v[q][j].z * v[q][j].z + v[q][j].w * v[q][j].w);
                sq[q] = wave_sum(t); }
#pragma unroll
            for (int q = 0; q < 4; ++q) { const int m = m0 + q * NGW; if (m < M) {
                GAS unsigned long long* o8 = (GAS unsigned long long*)(WSP(bf16, WS_HB) + (size_t)m * DM) + lane;
#pragma unroll
                for (int j = 0; j < 4; ++j) o8[64 * j] = (unsigned long long)pk2(v[q][j].x, v[q][j].y) | ((unsigned long long)pk2(v[q][j].z, v[q][j].w) << 32);
                if (lane < 16) (WSP(float, WS_SSQ0) + (size_t)m * 16)[lane] = (lane == 0) ? sq[q] : 0.f; } }
        }
    }
    if (gw < NMETA) row_to_bf16(((int)threadIdx.x & 63), F.in[1] + (size_t)gw * DM, WSP(bf16, WS_MISC + MISC_METAB) + (size_t)gw * DM, WSP(float, WS_MISC + MISC_SSQ0M) + gw * 16);
    const int gt = F.vcu * (NWAVES * 64) + (int)threadIdx.x;
    if (gt < 320 * 16) {
        const int pos = gt >> 4, j = gt & 15;
        const double inv = (double)exp2f(-(float)j * (13.287712379549449f / 16.0f));
        float sn, cs; sincos_d((double)(pos < 256 ? pos : pos - 256) * inv, sn, cs);
        f32x2* tab = (pos < 256) ? WSP(f32x2, WS_MISC + MISC_ROPER) + pos * 16 + j : WSP(f32x2, WS_MISC + MISC_ROPEC) + (pos - 256) * 16 + j;
        *tab = (f32x2){cs, sn};
    } else if (gt < 320 * 16 + 1024) {
        const int i = gt - 320 * 16, k = i & 511; const float* lb = (i < 512) ? F.in[8] : F.in[9];
        const float a0 = lb[k], a1 = lb[512 + k];
        (i < 512 ? WSP(float, WS_MISC + MISC_OMLF) : WSP(float, WS_MISC + MISC_OMLB))[k] = 1.0f / (1.0f + __expf(a0 - a1));
    }
}

template <int NG, int KS>
__device__ __forceinline__ void thin_job(const bf16* A, const bf16* Bt, const int (&brow)[NG], int K, LAS float* red, f32x4 (&acc)[NG], int wave, int lane) {
    const int kbeg = wave * KS * 32;
    const bf16* ap = A + (size_t)(lane & 15) * K + kbeg + 8 * (lane >> 4);
#pragma unroll
    for (int g = 0; g < NG; ++g) acc[g] = (f32x4){0.f, 0.f, 0.f, 0.f};
    bf16x8 af[KS];
#pragma unroll
    for (int s2 = 0; s2 < KS; ++s2) af[s2] = *(const GAS bf16x8*)(ap + 32 * s2);
#pragma unroll
    for (int g = 0; g < NG; ++g) {
        const bf16* bp = Bt + (size_t)(brow[g] + (lane & 15)) * K + kbeg + 8 * (lane >> 4);
        bf16x8 bfr[KS];
#pragma unroll
        for (int s2 = 0; s2 < KS; ++s2) bfr[s2] = *(const GAS bf16x8*)(bp + 32 * s2);
#pragma unroll
        for (int s2 = 0; s2 < KS; ++s2) acc[g] = __builtin_amdgcn_mfma_f32_16x16x32_bf16(af[s2], bfr[s2], acc[g], 0, 0, 0);
    }
#pragma unroll
    for (int g = 0; g < NG; ++g) *(LAS f32x4*)(red + ((wave * NG + g) * 64 + lane) * 4) = acc[g];
    __syncthreads();
    if (wave == 0) {
#pragma unroll
        for (int g = 0; g < NG; ++g) { f32x4 sum = acc[g];
#pragma unroll
            for (int w2 = 1; w2 < 8; ++w2) sum += *(const LAS f32x4*)(red + ((w2 * NG + g) * 64 + lane) * 4);
            acc[g] = sum; }
    }
    __syncthreads();
}
__device__ __forceinline__ int slack_first(int nwg, int G, int njobs) { const int cut = nwg % G; return (cut && G - cut >= njobs) ? cut : 0; }
__device__ __forceinline__ void meta_p1(Frame& F) {
    const int job = (int)blockIdx.x - slack_first((M / 256) * (NGU / 256), F.G, DFF / 32); if (job < 0 || job >= DFF / 32) return;
    const int j0 = 32 * job, j1 = j0 + 16, lane = (int)threadIdx.x & 63;
    const int brow[4] = {256 * (j0 >> 7) + (j0 & 127), 256 * (j0 >> 7) + (j0 & 127) + 128, 256 * (j1 >> 7) + (j1 & 127), 256 * (j1 >> 7) + (j1 & 127) + 128};
    f32x4 acc[4];
    thin_job<4, 4>(WSP(bf16, WS_MISC + MISC_METAB), WSP(bf16, WS_W + W_GU1), brow, DM, (LAS float*)(F.lds + RING_OFF), acc, F.wave, lane);
    if (F.wave != 0) return;
    const float* ssq = WSP(float, WS_MISC + MISC_SSQ0M); bf16* act = WSP(bf16, WS_MISC + MISC_ACTM);
#pragma unroll
    for (int r = 0; r < 4; ++r) { const int row = 4 * (lane >> 4) + r; const float rs = rsqrtf(ssq[row * 16] * (1.0f / 1024.0f) + pg8::RMS_EPS);
        act[(size_t)row * DFF + j0 + (lane & 15)] = (bf16)f2bf(pg8::fast_silu(acc[0][r] * rs) * (acc[1][r] * rs));
        act[(size_t)row * DFF + j1 + (lane & 15)] = (bf16)f2bf(pg8::fast_silu(acc[2][r] * rs) * (acc[3][r] * rs)); }
}
__device__ __forceinline__ void meta_p2(Frame& F) {
    const int job = (int)blockIdx.x; if (job >= DM / 16) return;
    const int c0 = 16 * job, lane = (int)threadIdx.x & 63;
    const int brow[1] = {c0};
    f32x4 acc[1];
    thin_job<1, 11>(WSP(bf16, WS_MISC + MISC_ACTM), WSP(bf16, WS_W + W_D1), brow, DFF, (LAS float*)(F.lds + RING_OFF), acc, F.wave, lane);
    if (F.wave != 0) return;
    float* h1 = WSP(float, WS_MISC + MISC_H1M); bf16* h1b = WSP(bf16, WS_MISC + MISC_H1MB); float* ssqm = WSP(float, WS_MISC + MISC_SSQM);
#pragma unroll
    for (int r = 0; r < 4; ++r) { const int row = 4 * (lane >> 4) + r; const size_t o = (size_t)row * DM + c0 + (lane & 15);
        const float v = F.in[1][o] + 0.5f * acc[0][r]; h1[o] = v; h1b[o] = (bf16)f2bf(v);
        float sq = v * v; sq += __shfl_xor(sq, 1); sq += __shfl_xor(sq, 2); sq += __shfl_xor(sq, 4); sq += __shfl_xor(sq, 8);
        if ((lane & 15) == 0) ssqm[row * 64 + job] = sq; }
}
__device__ __forceinline__ void meta_p3(Frame& F) {
    const int lane = (int)threadIdx.x & 63;
    bf16* HV = WSP(bf16, WS_Z + Z_HV); bf16* ZFF = WSP(bf16, WS_Z + Z_ZFF); bf16* KB = WSP(bf16, WS_Z + Z_KB); bf16* VB = WSP(bf16, WS_Z + Z_VB);
    if ((int)blockIdx.x == F.G - 1) {
        const v4u zero = {0u, 0u, 0u, 0u};
        for (int p = (int)threadIdx.x; p < 112 * 512 / 8; p += NWAVES * 64) { ((GAS v4u*)HV)[p] = zero; ((GAS v4u*)ZFF)[p] = zero; }
        for (int p = (int)threadIdx.x; p < 112 * 128 / 8; p += NWAVES * 64) { ((GAS v4u*)(KB + (size_t)(M + 16) * 128))[p] = zero; ((GAS v4u*)(VB + (size_t)(M + 16) * 128))[p] = zero; }
    }
    const int job = (int)blockIdx.x - slack_first((M / 256) * (NIN / 256), F.G, 20); if (job < 0 || job >= 20) return;
    int brow[4];
    if (job < 16) {
#pragma unroll
        for (int g = 0; g < 4; ++g) brow[g] = (job < 8 ? 512 : 1024) + 64 * (job & 7) + 16 * g;
    } else {
#pragma unroll
        for (int g = 0; g < 4; ++g) brow[g] = 3072 + 128 * (g >> 1) + 32 * (job - 16) + 16 * (g & 1);
    }
    f32x4 x[4];
    thin_job<4, 4>(WSP(bf16, WS_MISC + MISC_H1MB), WSP(bf16, WS_W + W_IN), brow, DM, (LAS float*)(F.lds + RING_OFF), x, F.wave, lane);
    if (F.wave != 0) return;
    float rs4[4];
    { const f32x4* p = (const f32x4*)(WSP(float, WS_MISC + MISC_SSQM) + (lane >> 2) * 64 + (lane & 3) * 16);
      const f32x4 a = p[0], b = p[1], c = p[2], d = p[3];
      float sq = (((a[0] + a[1]) + (a[2] + a[3])) + ((b[0] + b[1]) + (b[2] + b[3]))) + (((c[0] + c[1]) + (c[2] + c[3])) + ((d[0] + d[1]) + (d[2] + d[3])));
      sq += __shfl_xor(sq, 1); sq += __shfl_xor(sq, 2);
      const float rsv = rsqrtf(sq * (1.0f / 1024.0f) + pg8::RMS_EPS);
#pragma unroll
      for (int r = 0; r < 4; ++r) rs4[r] = __shfl(rsv, 4 * (4 * (lane >> 4) + r)); }
    if (job < 16) {
        bf16* dst = (job < 8 ? HV : ZFF) + 64 * (job & 7);
#pragma unroll
        for (int r = 0; r < 4; ++r) { const int row = 4 * (lane >> 4) + r;
#pragma unroll
            for (int g = 0; g < 4; ++g) { float v = x[g][r] * rs4[r];
                if (job >= 8) v = __builtin_amdgcn_logf(1.0f - WSP(float, WS_MISC + MISC_OMLF)[64 * (job & 7) + 16 * g + (lane & 15)] * __builtin_amdgcn_rcpf(1.0f + __builtin_amdgcn_exp2f(v * 1.4426950408889634f)));
                dst[(size_t)(112 + row) * HGW + 16 * g + (lane & 15)] = (bf16)f2bf(v); } }
    } else {
        const int hh = job - 16;
#pragma unroll
        for (int r = 0; r < 4; ++r) {
            const int row = 4 * (lane >> 4) + r; float v[4]; float ss = 0.f;
#pragma unroll
            for (int g = 0; g < 4; ++g) { v[g] = x[g][r] * rs4[r]; ss += v[g] * v[g]; }
            if (hh < 2) { ss += __shfl_xor(ss, 1); ss += __shfl_xor(ss, 2); ss += __shfl_xor(ss, 4); ss += __shfl_xor(ss, 8);
                const float rn = rsqrtf(ss * (1.0f / 64.0f) + pg8::RMS_EPS);
#pragma unroll
                for (int g = 0; g < 4; ++g) v[g] *= rn * F.in[12][16 * g + (lane & 15)]; }
            bf16* dst = (hh < 2 ? KB : VB) + (size_t)(M + row) * 128 + 64 * (hh & 1);
#pragma unroll
            for (int g = 0; g < 4; ++g) dst[16 * g + (lane & 15)] = (bf16)f2bf(v[g]);
        }
    }
}

typedef LAS const char* lds_cptr;
typedef short v4i16_t __attribute__((ext_vector_type(4)));
__device__ __forceinline__ s16x4 vtr(lds_cptr p) { return __builtin_bit_cast(s16x4, __builtin_amdgcn_ds_read_tr16_b64_v4i16((LAS v4i16_t*)p)); }
__device__ __forceinline__ int crow(int r, int hi) { return (r & 3) + 8 * (r >> 2) + 4 * hi; }
__device__ __forceinline__ int hg_img_off(int tb, int k, int seg) { return tb * 8192 + (k ^ ((k >> 4) & 1)) * 64 + ((seg ^ (k >> 2)) & 3) * 16; }
__device__ __forceinline__ bf16x8 trfrag(lds_cptr img, int tb, int ks, int lane) {
    const int k0 = 16 * ks + 8 * (lane >> 5) + ((lane & 15) >> 2), seg = ((lane >> 4) & 1) * 2 + ((lane & 3) >> 1), sub = (lane & 1) * 8;
    const s16x4 lo = vtr(img + hg_img_off(tb, k0, seg) + sub), hi = vtr(img + hg_img_off(tb, k0 + 4, seg) + sub);
    return (bf16x8){lo[0], lo[1], lo[2], lo[3], hi[0], hi[1], hi[2], hi[3]};
}
__device__ __forceinline__ bf16* hg_slot(Frame& F, int dir, int j, int h) { return (bf16*)F.out + ((size_t)((dir * 128 + (j - 1)) * 4 + h) << 14); }

typedef unsigned u32x2g __attribute__((ext_vector_type(2)));
__device__ __forceinline__ void hg_load8(const bf16* base  , int sg, int cq, u32x2g (&r)[8]) {
    const bf16* p = base + (size_t)(8 * sg) * HGW + 4 * cq;
#pragma unroll
    for (int i = 0; i < 8; ++i) r[i] = *(const GAS u32x2g*)(p + (size_t)i * HGW);
}
__device__ __forceinline__ float hg_elem(const u32x2g (&r)[8], int i, int c) { const unsigned w = (c < 2) ? r[i].x : r[i].y; return (c & 1) ? __uint_as_float(w & 0xffff0000u) : __uint_as_float(w << 16); }
__device__ __forceinline__ unsigned hg_raw(const u32x2g (&r)[8], int i, int c) { const unsigned w = (c < 2) ? r[i].x : r[i].y; return (c & 1) ? (w >> 16) : (w & 0xffffu); }
__device__ __forceinline__ f32x4 hg_gates8(const u32x2g (&z)[8], float (&kk)[4][8], LAS float* tot, int sg, int cq) {
    f32x4 run = {0.f, 0.f, 0.f, 0.f};
#pragma unroll
    for (int c = 0; c < 4; ++c)
#pragma unroll
        for (int i = 0; i < 8; ++i) { const float g = hg_elem(z, i, c); run[c] += g; kk[c][i] = 1.0f - __builtin_amdgcn_exp2f(g); }
    *(LAS f32x4*)(tot + sg * 128 + 4 * cq) = run;
    return run;
}
__device__ __forceinline__ void hg_prefix(const LAS float* tot, const f32x4 own, int sg, int cq, int dir, f32x4& pre, f32x4& ref, f32x4& all) {
    f32x4 lo = {0.f, 0.f, 0.f, 0.f}, hi = lo, pf = lo;
#pragma unroll
    for (int s2 = 0; s2 < 16; ++s2) { const f32x4 v = *(const LAS f32x4*)(tot + s2 * 128 + 4 * cq); const float m = (s2 < sg) ? 1.0f : 0.0f;
        if (s2 < 8) lo += v; else hi += v;
        pf[0] = __builtin_fmaf(v[0], m, pf[0]); pf[1] = __builtin_fmaf(v[1], m, pf[1]); pf[2] = __builtin_fmaf(v[2], m, pf[2]); pf[3] = __builtin_fmaf(v[3], m, pf[3]); }
    all = lo + hi;
    if (dir) { pre = all - pf - own; ref = hi; } else { pre = pf; ref = lo; }
}
__device__ __forceinline__ v4u hg_pack8(const float (&x)[8], int dir) {
    v4u w;
    if (!dir) { w.x = pk2(x[0], x[1]); w.y = pk2(x[2], x[3]); w.z = pk2(x[4], x[5]); w.w = pk2(x[6], x[7]); }
    else { w.x = pk2(x[7], x[6]); w.y = pk2(x[5], x[4]); w.z = pk2(x[3], x[2]); w.w = pk2(x[1], x[0]); }
    return w;
}
__device__ __forceinline__ v4u hg_pack8raw(const u32x2g (&r)[8], int c, int dir) {
    v4u w;
    if (!dir) { w.x = hg_raw(r, 0, c) | (hg_raw(r, 1, c) << 16); w.y = hg_raw(r, 2, c) | (hg_raw(r, 3, c) << 16); w.z = hg_raw(r, 4, c) | (hg_raw(r, 5, c) << 16); w.w = hg_raw(r, 6, c) | (hg_raw(r, 7, c) << 16); }
    else { w.x = hg_raw(r, 7, c) | (hg_raw(r, 6, c) << 16); w.y = hg_raw(r, 5, c) | (hg_raw(r, 4, c) << 16); w.z = hg_raw(r, 3, c) | (hg_raw(r, 2, c) << 16); w.w = hg_raw(r, 1, c) | (hg_raw(r, 0, c) << 16); }
    return w;
}
template <int DIR> __device__ __forceinline__ void hg_pass2_state(const float (&kk)[8], const u32x2g (&zr)[8], int cc, float pre, float B, float (&kx)[8]) {
    float b = pre;
#pragma unroll
    for (int ii = 0; ii < 8; ++ii) { constexpr int dummy = 0; (void)dummy; const int i = DIR ? 7 - ii : ii; const float k = kk[i]; b += hg_elem(zr, i, cc); kx[i] = k * __builtin_amdgcn_exp2f(B - b); }
}
template <int DIR> __device__ __forceinline__ void hg_pass2_out(const float (&kk)[8], const u32x2g (&zr)[8], const u32x2g (&qr)[8], int cc, float pre, float rref, float (&qx)[8], float (&kx)[8]) {
    float b = pre;
#pragma unroll
    for (int ii = 0; ii < 8; ++ii) { const int i = DIR ? 7 - ii : ii; const float k = kk[i]; b += hg_elem(zr, i, cc); const float e = b - rref;
        qx[i] = hg_elem(qr, i, cc) * __builtin_amdgcn_exp2f(fminf(e, 115.f)); kx[i] = k * __builtin_amdgcn_exp2f(fminf(-e, 115.f)); }
}
#define HG4_DECODE(s_, c_, h_, d_, nv_) int c_, h_, d_; bool nv_; \
        if ((s_) < 8) { c_ = (s_) >> 2; h_ = (s_) & 3; d_ = 0; nv_ = true; } \
        else if ((s_) < 1016) { const int q_ = (s_) - 8; c_ = 2 + (q_ >> 3); h_ = (q_ >> 1) & 3; d_ = q_ & 1; nv_ = (d_ == 0); } \
        else { c_ = 128; h_ = (s_) - 1016; d_ = 1; nv_ = true; }
#define HG4_ISSUE_LOADS(s_) do { HG4_DECODE(s_, cN_, hN_, dN_, nvN_); const size_t cb_ = ((size_t)128 * cN_) * HGW + hN_ * 128; \
        hg_load8(WSP(bf16, WS_Z + (dN_ ? Z_ZFB : Z_ZFF)) + cb_, sg, cq, zr); if (nvN_) hg_load8(WSP(bf16, WS_Z + Z_HV) + cb_, sg, cq, vr); } while (0)
__device__ __forceinline__ void hg_state_phase(Frame& F) {
    const int w = F.wave;
    LAS float* tot = (LAS float*)(F.lds + HL_TOT);
    if (F.vcu >= 255) return;
    u32x2g zr[8], vr[8];
    { const int tid = threadIdx.x, cq = tid & 31, sg = tid >> 5; HG4_ISSUE_LOADS(4 * F.vcu); }
#pragma unroll 1
    for (int blk = F.vcu; blk < 255; blk += F.G)
#pragma unroll 1
    for (int js = 0; js < 4; ++js) {
        const int st = 4 * blk + js;
        int tid_ = threadIdx.x; asm volatile("" : "+v"(tid_));
        const int tid = tid_, lane = tid & 63, r = lane & 31, hi = lane >> 5, cq = tid & 31, sg = tid >> 5;
        HG4_DECODE(st, c, h, dir, newv);
        float kk[4][8];
        const f32x4 own = hg_gates8(zr, kk, tot, sg, cq);
        if (newv) {
#pragma unroll
            for (int cc = 0; cc < 4; ++cc) *(LAS v4u*)(F.lds + HL_VT + (4 * cq + cc) * HL_PITCH + sg * 16) = hg_pack8raw(vr, cc, 0);
        }
        __syncthreads();
        f32x4 pre, ref, B; hg_prefix(tot, own, sg, cq, dir, pre, ref, B);
#pragma unroll
        for (int cc = 0; cc < 4; ++cc) {
            float kx[8];
            if (dir) hg_pass2_state<1>(kk[cc], zr, cc, pre[cc], B[cc], kx); else hg_pass2_state<0>(kk[cc], zr, cc, pre[cc], B[cc], kx);
            *(LAS v4u*)(F.lds + HL_QH + (4 * cq + cc) * HL_PITCH + sg * 16) = hg_pack8(kx, 0);
        }
        if (sg == 0) { f32x4 dd; dd[0] = __builtin_amdgcn_exp2f(B[0]); dd[1] = __builtin_amdgcn_exp2f(B[1]); dd[2] = __builtin_amdgcn_exp2f(B[2]); dd[3] = __builtin_amdgcn_exp2f(B[3]); *(f32x4*)(WSP(float, WS_MISC + (dir ? MISC_DB : MISC_DF)) + c * HGW + h * 128 + 4 * cq) = dd; }
        { const int sn = (js < 3) ? st + 1 : 4 * (blk + F.G); if (js < 3 || blk + F.G < 255) HG4_ISSUE_LOADS(sn); }
        __syncthreads();
        const int vb = w >> 1;
#pragma unroll
        for (int kbi = 0; kbi < 2; ++kbi) {
            const int kb = 2 * (w & 1) + kbi; f32x16 acc = {};
#pragma unroll
            for (int ks = 0; ks < 8; ++ks) {
                const bf16x8 a = *(const LAS bf16x8*)(F.lds + HL_VT + (32 * vb + r) * HL_PITCH + (16 * ks + 8 * hi) * 2);
                const bf16x8 bq = *(const LAS bf16x8*)(F.lds + HL_QH + (32 * kb + r) * HL_PITCH + (16 * ks + 8 * hi) * 2);
                acc = __builtin_amdgcn_mfma_f32_32x32x16_bf16(bq, a, acc, 0, 0, 0);
            }
            LAS unsigned char* ut = F.lds + HL_ST + (32 * vb + r) * HL_PITCH + (32 * kb + 4 * hi) * 2;
#pragma unroll
            for (int q4 = 0; q4 < 4; ++q4) { u32x2g w; w.x = pk2(acc[4 * q4], acc[4 * q4 + 1]); w.y = pk2(acc[4 * q4 + 2], acc[4 * q4 + 3]); *(LAS u32x2g*)(ut + 16 * q4) = w; }
        }
        __syncthreads();
        { bf16* slot = hg_slot(F, dir, dir ? c - 1 : c + 1, h);
#pragma unroll
          for (int j = 0; j < 4; ++j) { const int p = tid + 512 * j, v = p >> 4, k8 = (p & 15) * 8; *(GAS v4u*)(slot + (size_t)v * 128 + k8) = *(const LAS v4u*)(F.lds + HL_ST + v * HL_PITCH + k8 * 2); } }
    }
    __syncthreads();
}
#undef HG4_ISSUE_LOADS
#undef HG4_DECODE
__device__ __forceinline__ void hg_scan_phase(Frame& F) {
    if ((int)threadIdx.x >= 256) return;
    for (int task = F.vcu * 256 + (int)threadIdx.x; task < 65536; task += F.G * 256) {
        const int dir = task >> 15, h = (task >> 13) & 3, p = task & 8191, v = p >> 6, k = (p & 63) * 2;
        const float* dd = WSP(float, WS_MISC + (dir ? MISC_DB : MISC_DF)) + h * 128 + k;
        unsigned* base = (unsigned*)(hg_slot(F, dir, 1, h) + v * 128 + k);
        const size_t jstride = (size_t)4 * 8192;
        const int j0 = dir ? 127 : 1, step = dir ? -1 : 1;
        unsigned w0 = base[(size_t)(j0 - 1) * jstride]; float s0 = pg8::bf_lo(w0), s1 = pg8::bf_hi(w0);
#pragma unroll 1
        for (int n = 0; n < 127 - dir; n += 32) {
            unsigned wv[32]; f32x2 dv[32];
#pragma unroll
            for (int q = 0; q < 32; ++q) { const int j = j0 + step * (n + q + 1); const bool ok = (n + q) < 127 - dir; const int jj = ok ? j : j0;
                wv[q] = base[(size_t)(jj - 1) * jstride]; dv[q] = *(const f32x2*)(dd + (size_t)(jj - step) * HGW); }
#pragma unroll
            for (int q = 0; q < 32; ++q) { if ((n + q) < 127 - dir) { const int j = j0 + step * (n + q + 1);
                s0 = dv[q].x * s0 + pg8::bf_lo(wv[q]); s1 = dv[q].y * s1 + pg8::bf_hi(wv[q]);
                base[(size_t)(j - 1) * jstride] = pk2(s0, s1); } }
        }
    }
}
template <int CTRL> __device__ __forceinline__ float dpp_add(float v) { return v + __builtin_bit_cast(float, __builtin_amdgcn_update_dpp(0, __builtin_bit_cast(int, v), CTRL, 0xf, 0xf, false)); }
#define HG_ISSUE_LOADS(cN, hN, dirN) do { \
        const size_t cb_ = ((size_t)128 * (cN)) * HGW + (hN) * 128; \
        hg_load8(WSP(bf16, WS_Z + ((dirN) ? Z_ZFB : Z_ZFF)) + cb_, sg, cq, zr); \
        const bool hs_ = !((dirN) == 1 && (cN) == 128); const bf16* sl_ = hg_slot(F, (dirN), hs_ ? (cN) : 1, (hN)); \
        _Pragma("unroll") for (int j_ = 0; j_ < 4; ++j_) { const int p_ = tid + 512 * j_; sraw[j_] = *(const GAS v4u*)(sl_ + (size_t)(p_ >> 4) * 128 + (p_ & 15) * 8); } } while (0)
__device__ __forceinline__ void hg_out_phase(Frame& F, bf16* yabase) {
    const int w = F.wave, vh = w >> 2, tb = vh ? 3 - (w & 3) : (w & 3);
    LAS float* tot = (LAS float*)(F.lds + HL_TOT); LAS float* er = (LAS float*)(F.lds + HL_ER); LAS float* ssqx = (LAS float*)(F.lds + HL_SSQ); LAS float* ox = (LAS float*)(F.lds);
    const lds_cptr QH = (lds_cptr)(F.lds + HL_QH), KH = (lds_cptr)(F.lds + HL_KH);
    const int nun = (512 - F.vcu + F.G - 1) / F.G;
    if (nun <= 0) return;
    u32x2g zr[8]; v4u sraw[4];
    { const int tid = threadIdx.x, cq = tid & 31, sg = tid >> 5; HG_ISSUE_LOADS(1 + (F.vcu >> 2), F.vcu & 3, 0); }
    f32x16 of0 = {}, of1 = {};
#pragma unroll 1
    for (int st = 0; st < 2 * nun; ++st) {
        int tid_ = threadIdx.x; asm volatile("" : "+v"(tid_));
        const int tid = tid_, lane = tid & 63, r = lane & 31, hi = lane >> 5, cq = tid & 31, sg = tid >> 5;
        const int uid = F.vcu + (st >> 1) * F.G, c = 1 + (uid >> 2), h = uid & 3, dir = st & 1;
        const bool hasS = !(dir == 1 && c == 128);
        const int sgu = dir ? 15 - sg : sg;
        u32x2g qr[8], vr[8];
        { const size_t cb = ((size_t)128 * c) * HGW + h * 128; hg_load8(WSP(bf16, WS_Z + Z_HQ) + cb, sg, cq, qr); hg_load8(WSP(bf16, WS_Z + Z_HV) + cb, sg, cq, vr); }
        float kk[4][8];
        const f32x4 own = hg_gates8(zr, kk, tot, sg, cq);
#pragma unroll
        for (int cc = 0; cc < 4; ++cc) *(LAS v4u*)(F.lds + HL_VT + (4 * cq + cc) * HL_PITCH + sgu * 16) = hg_pack8raw(vr, cc, dir);
        __syncthreads();
        f32x4 pre, rref, ball; hg_prefix(tot, own, sg, cq, dir, pre, rref, ball);
#pragma unroll
        for (int cc = 0; cc < 4; ++cc) {
            float qx[8], kx[8];
            if (dir) hg_pass2_out<1>(kk[cc], zr, qr, cc, pre[cc], rref[cc], qx, kx); else hg_pass2_out<0>(kk[cc], zr, qr, cc, pre[cc], rref[cc], qx, kx);
            const int off = hg_img_off(sgu >> 2, 4 * cq + cc, sgu & 3);
            *(LAS v4u*)(F.lds + HL_QH + off) = hg_pack8(qx, dir); *(LAS v4u*)(F.lds + HL_KH + off) = hg_pack8(kx, dir);
        }
        if (sg == 0) { f32x4 ee; ee[0] = __builtin_amdgcn_exp2f(rref[0]); ee[1] = __builtin_amdgcn_exp2f(rref[1]); ee[2] = __builtin_amdgcn_exp2f(rref[2]); ee[3] = __builtin_amdgcn_exp2f(rref[3]); *(LAS f32x4*)(er + 4 * cq) = ee; }
        __syncthreads();
        if (hasS) {
#pragma unroll
            for (int j = 0; j < 4; ++j) { const int p = tid + 512 * j, v = p >> 4, k8 = (p & 15) * 8;
                const v4u sv = sraw[j];
                const f32x4 e0 = *(const LAS f32x4*)(er + k8), e1 = *(const LAS f32x4*)(er + k8 + 4); v4u o;
                o.x = pk2(pg8::bf_lo(sv.x) * e0[0], pg8::bf_hi(sv.x) * e0[1]); o.y = pk2(pg8::bf_lo(sv.y) * e0[2], pg8::bf_hi(sv.y) * e0[3]);
                o.z = pk2(pg8::bf_lo(sv.z) * e1[0], pg8::bf_hi(sv.z) * e1[1]); o.w = pk2(pg8::bf_lo(sv.w) * e1[2], pg8::bf_hi(sv.w) * e1[3]);
                *(LAS v4u*)(F.lds + HL_ST + v * HL_PITCH + k8 * 2) = o; }
        }
        if (st + 1 < 2 * nun) { const int uidn = F.vcu + ((st + 1) >> 1) * F.G; HG_ISSUE_LOADS(1 + (uidn >> 2), uidn & 3, (st + 1) & 1); }
        __syncthreads();
        f32x16 o0 = {}, o1 = {};
        bf16x8 qf[8];
#pragma unroll
        for (int ks = 0; ks < 8; ++ks) qf[ks] = trfrag(QH, tb, ks, lane);
        if (hasS) {
#pragma unroll
            for (int ks = 0; ks < 8; ++ks) {
                const bf16x8 a = qf[ks];
                const bf16x8 b0 = *(const LAS bf16x8*)(F.lds + HL_ST + (64 * vh + r) * HL_PITCH + (16 * ks + 8 * hi) * 2);
                const bf16x8 b1 = *(const LAS bf16x8*)(F.lds + HL_ST + (64 * vh + 32 + r) * HL_PITCH + (16 * ks + 8 * hi) * 2);
                o0 = __builtin_amdgcn_mfma_f32_32x32x16_bf16(a, b0, o0, 0, 0, 0); o1 = __builtin_amdgcn_mfma_f32_32x32x16_bf16(a, b1, o1, 0, 0, 0);
            }
        }
#pragma unroll 1
        for (int sb = 0; sb <= tb; ++sb) {
            f32x16 ct = {};
#pragma unroll
            for (int ks = 0; ks < 8; ++ks) { const bf16x8 a = trfrag(KH, sb, ks, lane); ct = __builtin_amdgcn_mfma_f32_32x32x16_bf16(a, qf[ks], ct, 0, 0, 0); }
            if (sb == tb) {
                int rr = r - 4 * hi; asm volatile("" : "+v"(rr));
#pragma unroll
                for (int g = 0; g < 16; ++g) if ((g & 3) + 8 * (g >> 2) > rr) ct[g] = 0.f;
            }
            v4u pw[2];
#pragma unroll
            for (int s2 = 0; s2 < 2; ++s2) { pw[s2].x = pk2(ct[8 * s2], ct[8 * s2 + 1]); pw[s2].y = pk2(ct[8 * s2 + 2], ct[8 * s2 + 3]); pw[s2].z = pk2(ct[8 * s2 + 4], ct[8 * s2 + 5]); pw[s2].w = pk2(ct[8 * s2 + 6], ct[8 * s2 + 7]); }
#pragma unroll
            for (int s2 = 0; s2 < 2; ++s2) {
                const bf16x8 pa = __builtin_bit_cast(bf16x8, pw[s2]);
                const LAS unsigned char* v0 = F.lds + HL_VT + (64 * vh + r) * HL_PITCH + (32 * sb + 16 * s2 + 4 * hi) * 2; const LAS unsigned char* v1 = v0 + 32 * HL_PITCH;
                const s16x4 a0 = *(const LAS s16x4*)v0, a1 = *(const LAS s16x4*)(v0 + 16), c0 = *(const LAS s16x4*)v1, c1 = *(const LAS s16x4*)(v1 + 16);
                o0 = __builtin_amdgcn_mfma_f32_32x32x16_bf16(pa, (bf16x8){a0[0], a0[1], a0[2], a0[3], a1[0], a1[1], a1[2], a1[3]}, o0, 0, 0, 0);
                o1 = __builtin_amdgcn_mfma_f32_32x32x16_bf16(pa, (bf16x8){c0[0], c0[1], c0[2], c0[3], c1[0], c1[1], c1[2], c1[3]}, o1, 0, 0, 0);
            }
        }
        __syncthreads();
        if (dir == 0) { of0 = o0; of1 = o1; }
        else {
            int lane2 = lane; asm volatile("" : "+v"(lane2)); const int r2 = lane2 & 31, hi2 = lane2 >> 5;
            int ub = (32 * tb + 4 * hi2) * OX_PITCH + 64 * vh + r2; asm volatile("" : "+v"(ub));
#pragma unroll
            for (int g = 0; g < 16; ++g) { const int cg = ((g & 3) + 8 * (g >> 2)) * OX_PITCH; ox[ub + cg] = o0[g]; ox[ub + cg + 32] = o1[g]; }
            int tid2 = tid; asm volatile("" : "+v"(tid2));
            v4u hgr[4];
            { const bf16* hgp = WSP(bf16, WS_Z + Z_HG) + ((size_t)128 * c + (tid2 >> 2)) * HGW + h * 128 + 32 * (tid2 & 3);
#pragma unroll
              for (int j = 0; j < 4; ++j) hgr[j] = *(const GAS v4u*)(hgp + 8 * j); }
            const float* ow = F.in[10] + h * 128 + 64 * vh + r2; const float w0 = ow[0], w1 = ow[32];
            __syncthreads();
            int tbase = 32 * tb + 4 * hi2; asm volatile("" : "+v"(tbase));
            { const int rb = (127 - tbase) * OX_PITCH + 64 * vh + r2;
              float sqv[16];
#pragma unroll
              for (int g = 0; g < 16; ++g) { const int cg = (g & 3) + 8 * (g >> 2);
                of0[g] += ox[rb - cg * OX_PITCH]; of1[g] += ox[rb - cg * OX_PITCH + 32];
                sqv[g] = of0[g] * of0[g] + of1[g] * of1[g]; }
#pragma unroll
              for (int g = 0; g < 16; ++g) { float sq = sqv[g]; sq = dpp_add<0xB1>(sq); sq = dpp_add<0x4E>(sq); sq = dpp_add<0x141>(sq); sq = dpp_add<0x140>(sq); sqv[g] = sq; }
              if ((r2 & 15) == 0) {
#pragma unroll
                for (int g = 0; g < 16; ++g) { const int cg = (g & 3) + 8 * (g >> 2); ssqx[(tbase + cg) * 4 + 2 * vh + (r2 >> 4)] = sqv[g]; } } }
            __syncthreads();
            { const int yb = tbase * OX_PITCH + 64 * vh + r2;
#pragma unroll
              for (int g = 0; g < 16; ++g) { const int cg = (g & 3) + 8 * (g >> 2);
                const f32x4 pp = *(const LAS f32x4*)(ssqx + (tbase + cg) * 4);
                const float rn = rsqrtf(((pp[0] + pp[1]) + (pp[2] + pp[3])) * (1.0f / 128.0f) + pg8::RMS_EPS);
                ox[yb + cg * OX_PITCH] = of0[g] * rn * w0; ox[yb + cg * OX_PITCH + 32] = of1[g] * rn * w1; } }
            __syncthreads();
            { const int t = tid2 >> 2, c0 = 32 * (tid2 & 3);
              bf16* ya = yabase + ((size_t)128 * c + t) * HGW + h * 128 + c0;
#pragma unroll
              for (int j = 0; j < 4; ++j) { const f32x4 y0 = *(const LAS f32x4*)(ox + t * OX_PITCH + c0 + 8 * j), y1 = *(const LAS f32x4*)(ox + t * OX_PITCH + c0 + 8 * j + 4); const v4u gq = hgr[j]; v4u o;
                  o.x = pk2(y0[0] * pg8::bf_lo(gq.x), y0[1] * pg8::bf_hi(gq.x)); o.y = pk2(y0[2] * pg8::bf_lo(gq.y), y0[3] * pg8::bf_hi(gq.y));
                  o.z = pk2(y1[0] * pg8::bf_lo(gq.z), y1[1] * pg8::bf_hi(gq.z)); o.w = pk2(y1[2] * pg8::bf_lo(gq.w), y1[3] * pg8::bf_hi(gq.w));
                  *(GAS v4u*)(ya + 8 * j) = o; } }
            __syncthreads();
        }
    }
}
#undef HG_ISSUE_LOADS

struct Args { const float* in[20]; float* out; unsigned char* ws; int ph_lo, ph_hi; };
__global__ void __launch_bounds__(NWAVES * 64, 2) mk_fwd(Args args) {
    extern __shared__ __attribute__((aligned(16))) unsigned char lds[];
    Frame F;
    F.lds = (LAS unsigned char*)lds;
    F.MISC = (volatile LAS unsigned*)(F.lds + MISC_OFF);
    F.wave = __builtin_amdgcn_readfirstlane((int)threadIdx.x >> 6);
    F.G = gridDim.x; { const int bx = blockIdx.x; F.vcu = (F.G % 8 == 0) ? (bx % 8) * (F.G / 8) + bx / 8 : bx; }
    F.ws = args.ws; F.out = args.out;
#pragma unroll
    for (int i = 0; i < 20; ++i) F.in[i] = args.in[i];
    F.ctl = (gu32*)(F.ws + WS_CTL);
    for (int u = (int)threadIdx.x; u < (LDS_BYTES - LDSCTL_OFF) / 4; u += NWAVES * 64) ((LAS unsigned*)(F.lds + LDSCTL_OFF))[u] = 0u;
    __syncthreads();
    XcdBarrier bar; bar.bar = (unsigned*)(F.ctl + CW_BAR); bar.x = 0; bar.st = nullptr;
    if (N_LAUNCHES == 1) bar = xcd_barrier_post((unsigned*)(F.ctl + CW_BAR), F.MISC + 8);
    const int lo = args.ph_lo, hi = args.ph_hi;
    bf16* Wb = WSP(bf16, WS_W); bf16* HB = WSP(bf16, WS_HB); bf16* ACT = WSP(bf16, WS_Z); bf16* MIXED = WSP(bf16, WS_Z + Z_HV);

#ifndef PHMASK
#define PHMASK 0x7ff
#endif
#define IN(k) (((PHMASK >> (k)) & 1) && lo <= (k) && (k) < hi)
#define SEAM(k) do { if ((k) + 1 < hi) xcd_barrier(bar); } while (0)
#define PH_GATEUP(W_off, SSQ_off) do { \
        pg8::Gemm g{HB, Wb + (W_off) / 2, M, NGU, DM}; pg8::RsOrder S; S.init(M, NGU, F.G, (int)blockIdx.x); S.ssqp = WSP(float, SSQ_off); S.tab = (LAS float*)(F.lds + RS_OFF); S.prefill(); \
        pg8::EpiSwiglu E{ACT, (const LAS float*)(F.lds + RS_OFF), DFF}; \
        pg8::gemm_phase<pg8::EpiSwiglu, pg8::RsOrder, true, true>(F.lds + RING_OFF, g, S, E); } while (0)
#define PH_RES(Aptr, W_off, Kdim, BASE32, BASE16, OUT32, HBOUT, SSQOUT, SCALE) do { \
        pg8::Gemm g{Aptr, Wb + (W_off) / 2, M, DM, Kdim}; pg8::StaticOrder S; S.init(M, DM, F.G, (int)blockIdx.x); \
        if (S.nwg <= F.G) { pg8::EpiResT E{BASE16, OUT32, HBOUT, SSQOUT, SCALE}; pg8::gemm_phase<pg8::EpiResT, pg8::StaticOrder, true, true>(F.lds + RING_OFF, g, S, E); }     \
        else { pg8::EpiRes E{BASE32, BASE16, OUT32, HBOUT, SSQOUT, SCALE}; pg8::gemm_phase<pg8::EpiRes, pg8::StaticOrder, true, true>(F.lds + RING_OFF, g, S, E); } } while (0)

#ifndef DUP_PHASE
#define DUP_PHASE -1
#endif
#define DUP(k) (DUP_PHASE == (k))
    if (IN(0)) { if (DUP(0)) { p0_prologue(F); xcd_barrier(bar); } p0_prologue(F); SEAM(0); }
    if (IN(1)) { if (DUP(1)) { meta_p1(F); PH_GATEUP(W_GU1, WS_SSQ0); xcd_barrier(bar); } meta_p1(F); convert_in_idle_slot(F, (M / 256) * (NGU / 256), CV_FFN1, CV_IN); PH_GATEUP(W_GU1, WS_SSQ0); SEAM(1); }
    if (IN(2)) { if (DUP(2)) { meta_p2(F); PH_RES(ACT, W_D1, DFF, (const float*)nullptr, HB, (float*)nullptr, HB, WSP(float, WS_SSQ1), 0.5f); xcd_barrier(bar); } meta_p2(F); PH_RES(ACT, W_D1, DFF, (const float*)nullptr, HB, (float*)nullptr, HB, WSP(float, WS_SSQ1), 0.5f); SEAM(2); }
#define PH_MIX() do { \
        meta_p3(F); \
        pg8::Gemm g{HB, Wb + W_IN / 2, M, NIN, DM}; pg8::RsOrder S; S.init(M, NIN, F.G, (int)blockIdx.x); S.ssqp = WSP(float, WS_SSQ1); S.tab = (LAS float*)(F.lds + RS_OFF); S.prefill(); \
        pg8::EpiMix E{(const LAS float*)(F.lds + RS_OFF), WSP(bf16, WS_Z + Z_HQ) + 128 * HGW, WSP(bf16, WS_Z + Z_HV) + 128 * HGW, WSP(bf16, WS_Z + Z_ZFF) + 128 * HGW, WSP(bf16, WS_Z + Z_ZFB) + 128 * HGW, WSP(bf16, WS_Z + Z_HG) + 128 * HGW, \
                      WSP(bf16, WS_Z + Z_QO), WSP(bf16, WS_Z + Z_KB), WSP(bf16, WS_Z + Z_VB), WSP(bf16, WS_Z + Z_GA), WSP(bf16, WS_Z + Z_GB), \
                      F.in[11], F.in[12], WSP(pg8::f32x2, WS_MISC + MISC_ROPER), WSP(pg8::f32x2, WS_MISC + MISC_ROPEC), attn_body::C2, WSP(float, WS_MISC + MISC_OMLF), WSP(float, WS_MISC + MISC_OMLB)}; \
        pg8::gemm_phase<pg8::EpiMix, pg8::RsOrder, true, true>(F.lds + RING_OFF, g, S, E); } while (0)
    if (IN(3)) { if (DUP(3)) { PH_MIX(); xcd_barrier(bar); } convert_in_idle_slot(F, (M / 256) * (NIN / 256), CV_IN, CV_ALL); PH_MIX(); SEAM(3); }
    if (IN(4)) { if (DUP(4)) { hg_state_phase(F); xcd_barrier(bar); } hg_state_phase(F); SEAM(4); }
    if (IN(5)) {
        if (DUP(5)) { const attn_body::AttnTensors ATd{WSP(bf16, WS_Z + Z_QO), WSP(bf16, WS_Z + Z_KB), WSP(bf16, WS_Z + Z_VB), Wb, F.in[11], F.in[12]}; attn_body::attn_phase<8>((char*)lds + RING_OFF, ATd, F.vcu, F.G); xcd_barrier(bar); }
        hg_scan_phase(F);
        const attn_body::AttnTensors AT{WSP(bf16, WS_Z + Z_QO), WSP(bf16, WS_Z + Z_KB), WSP(bf16, WS_Z + Z_VB), WSP(bf16, WS_Z + Z_QO), F.in[11], F.in[12]};
        attn_body::attn_phase<8>((char*)lds + RING_OFF, AT, F.vcu, F.G);
        SEAM(5);
    }
    if (IN(6)) { if (DUP(6)) { hg_out_phase(F, Wb); xcd_barrier(bar); } hg_out_phase(F, WSP(bf16, WS_Z + Z_HQ)); SEAM(6); }
    for (int rep7 = 0; rep7 < (DUP(7) ? 2 : 1); ++rep7)
    if (IN(7)) {
        if (rep7) xcd_barrier(bar);
        pg8::Gemm g{WSP(bf16, WS_Z + Z_HQ) + 128 * HGW, Wb + W_UP / 2, 2 * M, 2 * DM, HGW}; pg8::UpOrder S; S.init(F.G, (int)blockIdx.x);
        pg8::EpiUp E{WSP(bf16, WS_Z + Z_GA), WSP(bf16, WS_Z + Z_GB), MIXED};
        pg8::gemm_phase<pg8::EpiUp, pg8::UpOrder, true, true>(F.lds + RING_OFF, g, S, E);
        SEAM(7);
    }
    if (IN(8)) { PH_RES(MIXED, W_OUT, DM, (const float*)nullptr, HB, (float*)nullptr, HB, WSP(float, WS_SSQ2), 1.0f); SEAM(8); }
    if (IN(9)) { if (DUP(9)) { PH_GATEUP(W_GU2, WS_SSQ2); xcd_barrier(bar); } stagger_short_share(F, (M / 256) * (NGU / 256), 3); PH_GATEUP(W_GU2, WS_SSQ2); SEAM(9); }
    if (IN(10)) { PH_RES(ACT, W_D2, DFF, (const float*)nullptr, HB, F.out, (bf16*)nullptr, (float*)nullptr, 0.5f);
    }
#undef IN
#undef SEAM
}

extern "C" void kernel_launch(void* const* d_in, const int* in_sizes, int n_in, void* d_out, int out_size, void* d_ws, size_t ws_size, hipStream_t stream) {
    static int grid = 0;
    if (grid == 0) {
        if (n_in != 20 || in_sizes[0] != M * DM || out_size != M * DM || ws_size < WS_END) { fprintf(stderr, "kernel_launch: built for 20 inputs, x/out of %d floats, >= %zu bytes of workspace; got n_in %d, in0 %d, out %d, ws %zu; nothing launched\n", M * DM, (size_t)WS_END, n_in, n_in > 0 ? in_sizes[0] : -1, out_size, ws_size); grid = -1; return; }
        int dev = 0, cus = 0, per_cu = 0;
        if (hipGetDevice(&dev) != hipSuccess || hipDeviceGetAttribute(&cus, hipDeviceAttributeMultiprocessorCount, dev) != hipSuccess) { fprintf(stderr, "kernel_launch: device query failed\n"); grid = -1; return; }
        if (hipFuncSetAttribute((const void*)mk_fwd, hipFuncAttributeMaxDynamicSharedMemorySize, LDS_BYTES) != hipSuccess) { fprintf(stderr, "kernel_launch: hipFuncSetAttribute failed\n"); grid = -1; return; }
        if (hipOccupancyMaxActiveBlocksPerMultiprocessor(&per_cu, (const void*)mk_fwd, NWAVES * 64, LDS_BYTES) != hipSuccess || per_cu < 1) { fprintf(stderr, "kernel_launch: occupancy query reports %d workgroups per CU\n", per_cu); per_cu = 1; }
        (void)hipGetLastError();
        if (cus < DFF / 16) { fprintf(stderr, "kernel_launch: %d CUs; the meta-token side path deals one job per workgroup and needs >= %d workgroups; nothing launched\n", cus, DFF / 16); grid = -1; return; }
        grid = cus;
    }
    if (grid < 0) return;
    if (hipMemsetAsync((char*)d_ws + WS_CTL, 0, CTL_ZERO_BYTES, stream) != hipSuccess) { fprintf(stderr, "kernel_launch: memset failed\n"); return; }
    Args a{};
    for (int i = 0; i < 20; ++i) a.in[i] = (const float*)d_in[i];
    a.out = (float*)d_out; a.ws = (unsigned char*)d_ws;
    for (int li = 0; li < N_LAUNCHES; ++li) {
        a.ph_lo = (N_LAUNCHES == 1) ? 0 : li; a.ph_hi = (N_LAUNCHES == 1) ? N_PHASES : li + 1;
        hipLaunchKernelGGL(mk_fwd, dim3(grid), dim3(NWAVES * 64), LDS_BYTES, stream, a);
        const hipError_t le = hipPeekAtLastError();
        if (le != hipSuccess) { fprintf(stderr, "kernel_launch: launch %d failed: %s\n", li, hipGetErrorName(le)); break; }
    }
}
```

```cpp
#include <hip/hip_runtime.h>
#include <cstdio>
#include <cstdint>
#include <cmath>
#ifndef USIL_MIX
#define USIL_MIX 2
#endif
namespace pg8 {
#define PG8_LAS __attribute__((address_space(3)))
typedef unsigned short bf16_t;
typedef short bf16x8 __attribute__((ext_vector_type(8)));
typedef float f32x4 __attribute__((ext_vector_type(4)));
typedef unsigned u32x4 __attribute__((ext_vector_type(4)));
constexpr int BM = 256, BK = 64, HALF = 128, HTB = HALF * BK * 2  , STAGE_BYTES = 8 * HTB, NXCD = 8, WGM = 8;

__host__ __device__ __forceinline__ int lds_byte(int r, int c) { const int st = (r >> 4) * 2 + (c >> 5), rr = r & 15, cc = c & 31, ob = rr * 64 + cc * 2; return st * 1024 + (ob ^ (((ob >> 9) & 1) << 5)); }
__host__ __device__ __forceinline__ void stage_rc(int b, int& R, int& C) { const int st = b / 1024, sb = b % 1024, swz = sb ^ (((sb >> 9) & 1) << 5); R = (st >> 1) * 16 + swz / 64; C = (st & 1) * 32 + (swz % 64) / 2; }
__host__ __device__ __forceinline__ int perm32(int rho) { const int n = rho >> 4, i = rho & 15; return 8 * (i >> 2) + 4 * n + (i & 3); }

struct Unit { int pm, pn, idx; };
struct Gemm { const bf16_t* A; const bf16_t* Bt; int M, N, K; };

struct StaticOrder {
    int nM, nN, nwg, G, c, pmode;
    __host__ __device__ void init(int M, int N, int G_, int c_) { nM = M / BM; nN = N / BM; nwg = nM * nN; G = G_; c = c_; pmode = 0; }
    __host__ __device__ bool next(int i, Unit& u) const {
        const long L = (long)i * G + c; if (L >= nwg) return false;
        int wgid = (int)L; { const int q = nwg / NXCD, r = nwg % NXCD, xcd = wgid % NXCD, off = wgid / NXCD; wgid = (xcd < r ? xcd * (q + 1) : r * (q + 1) + (xcd - r) * q) + off; }
        const int nig = WGM * nN, gid = wgid / nig, fm = gid * WGM, gsz = (nM % WGM == 0) ? WGM : ((nM - fm) < WGM ? (nM - fm) : WGM);
        u.pm = fm + ((wgid % nig) % gsz); u.pn = (wgid % nig) / gsz; u.idx = i;
        if (pmode) { const int j = u.pm & 7, gq = u.pm >> 3; u.pm = 4 * gq + (j & 3) + ((j & 4) ? 32 : 0); }
        return true;
    }
    __device__ __forceinline__ void a_ready(const Unit&) const {}
    __device__ __forceinline__ void done(const Unit&) const {}
};


constexpr int RS_UNITS = 8;
struct RsOrder : StaticOrder {
    const float* ssqp; PG8_LAS float* tab;
    __device__ __forceinline__ void prefill() const {
        const int tid = threadIdx.x, row = tid >> 1, hf = tid & 1;
        f32x4 a[RS_UNITS], b[RS_UNITS]; bool ok[RS_UNITS]; Unit u0; next(0, u0);
#pragma unroll
        for (int i = 0; i < RS_UNITS; ++i) { Unit u; ok[i] = next(i, u); if (!ok[i]) u = u0;
            const f32x4* p = (const f32x4*)(ssqp + (size_t)(u.pm * BM + row) * 16 + hf * 8); a[i] = p[0]; b[i] = p[1]; }
#pragma unroll
        for (int i = 0; i < RS_UNITS; ++i) {
            float s = ((a[i][0] + a[i][1]) + (a[i][2] + a[i][3])) + ((b[i][0] + b[i][1]) + (b[i][2] + b[i][3]));
            s += __shfl_xor(s, 1);
            if (hf == 0 && ok[i]) tab[i * BM + row] = rsqrtf(s * (1.0f / 1024.0f) + 1e-6f);
        }
        __syncthreads();
    }
    __device__ __forceinline__ void a_ready(const Unit&) const {}
};

typedef float f32x2_cv __attribute__((ext_vector_type(2))); typedef __bf16 bf16x2_cv __attribute__((ext_vector_type(2)));
__device__ __forceinline__ unsigned cvt_pk_bf16(float lo, float hi) { f32x2_cv v = {lo, hi}; bf16x2_cv b = __builtin_convertvector(v, bf16x2_cv); return __builtin_bit_cast(unsigned, b); }
typedef float f32x2 __attribute__((ext_vector_type(2)));
typedef unsigned u32x2 __attribute__((ext_vector_type(2)));
__device__ __forceinline__ float bf_lo(unsigned w) { return __uint_as_float(w << 16); }
__device__ __forceinline__ float bf_hi(unsigned w) { return __uint_as_float(w & 0xffff0000u); }
__device__ __forceinline__ float fast_sigmoid(float v) { return __builtin_amdgcn_rcpf(1.0f + __expf(-v)); }
__device__ __forceinline__ float fast_silu(float v) { return v * __builtin_amdgcn_rcpf(1.0f + __expf(-v)); }
constexpr float RMS_EPS = 1e-6f;
__device__ __forceinline__ float rstd_from(const float* ssqp, int row) {
    const f32x4* p = (const f32x4*)(ssqp + (size_t)row * 16);
    const f32x4 a = p[0], b = p[1], c = p[2], d = p[3];
    const float s = (((a[0] + a[1]) + (a[2] + a[3])) + ((b[0] + b[1]) + (b[2] + b[3]))) + (((c[0] + c[1]) + (c[2] + c[3])) + ((d[0] + d[1]) + (d[2] + d[3])));
    return rsqrtf(s * (1.0f / 1024.0f) + RMS_EPS);
}

struct EpiSwiglu {
    static constexpr bool PERM = true, AFTER_DRAIN = false, KEEP_ACC = false; static constexpr int USIL = 3;
    bf16_t* O; const PG8_LAS float* tab; int ldo;
    __device__ __forceinline__ void operator()(const f32x4 (&acc)[2][2][4][2], const Unit& u, int wr, int wc, int fr, int fq) const {
        const int row0 = u.pm * BM + wr * 64 + fr, col0 = u.pn * HALF + wc * 32 + 8 * fq;
#pragma unroll
        for (int ai = 0; ai < 2; ++ai)
#pragma unroll
            for (int m = 0; m < 4; ++m) {
                const int row = row0 + ai * HALF + m * 16; const float rs = tab[u.idx * BM + ai * HALF + wr * 64 + m * 16 + fr];
                float o[8];
#pragma unroll
                for (int n = 0; n < 2; ++n)
#pragma unroll
                    for (int i = 0; i < 4; ++i) { const float g = acc[ai][0][m][n][i] * rs, up = acc[ai][1][m][n][i] * rs; o[4 * n + i] = fast_silu(g) * up; }
                u32x4 w; w.x = cvt_pk_bf16(o[0], o[1]); w.y = cvt_pk_bf16(o[2], o[3]); w.z = cvt_pk_bf16(o[4], o[5]); w.w = cvt_pk_bf16(o[6], o[7]);
                *(u32x4*)(O + (size_t)row * ldo + col0) = w;
            }
    }
};

struct EpiRes {
    static constexpr bool PERM = false, AFTER_DRAIN = false, KEEP_ACC = false; static constexpr int USIL = 3;
    const float* base32; const bf16_t* base16; float* out32; bf16_t* hb; float* ssqp; float scale;
    __device__ __forceinline__ void operator()(const f32x4 (&acc)[2][2][4][2], const Unit& u, int wr, int wc, int fr, int fq) const {
        const int row0 = u.pm * BM + wr * 64 + fr, col0 = u.pn * BM + wc * 32 + 4 * fq;
#pragma unroll
        for (int ai = 0; ai < 2; ++ai)
#pragma unroll
            for (int m = 0; m < 4; ++m) {
                const int row = row0 + ai * HALF + m * 16; const size_t off = (size_t)row * 1024 + col0; float ss = 0.f;
                f32x4 b[2][2];
#pragma unroll
                for (int bj = 0; bj < 2; ++bj)
#pragma unroll
                    for (int n = 0; n < 2; ++n) {
                        if (base32) b[bj][n] = *(const f32x4*)(base32 + off + bj * HALF + n * 16);
                        else { const u32x2 w = *(const u32x2*)(base16 + off + bj * HALF + n * 16); b[bj][n] = (f32x4){bf_lo(w.x), bf_hi(w.x), bf_lo(w.y), bf_hi(w.y)}; }
                    }
#pragma unroll
                for (int bj = 0; bj < 2; ++bj)
#pragma unroll
                    for (int n = 0; n < 2; ++n) {
                        const f32x4 v = b[bj][n] + acc[ai][bj][m][n] * scale;
                        if (out32) *(f32x4*)(out32 + off + bj * HALF + n * 16) = v;
                        if (hb) { u32x2 w; w.x = cvt_pk_bf16(v[0], v[1]); w.y = cvt_pk_bf16(v[2], v[3]); *(u32x2*)(hb + off + bj * HALF + n * 16) = w; }
                        ss += (v[0] * v[0] + v[1] * v[1]) + (v[2] * v[2] + v[3] * v[3]);
                    }
                if (ssqp) { ss += __shfl_xor(ss, 16); ss += __shfl_xor(ss, 32); if (fq == 0) ssqp[(size_t)row * 16 + u.pn * 4 + wc] = ss; }
            }
    }
};

template <int CTRL> __device__ __forceinline__ float dpp_addf(float v) { return v + __builtin_bit_cast(float, __builtin_amdgcn_update_dpp(0, __builtin_bit_cast(int, v), CTRL, 0xf, 0xf, false)); }
struct EpiResT {
    static constexpr bool PERM = false, AFTER_DRAIN = true, KEEP_ACC = false; static constexpr int USIL = 3;
    static constexpr int TP = 260;
    const bf16_t* base16; float* out32; bf16_t* hb; float* ssqp; float scale;
    __device__ __forceinline__ void operator()(const f32x4 (&)[2][2][4][2], const Unit&, int, int, int, int) const {}
    __device__ __forceinline__ void fused(const f32x4 (&acc)[2][2][4][2], const Unit& u, int wr, int wc, int fr, int fq, PG8_LAS unsigned char* lds, int wid, int lane) const {
        PG8_LAS float* T = (PG8_LAS float*)lds;
        const int tid = wid * 64 + lane, rr = tid >> 5, cc = (tid & 31) * 8;
        u32x4 bqa[2][8];
#pragma unroll
        for (int i = 0; i < 8; ++i) bqa[0][i] = *(const u32x4*)(base16 + (size_t)(u.pm * BM + rr) * 1024 + u.pn * BM + cc + (size_t)(16 * i) * 1024);
#pragma unroll
        for (int ai = 0; ai < 2; ++ai) {
            const size_t g0 = (size_t)(u.pm * BM + ai * HALF + rr) * 1024 + u.pn * BM + cc;
#pragma unroll
            for (int bj = 0; bj < 2; ++bj)
#pragma unroll
                for (int m = 0; m < 4; ++m)
#pragma unroll
                    for (int n = 0; n < 2; ++n) *(PG8_LAS f32x4*)(T + (wr * 64 + 16 * m + fr) * TP + bj * HALF + wc * 32 + 16 * n + 4 * fq) = acc[ai][bj][m][n];
            __syncthreads();
            if (ai == 0) {
#pragma unroll
                for (int i = 0; i < 8; ++i) bqa[1][i] = *(const u32x4*)(base16 + (size_t)(u.pm * BM + HALF + rr) * 1024 + u.pn * BM + cc + (size_t)(16 * i) * 1024);
            }
#pragma unroll
            for (int i = 0; i < 8; ++i) {
                const f32x4 a0 = *(const PG8_LAS f32x4*)(T + (rr + 16 * i) * TP + cc), a1 = *(const PG8_LAS f32x4*)(T + (rr + 16 * i) * TP + cc + 4);
                const u32x4 w = bqa[ai][i]; const size_t g = g0 + (size_t)(16 * i) * 1024;
                const f32x4 v0 = (f32x4){bf_lo(w.x), bf_hi(w.x), bf_lo(w.y), bf_hi(w.y)} + a0 * scale, v1 = (f32x4){bf_lo(w.z), bf_hi(w.z), bf_lo(w.w), bf_hi(w.w)} + a1 * scale;
                if (out32) { *(f32x4*)(out32 + g) = v0; *(f32x4*)(out32 + g + 4) = v1; }
                if (hb) { u32x4 o; o.x = cvt_pk_bf16(v0[0], v0[1]); o.y = cvt_pk_bf16(v0[2], v0[3]); o.z = cvt_pk_bf16(v1[0], v1[1]); o.w = cvt_pk_bf16(v1[2], v1[3]); *(u32x4*)(hb + g) = o; }
                if (ssqp) {
                    float ss = ((v0[0] * v0[0] + v0[1] * v0[1]) + (v0[2] * v0[2] + v0[3] * v0[3])) + ((v1[0] * v1[0] + v1[1] * v1[1]) + (v1[2] * v1[2] + v1[3] * v1[3]));
                    ss = dpp_addf<0xB1>(ss); ss = dpp_addf<0x4E>(ss); ss = dpp_addf<0x141>(ss);
                    if ((tid & 7) == 0) ssqp[(size_t)(u.pm * BM + ai * HALF + rr + 16 * i) * 16 + u.pn * 4 + ((tid & 31) >> 3)] = ss;
                }
            }
            __syncthreads();
        }
    }
};

struct EpiMix {
    static constexpr bool PERM = true, AFTER_DRAIN = false, KEEP_ACC = false; static constexpr int USIL = USIL_MIX;
    const PG8_LAS float* tab;
    bf16_t *HQ, *HV, *ZFF, *ZFB, *HG;
    bf16_t *QO; bf16_t *KB, *VB;
    bf16_t *GA, *GB;
    const float *qnw, *knw; const f32x2* ropeR; const f32x2* ropeC; float c2; const float *omlf, *omlb;
    template <int ACT>
    __device__ __forceinline__ void ew_store(const f32x4 (&acc)[2][2][4][2], const Unit& u, bf16_t* dst, int pitch, int row0, int col0, int wr, int fr, const float* oml = nullptr) const {
        float om[2][8];
        if (ACT == 3) {
#pragma unroll
            for (int bj = 0; bj < 2; ++bj) { const f32x4 a = *(const f32x4*)(oml + col0 + bj * HALF), b = *(const f32x4*)(oml + col0 + bj * HALF + 4); om[bj][0] = a[0]; om[bj][1] = a[1]; om[bj][2] = a[2]; om[bj][3] = a[3]; om[bj][4] = b[0]; om[bj][5] = b[1]; om[bj][6] = b[2]; om[bj][7] = b[3]; }
        }
#pragma unroll
        for (int ai = 0; ai < 2; ++ai)
#pragma unroll
            for (int m = 0; m < 4; ++m) {
                const int row = row0 + ai * HALF + m * 16; const float rs = tab[u.idx * BM + ai * HALF + wr * 64 + m * 16 + fr];
#pragma unroll
                for (int bj = 0; bj < 2; ++bj) {
                    float o[8];
#pragma unroll
                    for (int n = 0; n < 2; ++n)
#pragma unroll
                        for (int i = 0; i < 4; ++i) { const float v = acc[ai][bj][m][n][i] * rs;
                            if (ACT == 3) o[4 * n + i] = __builtin_amdgcn_logf(1.0f - om[bj][4 * n + i] * __builtin_amdgcn_rcpf(1.0f + __builtin_amdgcn_exp2f(v * 1.4426950408889634f)));
                            else o[4 * n + i] = (ACT == 0) ? v : ((ACT == 1) ? fast_silu(v) : fast_sigmoid(v)); }
                    u32x4 w; w.x = cvt_pk_bf16(o[0], o[1]); w.y = cvt_pk_bf16(o[2], o[3]); w.z = cvt_pk_bf16(o[4], o[5]); w.w = cvt_pk_bf16(o[6], o[7]);
                    *(u32x4*)(dst + (size_t)row * pitch + col0 + bj * HALF) = w;
                }
            }
    }
    __device__ __forceinline__ void operator()(const f32x4 (&acc)[2][2][4][2], const Unit& u, int wr, int wc, int fr, int fq) const {
        const int row0 = u.pm * BM + wr * 64 + fr; const int pn = u.pn;
        if (pn >= 13) {
            const int col0 = (pn - 13) * HALF + wc * 32 + 8 * fq;
#pragma unroll
            for (int ai = 0; ai < 2; ++ai)
#pragma unroll
                for (int m = 0; m < 4; ++m) {
                    const int row = row0 + ai * HALF + m * 16; const float rs = tab[u.idx * BM + ai * HALF + wr * 64 + m * 16 + fr];
                    float sb[8], ra[8]; const float c1 = rs * -1.4426950408889634f;
#pragma unroll
                    for (int n = 0; n < 2; ++n)
#pragma unroll
                        for (int i = 0; i < 4; ++i) { const float db = fminf(1.0f + __builtin_amdgcn_exp2f(acc[ai][1][m][n][i] * c1), 1e30f), da = 1.0f + __builtin_amdgcn_exp2f(acc[ai][0][m][n][i] * c1);
                            sb[4 * n + i] = __builtin_amdgcn_rcpf(db); ra[4 * n + i] = db * __builtin_amdgcn_rcpf(da); }
                    u32x4 wb; wb.x = cvt_pk_bf16(sb[0], sb[1]); wb.y = cvt_pk_bf16(sb[2], sb[3]); wb.z = cvt_pk_bf16(sb[4], sb[5]); wb.w = cvt_pk_bf16(sb[6], sb[7]);
                    u32x4 wa; wa.x = cvt_pk_bf16(ra[0], ra[1]); wa.y = cvt_pk_bf16(ra[2], ra[3]); wa.z = cvt_pk_bf16(ra[4], ra[5]); wa.w = cvt_pk_bf16(ra[6], ra[7]);
                    *(u32x4*)(GA + (size_t)row * 1024 + col0) = wa; *(u32x4*)(GB + (size_t)row * 1024 + col0) = wb;
                }
        } else if (pn < 10) {
            bf16_t* dst; int pitch, ct, act; const float* oml = nullptr;
            if (pn < 2) { dst = HQ; pitch = 512; ct = pn; act = 1; }
            else if (pn < 4) { dst = HV; pitch = 512; ct = pn - 2; act = 0; }
            else if (pn < 6) { dst = ZFF; pitch = 512; ct = pn - 4; act = 3; oml = omlf; }
            else if (pn < 8) { dst = ZFB; pitch = 512; ct = pn - 6; act = 3; oml = omlb; }
            else { dst = HG; pitch = 512; ct = pn - 8; act = 1; }
            const int col0 = ct * BM + wc * 32 + 8 * fq;
            if (act == 0) ew_store<0>(acc, u, dst, pitch, row0, col0, wr, fr); else if (act == 1) ew_store<1>(acc, u, dst, pitch, row0, col0, wr, fr); else if (act == 2) ew_store<2>(acc, u, dst, pitch, row0, col0, wr, fr); else ew_store<3>(acc, u, dst, pitch, row0, col0, wr, fr, oml);
        } else {
            const bool isv = (pn == 12) && (wc >= 2);
            const bool isq = (pn < 12);
            bf16_t* dst; int pitch, hcol;
            if (isq) { dst = QO; pitch = 512; hcol = (4 * (pn - 10) + wc) * 64; }
            else if (!isv) { dst = KB; pitch = 128; hcol = wc * 64; }
            else { dst = VB; pitch = 128; hcol = (wc - 2) * 64; }
            const float* nw = isq ? qnw : knw; const float osc = isq ? c2 : 1.0f;
            float wgt[2][8];
#pragma unroll
            for (int bj = 0; bj < 2; ++bj)
#pragma unroll
                for (int j = 0; j < 8; ++j) wgt[bj][j] = nw[32 * bj + 8 * fq + j] * osc;
#pragma unroll
            for (int ai = 0; ai < 2; ++ai)
#pragma unroll
                for (int m = 0; m < 4; ++m) {
                    const int row = row0 + ai * HALF + m * 16; const float rs = tab[u.idx * BM + ai * HALF + wr * 64 + m * 16 + fr];
                    float x[2][8]; float ss = 0.f;
#pragma unroll
                    for (int bj = 0; bj < 2; ++bj)
#pragma unroll
                        for (int n = 0; n < 2; ++n)
#pragma unroll
                            for (int i = 0; i < 4; ++i) { const float v = acc[ai][bj][m][n][i] * rs; x[bj][4 * n + i] = v; ss += v * v; }
                    if (!isv) {
                        ss += __shfl_xor(ss, 16); ss += __shfl_xor(ss, 32);
                        const float rn = rsqrtf(ss * (1.0f / 64.0f) + RMS_EPS);
                        const int rpos = row >> 6, cpos = row & 63;
#pragma unroll
                        for (int bj = 0; bj < 2; ++bj) {
                            const f32x2* tab = (bj == 0 ? ropeR + rpos * 16 : ropeC + cpos * 16) + 4 * fq;
#pragma unroll
                            for (int pr = 0; pr < 4; ++pr) {
                                const f32x2 cs = tab[pr];
                                const float a = x[bj][2 * pr] * rn * wgt[bj][2 * pr], b = x[bj][2 * pr + 1] * rn * wgt[bj][2 * pr + 1];
                                x[bj][2 * pr] = a * cs.x - b * cs.y; x[bj][2 * pr + 1] = a * cs.y + b * cs.x;
                            }
                        }
                    }
#pragma unroll
                    for (int bj = 0; bj < 2; ++bj) {
                        u32x4 w; w.x = cvt_pk_bf16(x[bj][0], x[bj][1]); w.y = cvt_pk_bf16(x[bj][2], x[bj][3]); w.z = cvt_pk_bf16(x[bj][4], x[bj][5]); w.w = cvt_pk_bf16(x[bj][6], x[bj][7]);
                        *(u32x4*)(dst + (size_t)row * pitch + hcol + 32 * bj + 8 * fq) = w;
                    }
                }
        }
    }
};

struct EpiUp {
    static constexpr bool PERM = true, AFTER_DRAIN = false, KEEP_ACC = true; static constexpr int USIL = 3;
    const bf16_t *R, *GB; bf16_t* MX;
    __device__ __forceinline__ bool keep(const Unit& u) const { return u.pn < 4; }
    __device__ __forceinline__ void operator()(f32x4 (&acc)[2][2][4][2], const Unit& u, int wr, int wc, int fr, int fq) const {
        const int z = (u.pn >= 4) ? 1 : 0; const int pm = u.pm - 64 * z, pn = u.pn - 4 * z;
        const bf16_t* G = z ? GB : R;
        const int row0 = pm * BM + wr * 64 + fr, col0 = pn * BM + wc * 32 + 8 * fq;
        u32x4 gq[16];
#define UP_OFF(it) ((size_t)(row0 + ((it) >> 3) * HALF + (((it) >> 1) & 3) * 16) * 1024 + col0 + ((it) & 1) * HALF)
#pragma unroll
        for (int it = 0; it < 4; ++it) gq[it] = *(const u32x4*)(G + UP_OFF(it));
#pragma unroll
        for (int it = 0; it < 16; ++it) {
            const int ai = it >> 3, m = (it >> 1) & 3, bj = it & 1;
            const u32x4 g = gq[it];
            if (it + 4 < 16) gq[it + 4] = *(const u32x4*)(G + UP_OFF(it + 4));
            const f32x4 g0 = {bf_lo(g.x), bf_hi(g.x), bf_lo(g.y), bf_hi(g.y)}, g1 = {bf_lo(g.z), bf_hi(g.z), bf_lo(g.w), bf_hi(g.w)};
            const f32x4 o0 = acc[ai][bj][m][0] * g0, o1 = acc[ai][bj][m][1] * g1;
            if (!z) { acc[ai][bj][m][0] = o0; acc[ai][bj][m][1] = o1; }
            else { u32x4 w; w.x = cvt_pk_bf16(o0[0], o0[1]); w.y = cvt_pk_bf16(o0[2], o0[3]); w.z = cvt_pk_bf16(o1[0], o1[1]); w.w = cvt_pk_bf16(o1[2], o1[3]);
                *(u32x4*)(MX + UP_OFF(it)) = w; }
        }
#undef UP_OFF
    }
};
struct UpOrder {
    StaticOrder so;
    __device__ void init(int G_, int c_) { so.init(16384, 1024, G_, c_); }
    __device__ bool next(int i, Unit& u) const {
        const int rounds = (so.nwg + so.G - 1) / so.G; if (i >= 2 * rounds) return false;
        Unit t; if (!so.next(i >> 1, t)) return false;
        const int z = i & 1; u.pm = t.pm + 64 * z; u.pn = t.pn + 4 * z; u.idx = i; return true;
    }
    __device__ __forceinline__ void a_ready(const Unit&) const {}
    __device__ __forceinline__ void done(const Unit&) const {}
};
template <class Epi, class Sched, bool ALIGN_EPI = false, bool SP2 = false>
__device__ __forceinline__ void gemm_phase(PG8_LAS unsigned char* lds, const Gemm g, const Sched& S, const Epi& E) {
    int tid_ = threadIdx.x; asm volatile("" : "+v"(tid_));
    const int tid = tid_, wid = __builtin_amdgcn_readfirstlane(tid >> 6), lane = tid & 63, wr = wid >> 2, wc = wid & 3, fr = lane & 15, fq = lane >> 4;
    const int K = g.K, nt = K / BK;
    unsigned voffA[2], voffB[2];
#pragma unroll
    for (int i = 0; i < 2; ++i) { int R, C; stage_rc(tid * 16 + i * 8192, R, C); const int Rb = Epi::PERM ? ((R & ~31) + perm32(R & 31)) : R;
        voffA[i] = (unsigned)(R * K + C) * 2u; voffB[i] = (unsigned)(Rb * K + C) * 2u; }
    const size_t kstep = (size_t)(BK * 2);
    const size_t hstep = (size_t)HALF * K * 2;
    const size_t tstep = 2 * hstep;
    const unsigned ldsw = (unsigned)wid * 1024u;
    const int aoff = lds_byte(wr * 64 + fr, fq * 8), boff = lds_byte(wc * 32 + fr, fq * 8);
#define PG8_SA(b, h) (((b) * 2 + (h)) * HTB)
#define PG8_SB(b, h) ((4 + (b) * 2 + (h)) * HTB)
#define PG8_STAGE(bufoff, gbase, voff) do { _Pragma("unroll") for (int _i = 0; _i < 2; ++_i) \
        __builtin_amdgcn_global_load_lds((const unsigned*)((const char*)(gbase) + (voff)[_i]), (PG8_LAS unsigned*)(lds + (bufoff) + ldsw + _i * 8192), 16, 0, 0); } while (0)
#define PG8_LDA(dst, b, h) do { _Pragma("unroll") for (int m = 0; m < 4; ++m) _Pragma("unroll") for (int k = 0; k < 2; ++k) dst[m][k] = *(const PG8_LAS bf16x8*)(lds + PG8_SA(b, h) + aoff + m * 2048 + k * 1024); } while (0)
#define PG8_LDB(dst, b, h) do { _Pragma("unroll") for (int n = 0; n < 2; ++n) _Pragma("unroll") for (int k = 0; k < 2; ++k) dst[n][k] = *(const PG8_LAS bf16x8*)(lds + PG8_SB(b, h) + boff + n * 2048 + k * 1024); } while (0)
#define PG8_MMA(ai, bj, At, Bt) do { __builtin_amdgcn_s_setprio(1); _Pragma("unroll") for (int m = 0; m < 4; ++m) _Pragma("unroll") for (int n = 0; n < 2; ++n) _Pragma("unroll") for (int k = 0; k < 2; ++k) \
        acc[ai][bj][m][n] = __builtin_amdgcn_mfma_f32_16x16x32_bf16(Bt[n][k], At[m][k], acc[ai][bj][m][n], 0, 0, 0); __builtin_amdgcn_s_setprio(0); } while (0)
#define PG8_WAIT_V(n) asm volatile("s_waitcnt vmcnt(" #n ")" ::: "memory")
#define PG8_WAIT_L(n) asm volatile("s_waitcnt lgkmcnt(" #n ")" ::: "memory")
#define PG8_BAR __builtin_amdgcn_s_barrier()
#define PG8_SCHED __builtin_amdgcn_sched_barrier(0)
    Unit cur, nxt; int ui = 0;
    if (!S.next(0, cur)) return;
    f32x4 acc[2][2][4][2];
    bool zero_acc = true;
#define PG8_ZERO_ACC() do { _Pragma("unroll") for (int a = 0; a < 2; ++a) _Pragma("unroll") for (int b = 0; b < 2; ++b) _Pragma("unroll") for (int m = 0; m < 4; ++m) _Pragma("unroll") for (int n = 0; n < 2; ++n) acc[a][b][m][n] = (f32x4){0.f, 0.f, 0.f, 0.f}; } while (0)
    constexpr bool UZ = SP2 && (Epi::USIL & 1) != 0, UN = SP2 && (Epi::USIL & 2) != 0;
    if constexpr (!UZ) { PG8_ZERO_ACC(); zero_acc = false; }
    bf16x8 At[4][2], B0[2][2], B1[2][2];
    const char* cA = (const char*)g.A + (size_t)cur.pm * tstep; const char* cB = (const char*)g.Bt + (size_t)cur.pn * tstep;
    S.a_ready(cur);
    if constexpr (SP2) {
        PG8_STAGE(PG8_SB(0, 0), cB, voffB); PG8_STAGE(PG8_SB(0, 1), cB + hstep, voffB); PG8_STAGE(PG8_SA(0, 0), cA, voffA); PG8_STAGE(PG8_SA(0, 1), cA + hstep, voffA);
        if (wr == 1) PG8_BAR;
        PG8_WAIT_V(2); PG8_BAR;
        PG8_STAGE(PG8_SB(1, 0), cB + kstep, voffB); PG8_STAGE(PG8_SB(1, 1), cB + hstep + kstep, voffB);
        PG8_WAIT_V(4); PG8_BAR;
    } else {
        PG8_STAGE(PG8_SB(0, 0), cB, voffB); PG8_STAGE(PG8_SA(0, 0), cA, voffA); PG8_STAGE(PG8_SB(0, 1), cB + hstep, voffB); PG8_STAGE(PG8_SA(0, 1), cA + hstep, voffA);
        if (wr == 1) PG8_BAR;
        PG8_WAIT_V(4); PG8_BAR;
        PG8_STAGE(PG8_SB(1, 0), cB + kstep, voffB); PG8_STAGE(PG8_SA(1, 0), cA + kstep, voffA); PG8_STAGE(PG8_SB(1, 1), cB + hstep + kstep, voffB);
        PG8_WAIT_V(6); PG8_BAR;
    }
    for (;;) {
        bool has_next = false; const char* nA = cA; const char* nB = cB;
        if (!UN || nt <= 2) { has_next = S.next(ui + 1, nxt); nA = has_next ? (const char*)g.A + (size_t)nxt.pm * tstep : cA; nB = has_next ? (const char*)g.Bt + (size_t)nxt.pn * tstep : cB; }
        if (!UZ || nt <= 2) { if (zero_acc) { PG8_ZERO_ACC(); zero_acc = false; } }
        for (int t = 0; t < nt; t += 2) {
            const bool last = (t == nt - 2);
            const char* a1 = cA + (size_t)(t + 1) * kstep;
            const char* a2 = last ? nA : cA + (size_t)(t + 2) * kstep; const char* b2 = last ? nB : cB + (size_t)(t + 2) * kstep;
            const char* a3 = a2 + kstep; const char* b3 = b2 + kstep;
            if (last && has_next) S.a_ready(nxt);
            const bool fin = SP2 && last && !has_next;
#define PG8_WVF(nn, nf) do { if (fin) { PG8_WAIT_V(nf); } else { PG8_WAIT_V(nn); } } while (0)
            if constexpr (SP2) {
            PG8_LDB(B0, 0, 0); PG8_LDB(B1, 0, 1); PG8_SCHED; PG8_LDA(At, 0, 0); PG8_STAGE(PG8_SA(1, 0), a1, voffA); PG8_STAGE(PG8_SA(1, 1), a1 + hstep, voffA);
            if ((UZ || UN) && t == 0 && nt > 2) { PG8_SCHED; if constexpr (UZ) { if (zero_acc) { PG8_ZERO_ACC(); zero_acc = false; } }
                if constexpr (UN) { has_next = S.next(ui + 1, nxt); nA = has_next ? (const char*)g.A + (size_t)nxt.pm * tstep : cA; nB = has_next ? (const char*)g.Bt + (size_t)nxt.pn * tstep : cB; } PG8_SCHED; }
            PG8_WAIT_V(8); PG8_WAIT_L(0); PG8_BAR; PG8_MMA(0, 0, At, B0); PG8_MMA(0, 1, At, B1); PG8_BAR; PG8_SCHED;
            PG8_LDA(At, 0, 1); if (!fin) { PG8_STAGE(PG8_SB(0, 0), b2, voffB); PG8_STAGE(PG8_SB(0, 1), b2 + hstep, voffB); }
            PG8_WVF(6, 2); PG8_WAIT_L(0); PG8_BAR; PG8_MMA(1, 0, At, B0); PG8_MMA(1, 1, At, B1); PG8_BAR; PG8_SCHED;
            PG8_LDB(B0, 1, 0); PG8_LDB(B1, 1, 1); PG8_SCHED; PG8_LDA(At, 1, 0); if (!fin) { PG8_STAGE(PG8_SA(0, 0), a2, voffA); PG8_STAGE(PG8_SA(0, 1), a2 + hstep, voffA); }
            PG8_WVF(8, 0); PG8_WAIT_L(0); PG8_BAR; PG8_MMA(0, 0, At, B0); PG8_MMA(0, 1, At, B1); PG8_BAR; PG8_SCHED;
            PG8_LDA(At, 1, 1); if (!fin) { PG8_STAGE(PG8_SB(1, 0), b3, voffB); PG8_STAGE(PG8_SB(1, 1), b3 + hstep, voffB); }
            PG8_WVF(6, 0); PG8_WAIT_L(0); PG8_BAR; PG8_MMA(1, 0, At, B0); PG8_MMA(1, 1, At, B1); PG8_BAR; PG8_SCHED;
            } else {
            PG8_LDB(B0, 0, 0); PG8_SCHED; PG8_LDA(At, 0, 0); PG8_STAGE(PG8_SA(1, 1), a1 + hstep, voffA);
            PG8_WAIT_L(8); PG8_BAR; PG8_WAIT_L(0); PG8_MMA(0, 0, At, B0); PG8_BAR; PG8_SCHED;
            PG8_LDB(B1, 0, 1); PG8_STAGE(PG8_SB(0, 0), b2, voffB);
            PG8_BAR; PG8_WAIT_L(0); PG8_MMA(0, 1, At, B1); PG8_BAR;
            PG8_LDA(At, 0, 1); PG8_STAGE(PG8_SA(0, 0), a2, voffA);
            PG8_BAR; PG8_WAIT_L(0); PG8_MMA(1, 0, At, B0); PG8_BAR; PG8_SCHED;
            PG8_STAGE(PG8_SB(0, 1), b2 + hstep, voffB);
            PG8_WAIT_V(6); PG8_BAR; PG8_MMA(1, 1, At, B1); PG8_BAR;
            PG8_LDB(B0, 1, 0); PG8_SCHED; PG8_LDA(At, 1, 0); PG8_STAGE(PG8_SA(0, 1), a2 + hstep, voffA);
            PG8_WAIT_L(8); PG8_BAR; PG8_WAIT_L(0); PG8_MMA(0, 0, At, B0); PG8_BAR; PG8_SCHED;
            PG8_LDB(B1, 1, 1); PG8_STAGE(PG8_SB(1, 0), b3, voffB);
            PG8_BAR; PG8_WAIT_L(0); PG8_MMA(0, 1, At, B1); PG8_BAR;
            PG8_LDA(At, 1, 1); PG8_STAGE(PG8_SA(1, 0), a3, voffA);
            PG8_BAR; PG8_WAIT_L(0); PG8_MMA(1, 0, At, B0); PG8_BAR; PG8_SCHED;
            PG8_STAGE(PG8_SB(1, 1), b3 + hstep, voffB);
            PG8_WAIT_V(6); PG8_BAR; PG8_MMA(1, 1, At, B1); PG8_BAR;
            }
        }
        if constexpr (ALIGN_EPI) { if (wr == 0) PG8_BAR; }
        if constexpr (!Epi::AFTER_DRAIN) { E(acc, cur, wr, wc, fr, fq); S.done(cur); }
        bool keep_acc = false; if constexpr (Epi::KEEP_ACC) keep_acc = E.keep(cur);
        if (!has_next) break;
        zero_acc = !keep_acc;
        cur = nxt; cA = nA; cB = nB; ++ui;
        if constexpr (ALIGN_EPI) { if (wr == 1) PG8_BAR; }
    }
    PG8_WAIT_V(0);
    if constexpr (!ALIGN_EPI) { if (wr == 0) PG8_BAR; }
    PG8_BAR;
    if constexpr (Epi::AFTER_DRAIN) { E.fused(acc, cur, wr, wc, fr, fq, lds, wid, lane); S.done(cur); }
#undef PG8_SA
#undef PG8_SB
#undef PG8_STAGE
#undef PG8_LDA
#undef PG8_LDB
#undef PG8_MMA
#undef PG8_WAIT_V
#undef PG8_WAIT_L
#undef PG8_BAR
#undef PG8_SCHED
#undef PG8_ZERO_ACC
#undef PG8_WVF
}
}
namespace attn_body {
using bf16=unsigned short;
__device__ __forceinline__ unsigned short f2bf16(float f){unsigned u=__builtin_bit_cast(unsigned,f);return (unsigned short)((u+0x7fffu+((u>>16)&1u))>>16);}
using bf16x8=__attribute__((ext_vector_type(8)))short;
using s16x4=__attribute__((ext_vector_type(4)))short;
using f32x16=__attribute__((ext_vector_type(16)))float;
using u32x4=__attribute__((ext_vector_type(4)))unsigned;
constexpr int D=64,QP=512,KP=128;
constexpr int NW=8,QBLK=32,QB=QBLK*NW,KVBLK=64;
constexpr int NT=258;
constexpr int ATTN_UNIT_ROWS=QB;
__device__ __forceinline__ int crow(int r,int hi){return (r&3)+8*(r>>2)+4*hi;}
#define SBAR() __builtin_amdgcn_sched_barrier(0)
__device__ __forceinline__ void cmask(f32x16&p0,f32x16&p1,int jb){
  const float NEG=-INFINITY;
  if(jb==2){
    #pragma unroll
    for(int r=8;r<16;++r)p0[r]=NEG;
    #pragma unroll
    for(int r=0;r<16;++r)p1[r]=NEG;
  } else if(jb==3){
    #pragma unroll
    for(int r=0;r<16;++r){p0[r]=NEG;p1[r]=NEG;}
  }
}

constexpr int NSLOT=3, SLOTB=8192;
constexpr int LDS_K=0, LDS_V=NSLOT*SLOTB, LDS_WS=2*NSLOT*SLOTB, LDS_OST=LDS_WS+NW*64*4, LDS_BYTES=LDS_OST+NW*4096;
constexpr float C2=0.125f*1.4426950408889634f;
__device__ __forceinline__ void glds16(const void*gsrc,unsigned lds_dst){unsigned keep;
  asm volatile("s_mov_b32 %0, m0\n\ts_mov_b32 m0, %2\n\ts_nop 0\n\tglobal_load_lds_dwordx4 %1, off\n\ts_mov_b32 m0, %0":"=&s"(keep):"v"(gsrc),"s"(lds_dst):"memory");}
__device__ __forceinline__ float max3f(float a,float b,float c){float r;asm("v_max3_f32 %0, %1, %2, %3":"=v"(r):"v"(a),"v"(b),"v"(c));return r;}
__device__ __forceinline__ float max2f(float a,float b){float r;asm("v_max_f32_e32 %0, %1, %2":"=v"(r):"v"(a),"v"(b));return r;}
__device__ __forceinline__ float fadd_s(float a,float b){float r;asm("v_add_f32_e32 %0, %1, %2":"=v"(r):"v"(a),"v"(b));return r;}
__device__ __forceinline__ float fsub_s(float a,float b){float r;asm("v_sub_f32_e32 %0, %1, %2":"=v"(r):"v"(a),"v"(b));return r;}
typedef float f32x2_t __attribute__((ext_vector_type(2))); typedef __bf16 bf16x2_t __attribute__((ext_vector_type(2)));
__device__ __forceinline__ unsigned cvtpk_s(float lo,float hi){f32x2_t v={lo,hi};bf16x2_t b=__builtin_convertvector(v,bf16x2_t);return __builtin_bit_cast(unsigned,b);}
#define WAIT_BAR(N) asm volatile("s_waitcnt vmcnt(" #N ") lgkmcnt(0)\n\ts_barrier":::"memory")

__device__ __forceinline__ void qkt(f32x16&p0,f32x16&p1,const char*Kslot,const bf16x8*qr,const f32x16&negm,int r32,int hi){
  const char*kb=Kslot+hi*1024+r32*16;
  #pragma unroll
  for(int d0=0;d0<4;++d0){
    const bf16x8 b0=*reinterpret_cast<const bf16x8*>(kb+d0*2048);
    const bf16x8 b1=*reinterpret_cast<const bf16x8*>(kb+d0*2048+512);
    if(d0==0){p0=__builtin_amdgcn_mfma_f32_32x32x16_bf16(b0,qr[0],negm,0,0,0);p1=__builtin_amdgcn_mfma_f32_32x32x16_bf16(b1,qr[0],negm,0,0,0);}
    else{p0=__builtin_amdgcn_mfma_f32_32x32x16_bf16(b0,qr[d0],p0,0,0,0);p1=__builtin_amdgcn_mfma_f32_32x32x16_bf16(b1,qr[d0],p1,0,0,0);}}
}
typedef __attribute__((address_space(3))) const char* lds_cptr;
typedef short v4i16_t __attribute__((ext_vector_type(4)));
__device__ __forceinline__ void kload8(bf16x8*kf,lds_cptr kp){
  kf[0]=*(const __attribute__((address_space(3))) bf16x8*)(kp);      kf[1]=*(const __attribute__((address_space(3))) bf16x8*)(kp+512);
  kf[2]=*(const __attribute__((address_space(3))) bf16x8*)(kp+2048); kf[3]=*(const __attribute__((address_space(3))) bf16x8*)(kp+2560);
  kf[4]=*(const __attribute__((address_space(3))) bf16x8*)(kp+4096); kf[5]=*(const __attribute__((address_space(3))) bf16x8*)(kp+4608);
  kf[6]=*(const __attribute__((address_space(3))) bf16x8*)(kp+6144); kf[7]=*(const __attribute__((address_space(3))) bf16x8*)(kp+6656);
}
__device__ __forceinline__ void kload2(bf16x8*kf,lds_cptr kp,int j){ kf[2*j]=*(const __attribute__((address_space(3))) bf16x8*)(kp+j*2048); kf[2*j+1]=*(const __attribute__((address_space(3))) bf16x8*)(kp+j*2048+512); }
__device__ __forceinline__ s16x4 vtr(lds_cptr p){ return __builtin_bit_cast(s16x4,__builtin_amdgcn_ds_read_tr16_b64_v4i16((__attribute__((address_space(3))) v4i16_t*)p)); }
__device__ __forceinline__ float rowmax(const f32x16&p0,const f32x16&p1){
  float a=max3f(p0[0],p0[1],p1[0]),b=max3f(p0[2],p0[3],p1[1]);a=max3f(a,p1[2],p1[3]);
  #pragma unroll
  for(int r=4;r<16;r+=4){a=max3f(a,p0[r],p0[r+1]);b=max3f(b,p0[r+2],p0[r+3]);a=max3f(a,p1[r],p1[r+1]);b=max3f(b,p1[r+2],p1[r+3]);}
  const float m=max2f(a,b);
  auto rr=__builtin_amdgcn_permlane32_swap(__float_as_uint(m),__float_as_uint(m),false,false);
  return max2f(__uint_as_float(rr[0]),__uint_as_float(rr[1]));
}
__device__ __forceinline__ void pv(f32x16*o,int vb,bf16x8 pa0,bf16x8 pa1,bf16x8 pa2,bf16x8 pa3){
  #pragma unroll
  for(int d0=0;d0<2;++d0){s16x4 lo[4],hi[4];
    #pragma unroll
    for(int ks=0;ks<4;++ks){
      asm volatile("ds_read_b64_tr_b16 %0,%1 offset:%c2":"=&v"(lo[ks]):"v"(vb),"i"(d0*4096+ks*1024):"memory");
      asm volatile("ds_read_b64_tr_b16 %0,%1 offset:%c2":"=&v"(hi[ks]):"v"(vb),"i"(d0*4096+ks*1024+512):"memory");}
    asm volatile("s_waitcnt lgkmcnt(0)":::"memory");SBAR();
    #define PK(k) (bf16x8){lo[k][0],lo[k][1],lo[k][2],lo[k][3],hi[k][0],hi[k][1],hi[k][2],hi[k][3]}
    o[d0]=__builtin_amdgcn_mfma_f32_32x32x16_bf16(pa0,PK(0),o[d0],0,0,0);
    o[d0]=__builtin_amdgcn_mfma_f32_32x32x16_bf16(pa1,PK(1),o[d0],0,0,0);
    o[d0]=__builtin_amdgcn_mfma_f32_32x32x16_bf16(pa2,PK(2),o[d0],0,0,0);
    o[d0]=__builtin_amdgcn_mfma_f32_32x32x16_bf16(pa3,PK(3),o[d0],0,0,0);
    #undef PK
  }
}

#ifndef ATTN_STORE16
#define ATTN_STORE16(p,v) (*(u32x4*)(p)=(v))
#endif
template<int THRL> __device__ __forceinline__ void attn_unit(int h,int qb,const bf16*Q,const bf16*__restrict__ K,const bf16*__restrict__ V,bf16*O,char*shm){
  int tid_=threadIdx.x; asm volatile("":"+v"(tid_));
  const int tid=tid_,lane=tid&63,r32=lane&31,hi=lane>>5; const int wid=__builtin_amdgcn_readfirstlane(tid>>6);
  const int q0=qb*QB; const int kvh=h>>2;
  const bf16*Qw=Q+(long)(q0+wid*QBLK)*QP+h*D;
  const bf16*Kh=K+kvh*D,*Vh=V+kvh*D;
  const unsigned lds0=(unsigned)(uintptr_t)shm;
  float*wsf=(float*)(shm+LDS_WS)+wid*64;
  const bf16*ksrc=Kh+(long)lane*KP+wid*8;
  const bf16*vsrc=Vh+(long)(16*(wid&3)+(lane>>2))*KP+(wid>>2)*32+(lane&3)*8;
  const unsigned kdst=lds0+LDS_K+wid*1024, vdst=lds0+LDS_V+wid*1024;
  #define DMA_K(t,slot) glds16(ksrc+(long)(t)*KVBLK*KP,(unsigned)__builtin_amdgcn_readfirstlane(kdst+(slot)))
  #define DMA_V(t,slot) glds16(vsrc+(long)(t)*KVBLK*KP,(unsigned)__builtin_amdgcn_readfirstlane(vdst+(slot)))
  const int vb0=(int)(lds0+LDS_V)+((lane>>4)&1)*32+(lane&3)*8+(4*hi+((lane&15)>>2))*64;
  const char*Kbase=shm+LDS_K; bf16x8 kf[8];
  const lds_cptr shm3=(lds_cptr)shm; const lds_cptr kp0=shm3+LDS_K+hi*1024+r32*16; const lds_cptr vp0=shm3+LDS_V+((lane>>4)&1)*32+(lane&3)*8+(4*hi+((lane&15)>>2))*64;
  DMA_K(0,0);DMA_V(0,0);DMA_K(1,SLOTB);
  bf16x8 qr[4];
  #pragma unroll
  for(int d0=0;d0<4;++d0)qr[d0]=*reinterpret_cast<const bf16x8*>(&Qw[(long)r32*QP+d0*16+hi*8]);
  float mhat=0.f,l_reg=0.f;f32x16 o[2];o[0]=f32x16{};o[1]=f32x16{};f32x16 negm=f32x16{};asm volatile("":"+v"(negm));
  #define CMASK(P0,P1,t) do{int jb_=(t)-(NT-4); if(jb_>=2)cmask(P0,P1,jb_);}while(0)
  bool resc=false;
  #define START(P0,P1) do{ const float rm=rowmax(P0,P1); resc=false; \
    { const float dl=rm; mhat=fadd_s(mhat,dl); \
      _Pragma("unroll") for(int r=0;r<16;++r){P0[r]=fsub_s(P0[r],dl);P1[r]=fsub_s(P1[r],dl);} \
      _Pragma("unroll") for(int r=0;r<16;++r)negm[r]=-mhat; asm volatile("":"+v"(negm)); } \
    _Pragma("unroll") for(int r=0;r<16;++r)P0[r]=__builtin_amdgcn_exp2f(P0[r]); }while(0)
  #define RESC() do{ if(resc){ asm volatile("s_waitcnt lgkmcnt(0)":::"memory"); \
      _Pragma("unroll") for(int d_=0;d_<2;++d_) _Pragma("unroll") for(int r=0;r<16;++r)o[d_][r]*=wsf[crow(r,hi)]; } }while(0)
  f32x16 pA0,pA1,pB0,pB1;
  int sl_prev=0,sl_cur=0,sl_next=SLOTB;
  #define ROT() do{sl_prev=sl_cur;sl_cur=sl_next;sl_next=(sl_next==(NSLOT-1)*SLOTB)?0:sl_next+SLOTB;}while(0)
  DMA_K(2,2*SLOTB);
  WAIT_BAR(3);
  qkt(pA0,pA1,Kbase,qr,negm,r32,hi);asm volatile("s_nop 15\n\ts_nop 7":"+v"(pA0),"+v"(pA1));CMASK(pA0,pA1,0);
  START(pA0,pA1);
  _Pragma("unroll") for(int r=0;r<16;++r)pA1[r]=__builtin_amdgcn_exp2f(pA1[r]);
  WAIT_BAR(0);
  DMA_K(3,0);DMA_V(1,SLOTB);
  ROT();
  kload8(kf,kp0+sl_cur);
  WAIT_BAR(2);
  s16x4 vlo[8],vhi[8]; u32x4 pw0,pw1,pw2,pw3;
  #define PKW(P,B) cvtpk_s(P[B],P[B+1])
  #define PAF(k) __builtin_bit_cast(bf16x8,pw##k)
  #define VFR(i) (bf16x8){vlo[i][0],vlo[i][1],vlo[i][2],vlo[i][3],vhi[i][0],vhi[i][1],vhi[i][2],vhi[i][3]}
  #define PIN(x) asm volatile("":"+v"(x))
  #define MX3(a,b,c) __builtin_fmaxf(__builtin_fmaxf((a),(b)),(c))
  #define GAPA(MF,A0,A1,A2,A3,W0,W1,PW) do{ MF; sacc+=A0; sacc+=A1; sacc+=A2; sacc+=A3; PIN(sacc); W0; W1; PIN(PW); SBAR(); }while(0)
  #define EX(v) __builtin_amdgcn_exp2f(v)
  #define GAPB(MF,X,B) do{ MF; X[B]=EX(X[B]); X[B+1]=EX(X[B+1]); X[B+2]=EX(X[B+2]); X[B+3]=EX(X[B+3]); PIN(X); SBAR(); }while(0)
  #define VRD(i) do{ vlo[i]=vtr(vp_+(((i)>>2)*4096+((i)&3)*1024)); vhi[i]=vtr(vp_+(((i)>>2)*4096+((i)&3)*1024+512)); }while(0)
  #define KRD(G,j) do{ if(G){ kload2(kf,kp0+sl_next,j); SBAR(); } }while(0)
  #define STEP(C0,C1,P0,P1,t,GK,GV,GL) do{ SBAR(); \
    const lds_cptr vp_=vp0+sl_prev; \
    VRD(0); SBAR(); float sacc=(P0[0]+P0[1]); \
    GAPA(C0=__builtin_amdgcn_mfma_f32_32x32x16_bf16(kf[0],qr[0],negm,0,0,0), P0[2],P0[3],P0[4],P0[5],     pw0[0]=PKW(P0,0), pw0[1]=PKW(P0,2), pw0); \
    VRD(4); SBAR(); GAPA(C1=__builtin_amdgcn_mfma_f32_32x32x16_bf16(kf[1],qr[0],negm,0,0,0), P0[6],P0[7],P0[8],P0[9],     pw0[2]=PKW(P0,4), pw0[3]=PKW(P0,6), pw0); \
    VRD(1); SBAR(); GAPA(C0=__builtin_amdgcn_mfma_f32_32x32x16_bf16(kf[2],qr[1],C0,0,0,0),   P0[10],P0[11],P0[12],P0[13], pw1[0]=PKW(P0,8), pw1[1]=PKW(P0,10), pw1); \
    VRD(5); SBAR(); GAPA(C1=__builtin_amdgcn_mfma_f32_32x32x16_bf16(kf[3],qr[1],C1,0,0,0),   P0[14],P0[15],P1[0],P1[1],   pw1[2]=PKW(P0,12),pw1[3]=PKW(P0,14), pw1); \
    VRD(2); SBAR(); GAPA(C0=__builtin_amdgcn_mfma_f32_32x32x16_bf16(kf[4],qr[2],C0,0,0,0),   P1[2],P1[3],P1[4],P1[5],     pw2[0]=PKW(P1,0), pw2[1]=PKW(P1,2), pw2); \
    VRD(6); SBAR(); GAPA(C1=__builtin_amdgcn_mfma_f32_32x32x16_bf16(kf[5],qr[2],C1,0,0,0),   P1[6],P1[7],P1[8],P1[9],     pw2[2]=PKW(P1,4), pw2[3]=PKW(P1,6), pw2); \
    VRD(3); SBAR(); GAPA(C0=__builtin_amdgcn_mfma_f32_32x32x16_bf16(kf[6],qr[3],C0,0,0,0),   P1[10],P1[11],P1[12],P1[13], pw3[0]=PKW(P1,8), pw3[1]=PKW(P1,10), pw3); \
    VRD(7); SBAR(); GAPA(C1=__builtin_amdgcn_mfma_f32_32x32x16_bf16(kf[7],qr[3],C1,0,0,0),   P1[14],P1[15],0.f,0.f,       pw3[2]=PKW(P1,12),pw3[3]=PKW(P1,14), pw3); \
    l_reg+=sacc; \
    if(GK){DMA_K((t)+3,sl_cur);} if(GV){DMA_V((t)+1,sl_next);} \
    CMASK(C0,C1,t); \
    { float a=MX3(C0[0],C0[1],C1[0]),b=MX3(C0[2],C0[3],C1[1]); a=MX3(a,C1[2],C1[3]); \
      _Pragma("unroll") for(int r=4;r<16;r+=4){a=MX3(a,C0[r],C0[r+1]);b=MX3(b,C0[r+2],C0[r+3]);a=MX3(a,C1[r],C1[r+1]);b=MX3(b,C1[r+2],C1[r+3]);} \
      float rm=__builtin_fmaxf(a,b); { auto rr=__builtin_amdgcn_permlane32_swap(__float_as_uint(rm),__float_as_uint(rm),false,false); rm=__builtin_fmaxf(__uint_as_float(rr[0]),__uint_as_float(rr[1])); } \
      resc=false; \
      if(__builtin_expect(__any(rm>(float)THRL),0)){ const float dl=__builtin_fmaxf(rm,0.f); mhat+=dl; \
        _Pragma("unroll") for(int r=0;r<16;++r){C0[r]-=dl;C1[r]-=dl;} \
        _Pragma("unroll") for(int r=0;r<16;++r)negm[r]=-mhat; asm volatile("":"+v"(negm)); \
        const float f=__builtin_amdgcn_exp2f(-dl); l_reg*=f; if(hi==0)wsf[r32]=f; resc=true; } } \
    SBAR(); \
    GAPB(o[0]=__builtin_amdgcn_mfma_f32_32x32x16_bf16(PAF(0),VFR(0),o[0],0,0,0), C0,0); \
    GAPB(o[1]=__builtin_amdgcn_mfma_f32_32x32x16_bf16(PAF(0),VFR(4),o[1],0,0,0), C0,4); \
    KRD(GL,0); GAPB(o[0]=__builtin_amdgcn_mfma_f32_32x32x16_bf16(PAF(1),VFR(1),o[0],0,0,0), C0,8); \
    KRD(GL,1); GAPB(o[1]=__builtin_amdgcn_mfma_f32_32x32x16_bf16(PAF(1),VFR(5),o[1],0,0,0), C0,12); \
    KRD(GL,2); GAPB(o[0]=__builtin_amdgcn_mfma_f32_32x32x16_bf16(PAF(2),VFR(2),o[0],0,0,0), C1,0); \
    KRD(GL,3); GAPB(o[1]=__builtin_amdgcn_mfma_f32_32x32x16_bf16(PAF(2),VFR(6),o[1],0,0,0), C1,4); \
    GAPB(o[0]=__builtin_amdgcn_mfma_f32_32x32x16_bf16(PAF(3),VFR(3),o[0],0,0,0), C1,8); \
    GAPB(o[1]=__builtin_amdgcn_mfma_f32_32x32x16_bf16(PAF(3),VFR(7),o[1],0,0,0), C1,12); \
    }while(0)
  int t=1;
  #undef CMASK
  #define CMASK(P0,P1,t) do{}while(0)
  for(;t+5<NT;t+=2){
    STEP(pB0,pB1,pA0,pA1,t,true,true,true);     WAIT_BAR(2); RESC(); ROT();
    STEP(pA0,pA1,pB0,pB1,t+1,true,true,true);   WAIT_BAR(2); RESC(); ROT();
  }
  #undef CMASK
  #define CMASK(P0,P1,t) do{int jb_=(t)-(NT-4); if(jb_>=2)cmask(P0,P1,jb_);}while(0)
  #define ENDW(tt) do{ if((tt)+3<NT){WAIT_BAR(2);} else if((tt)+2<NT){WAIT_BAR(1);} else {WAIT_BAR(0);} }while(0)
  for(;t+1<NT;t+=2){
    STEP(pB0,pB1,pA0,pA1,t,(t+3<NT),(t+1<NT),(t+1<NT));       ENDW(t);   RESC(); ROT();
    STEP(pA0,pA1,pB0,pB1,t+1,(t+4<NT),(t+2<NT),(t+2<NT));     ENDW(t+1); RESC(); ROT();
  }
  STEP(pB0,pB1,pA0,pA1,NT-1,false,false,false); RESC();
  { float sacc=pB0[0]+pB0[1]; _Pragma("unroll") for(int r=2;r<16;++r)sacc+=pB0[r]; _Pragma("unroll") for(int r=0;r<16;++r)sacc+=pB1[r]; l_reg+=sacc;
    pw0=(u32x4){PKW(pB0,0),PKW(pB0,2),PKW(pB0,4),PKW(pB0,6)};pw1=(u32x4){PKW(pB0,8),PKW(pB0,10),PKW(pB0,12),PKW(pB0,14)};pw2=(u32x4){PKW(pB1,0),PKW(pB1,2),PKW(pB1,4),PKW(pB1,6)};pw3=(u32x4){PKW(pB1,8),PKW(pB1,10),PKW(pB1,12),PKW(pB1,14)};
    SBAR(); pv(o,vb0+sl_cur,PAF(0),PAF(1),PAF(2),PAF(3)); }
  #undef PKW
  #undef PAF
  #undef VFR
  #undef PIN
  #undef MX3
  #undef GAPA
  #undef GAPB
  #undef EX
  #undef VRD
  #undef KRD
  #undef STEP
  #undef ENDW
  {auto rr=__builtin_amdgcn_permlane32_swap(__float_as_uint(l_reg),__float_as_uint(l_reg),false,false);l_reg=__uint_as_float(rr[0])+__uint_as_float(rr[1]);}
  if(hi==0)wsf[32+r32]=l_reg;asm volatile("s_waitcnt lgkmcnt(0)":::"memory");
  float rli[16];
  #pragma unroll
  for(int r=0;r<16;++r)rli[r]=__builtin_amdgcn_rcpf(wsf[32+crow(r,hi)]);
  bf16*Ow=O+(long)(q0+wid*QBLK)*QP+h*D;
  { bf16*stg=(bf16*)(shm+LDS_OST)+wid*2048;
    #pragma unroll
    for(int r=0;r<16;++r){const int orow=crow(r,hi);
      #pragma unroll
      for(int d0=0;d0<2;++d0)stg[orow*64+d0*32+r32]=f2bf16(o[d0][r]*rli[r]);}
    asm volatile("s_waitcnt lgkmcnt(0)":::"memory");
    #pragma unroll
    for(int i=0;i<4;++i){const int row=i*8+(lane>>3),ch=lane&7; const u32x4 v=*(const u32x4*)(stg+row*64+ch*8); ATTN_STORE16(Ow+(long)row*QP+ch*8,v);} }
  asm volatile("s_waitcnt lgkmcnt(0)\n\ts_barrier":::"memory");
  #undef DMA_K
  #undef DMA_V
  #undef CMASK
  #undef START
  #undef RESC
  #undef ROT
}
__device__ __forceinline__ void attn_unit_fixed(float mref,int h,int qb,const bf16*Q,const bf16*__restrict__ K,const bf16*__restrict__ V,bf16*O,char*shm){
  int tid_=threadIdx.x; asm volatile("":"+v"(tid_));
  const int tid=tid_,lane=tid&63,r32=lane&31,hi=lane>>5; const int wid=__builtin_amdgcn_readfirstlane(tid>>6);
  const int q0=qb*QB; const int kvh=h>>2;
  const bf16*Qw=Q+(long)(q0+wid*QBLK)*QP+h*D;
  const bf16*Kh=K+kvh*D,*Vh=V+kvh*D;
  const unsigned lds0=(unsigned)(uintptr_t)shm;
  float*wsf=(float*)(shm+LDS_WS)+wid*64;
  const bf16*ksrc=Kh+(long)lane*KP+wid*8;
  const bf16*vsrc=Vh+(long)(16*(wid&3)+(lane>>2))*KP+(wid>>2)*32+(lane&3)*8;
  const unsigned kdst=lds0+LDS_K+wid*1024, vdst=lds0+LDS_V+wid*1024;
  #define DMA_K(t,slot) glds16(ksrc+(long)(t)*KVBLK*KP,(unsigned)__builtin_amdgcn_readfirstlane(kdst+(slot)))
  #define DMA_V(t,slot) glds16(vsrc+(long)(t)*KVBLK*KP,(unsigned)__builtin_amdgcn_readfirstlane(vdst+(slot)))
  const int vb0=(int)(lds0+LDS_V)+((lane>>4)&1)*32+(lane&3)*8+(4*hi+((lane&15)>>2))*64;
  const char*Kbase=shm+LDS_K; bf16x8 kf[8];
  const lds_cptr shm3=(lds_cptr)shm; const lds_cptr kp0=shm3+LDS_K+hi*1024+r32*16; const lds_cptr vp0=shm3+LDS_V+((lane>>4)&1)*32+(lane&3)*8+(4*hi+((lane&15)>>2))*64;
  DMA_K(0,0);DMA_V(0,0);DMA_K(1,SLOTB);
  bf16x8 qr[4];
  #pragma unroll
  for(int d0=0;d0<4;++d0)qr[d0]=*reinterpret_cast<const bf16x8*>(&Qw[(long)r32*QP+d0*16+hi*8]);
  f32x16 o[2];o[0]=f32x16{};o[1]=f32x16{};float l_reg=0.f;f32x16 negm;
  #pragma unroll
  for(int r=0;r<16;++r)negm[r]=-mref;
  asm volatile("":"+v"(negm));
  #define CMASK(P0,P1,t) do{int jb_=(t)-(NT-4); if(jb_>=2)cmask(P0,P1,jb_);}while(0)
  #define START(P0,P1) do{ _Pragma("unroll") for(int r=0;r<16;++r)P0[r]=__builtin_amdgcn_exp2f(P0[r]); }while(0)
  f32x16 pA0,pA1,pB0,pB1;
  int sl_prev=0,sl_cur=0,sl_next=SLOTB;
  #define ROT() do{sl_prev=sl_cur;sl_cur=sl_next;sl_next=(sl_next==(NSLOT-1)*SLOTB)?0:sl_next+SLOTB;}while(0)
  DMA_K(2,2*SLOTB);
  WAIT_BAR(3);
  qkt(pA0,pA1,Kbase,qr,negm,r32,hi);asm volatile("s_nop 15\n\ts_nop 7":"+v"(pA0),"+v"(pA1));CMASK(pA0,pA1,0);
  START(pA0,pA1);
  _Pragma("unroll") for(int r=0;r<16;++r)pA1[r]=__builtin_amdgcn_exp2f(pA1[r]);
  WAIT_BAR(0);
  DMA_K(3,0);DMA_V(1,SLOTB);
  ROT();
  kload8(kf,kp0+sl_cur);
  WAIT_BAR(2);
  s16x4 vlo[8],vhi[8]; u32x4 pw0,pw1,pw2,pw3;
  #define PKW(P,B) cvtpk_s(P[B],P[B+1])
  #define PAF(k) __builtin_bit_cast(bf16x8,pw##k)
  #define VFR(i) (bf16x8){vlo[i][0],vlo[i][1],vlo[i][2],vlo[i][3],vhi[i][0],vhi[i][1],vhi[i][2],vhi[i][3]}
  #define PIN(x) asm volatile("":"+v"(x))
  #define MX3(a,b,c) __builtin_fmaxf(__builtin_fmaxf((a),(b)),(c))
  #define GAPA(MF,A0,A1,A2,A3,W0,W1,PW) do{ MF; sacc+=A0; sacc+=A1; sacc+=A2; sacc+=A3; PIN(sacc); W0; W1; PIN(PW); SBAR(); }while(0)
  #define EX(v) __builtin_amdgcn_exp2f(v)
  #define GAPB(MF,X,B) do{ MF; X[B]=EX(X[B]); X[B+1]=EX(X[B+1]); X[B+2]=EX(X[B+2]); X[B+3]=EX(X[B+3]); PIN(X); SBAR(); }while(0)
  #define VRD(i) do{ vlo[i]=vtr(vp_+(((i)>>2)*4096+((i)&3)*1024)); vhi[i]=vtr(vp_+(((i)>>2)*4096+((i)&3)*1024+512)); }while(0)
  #define KRD(G,j) do{ if(G){ kload2(kf,kp0+sl_next,j); SBAR(); } }while(0)
  #define STEP(C0,C1,P0,P1,t,GK,GV,GL) do{ SBAR(); \
    if(GK){DMA_K((t)+3,sl_cur);} if(GV){DMA_V((t)+1,sl_next);} \
    const lds_cptr vp_=vp0+sl_prev; \
    VRD(0); SBAR(); float sacc=(P0[0]+P0[1]); \
    GAPA(C0=__builtin_amdgcn_mfma_f32_32x32x16_bf16(kf[0],qr[0],negm,0,0,0), P0[2],P0[3],P0[4],P0[5],     pw0[0]=PKW(P0,0), pw0[1]=PKW(P0,2), pw0); \
    VRD(4); SBAR(); GAPA(C1=__builtin_amdgcn_mfma_f32_32x32x16_bf16(kf[1],qr[0],negm,0,0,0), P0[6],P0[7],P0[8],P0[9],     pw0[2]=PKW(P0,4), pw0[3]=PKW(P0,6), pw0); \
    VRD(1); SBAR(); GAPA(C0=__builtin_amdgcn_mfma_f32_32x32x16_bf16(kf[2],qr[1],C0,0,0,0),   P0[10],P0[11],P0[12],P0[13], pw1[0]=PKW(P0,8), pw1[1]=PKW(P0,10), pw1); \
    VRD(5); SBAR(); GAPA(C1=__builtin_amdgcn_mfma_f32_32x32x16_bf16(kf[3],qr[1],C1,0,0,0),   P0[14],P0[15],P1[0],P1[1],   pw1[2]=PKW(P0,12),pw1[3]=PKW(P0,14), pw1); \
    VRD(2); SBAR(); GAPA(C0=__builtin_amdgcn_mfma_f32_32x32x16_bf16(kf[4],qr[2],C0,0,0,0),   P1[2],P1[3],P1[4],P1[5],     pw2[0]=PKW(P1,0), pw2[1]=PKW(P1,2), pw2); \
    VRD(6); SBAR(); GAPA(C1=__builtin_amdgcn_mfma_f32_32x32x16_bf16(kf[5],qr[2],C1,0,0,0),   P1[6],P1[7],P1[8],P1[9],     pw2[2]=PKW(P1,4), pw2[3]=PKW(P1,6), pw2); \
    VRD(3); SBAR(); GAPA(C0=__builtin_amdgcn_mfma_f32_32x32x16_bf16(kf[6],qr[3],C0,0,0,0),   P1[10],P1[11],P1[12],P1[13], pw3[0]=PKW(P1,8), pw3[1]=PKW(P1,10), pw3); \
    VRD(7); SBAR(); GAPA(C1=__builtin_amdgcn_mfma_f32_32x32x16_bf16(kf[7],qr[3],C1,0,0,0),   P1[14],P1[15],0.f,0.f,       pw3[2]=PKW(P1,12),pw3[3]=PKW(P1,14), pw3); \
    l_reg+=sacc; \
    CMASK(C0,C1,t); \
    SBAR(); \
    GAPB(o[0]=__builtin_amdgcn_mfma_f32_32x32x16_bf16(PAF(0),VFR(0),o[0],0,0,0), C0,0); \
    GAPB(o[1]=__builtin_amdgcn_mfma_f32_32x32x16_bf16(PAF(0),VFR(4),o[1],0,0,0), C0,4); \
    KRD(GL,0); GAPB(o[0]=__builtin_amdgcn_mfma_f32_32x32x16_bf16(PAF(1),VFR(1),o[0],0,0,0), C0,8); \
    KRD(GL,1); GAPB(o[1]=__builtin_amdgcn_mfma_f32_32x32x16_bf16(PAF(1),VFR(5),o[1],0,0,0), C0,12); \
    KRD(GL,2); GAPB(o[0]=__builtin_amdgcn_mfma_f32_32x32x16_bf16(PAF(2),VFR(2),o[0],0,0,0), C1,0); \
    KRD(GL,3); GAPB(o[1]=__builtin_amdgcn_mfma_f32_32x32x16_bf16(PAF(2),VFR(6),o[1],0,0,0), C1,4); \
    GAPB(o[0]=__builtin_amdgcn_mfma_f32_32x32x16_bf16(PAF(3),VFR(3),o[0],0,0,0), C1,8); \
    GAPB(o[1]=__builtin_amdgcn_mfma_f32_32x32x16_bf16(PAF(3),VFR(7),o[1],0,0,0), C1,12); \
    }while(0)
  int t=1;
  #undef CMASK
  #define CMASK(P0,P1,t) do{}while(0)
  for(;t+5<NT;t+=2){
    STEP(pB0,pB1,pA0,pA1,t,true,true,true);     WAIT_BAR(2); ROT();
    STEP(pA0,pA1,pB0,pB1,t+1,true,true,true);   WAIT_BAR(2); ROT();
  }
  #undef CMASK
  #define CMASK(P0,P1,t) do{int jb_=(t)-(NT-4); if(jb_>=2)cmask(P0,P1,jb_);}while(0)
  #define ENDW(tt) do{ if((tt)+3<NT){WAIT_BAR(2);} else if((tt)+2<NT){WAIT_BAR(1);} else {WAIT_BAR(0);} }while(0)
  for(;t+1<NT;t+=2){
    STEP(pB0,pB1,pA0,pA1,t,(t+3<NT),(t+1<NT),(t+1<NT));       ENDW(t);   ROT();
    STEP(pA0,pA1,pB0,pB1,t+1,(t+4<NT),(t+2<NT),(t+2<NT));     ENDW(t+1); ROT();
  }
  STEP(pB0,pB1,pA0,pA1,NT-1,false,false,false);
  {
    pw0=(u32x4){PKW(pB0,0),PKW(pB0,2),PKW(pB0,4),PKW(pB0,6)};pw1=(u32x4){PKW(pB0,8),PKW(pB0,10),PKW(pB0,12),PKW(pB0,14)};pw2=(u32x4){PKW(pB1,0),PKW(pB1,2),PKW(pB1,4),PKW(pB1,6)};pw3=(u32x4){PKW(pB1,8),PKW(pB1,10),PKW(pB1,12),PKW(pB1,14)};
    { float sacc=pB0[0]+pB0[1]; _Pragma("unroll") for(int r=2;r<16;++r)sacc+=pB0[r]; _Pragma("unroll") for(int r=0;r<16;++r)sacc+=pB1[r]; l_reg+=sacc; }
    SBAR(); pv(o,vb0+sl_cur,PAF(0),PAF(1),PAF(2),PAF(3)); }
  #undef PKW
  #undef PAF
  #undef VFR
  #undef PIN
  #undef MX3
  #undef GAPA
  #undef GAPB
  #undef EX
  #undef VRD
  #undef KRD
  #undef STEP
  #undef ENDW
  {auto rr=__builtin_amdgcn_permlane32_swap(__float_as_uint(l_reg),__float_as_uint(l_reg),false,false);l_reg=__uint_as_float(rr[0])+__uint_as_float(rr[1]);}
  if(hi==0)wsf[32+r32]=l_reg;asm volatile("s_waitcnt lgkmcnt(0)":::"memory");
  float rli[16];
  #pragma unroll
  for(int r=0;r<16;++r)rli[r]=__builtin_amdgcn_rcpf(wsf[32+crow(r,hi)]);
  bf16*Ow=O+(long)(q0+wid*QBLK)*QP+h*D;
  { bf16*stg=(bf16*)(shm+LDS_OST)+wid*2048;
    #pragma unroll
    for(int r=0;r<16;++r){const int orow=crow(r,hi);
      #pragma unroll
      for(int d0=0;d0<2;++d0)stg[orow*64+d0*32+r32]=f2bf16(o[d0][r]*rli[r]);}
    asm volatile("s_waitcnt lgkmcnt(0)":::"memory");
    #pragma unroll
    for(int i=0;i<4;++i){const int row=i*8+(lane>>3),ch=lane&7; const u32x4 v=*(const u32x4*)(stg+row*64+ch*8); ATTN_STORE16(Ow+(long)row*QP+ch*8,v);} }
  asm volatile("s_waitcnt lgkmcnt(0)\n\ts_barrier":::"memory");
  #undef DMA_K
  #undef DMA_V
  #undef CMASK
  #undef START
  #undef ROT
}


__device__ __forceinline__ void attn_unit_fixed2(float mref,int h,int qb,const bf16*Q,const bf16*__restrict__ K,const bf16*__restrict__ V,bf16*O,char*shm){
  constexpr int NT=257;
  int tid_=threadIdx.x; asm volatile("":"+v"(tid_));
  const int tid=tid_,lane=tid&63,r32=lane&31,hi=lane>>5; const int wid=__builtin_amdgcn_readfirstlane(tid>>6);
  const int q0=qb*QB; const int kvh=h>>2;
  constexpr int NS2=4, LDS_V2=NS2*SLOTB, LDS_WS2=2*NS2*SLOTB, LDS_OST2=LDS_WS2+NW*64*4;
  const bf16*Qw=Q+(long)(q0+wid*QBLK)*QP+h*D;
  const bf16*Kh=K+kvh*D,*Vh=V+kvh*D;
  const unsigned lds0=(unsigned)(uintptr_t)shm;
  float*wsf=(float*)(shm+LDS_WS2)+wid*64;
  const bf16*ksrc=Kh+(long)lane*KP+wid*8;
  const bf16*vsrc=Vh+(long)(16*(wid&3)+(lane>>2))*KP+(wid>>2)*32+(lane&3)*8;
  const unsigned kdst=lds0+LDS_K+wid*1024, vdst=lds0+LDS_V2+wid*1024;
  #define DMA_K(t,slot) glds16(ksrc+(long)(t)*KVBLK*KP,(unsigned)__builtin_amdgcn_readfirstlane(kdst+(slot)))
  #define DMA_V(t,slot) glds16(vsrc+(long)(t)*KVBLK*KP,(unsigned)__builtin_amdgcn_readfirstlane(vdst+(slot)))
  const int vb0=(int)(lds0+LDS_V2)+((lane>>4)&1)*32+(lane&3)*8+(4*hi+((lane&15)>>2))*64;
  const char*Kbase=shm+LDS_K; bf16x8 kf[8];
  const lds_cptr shm3=(lds_cptr)shm; const lds_cptr kp0=shm3+LDS_K+hi*1024+r32*16; const lds_cptr vp0=shm3+LDS_V2+((lane>>4)&1)*32+(lane&3)*8+(4*hi+((lane&15)>>2))*64;
  DMA_K(0,0);DMA_V(0,0);DMA_K(1,SLOTB);
  bf16x8 qr[4];
  #pragma unroll
  for(int d0=0;d0<4;++d0)qr[d0]=*reinterpret_cast<const bf16x8*>(&Qw[(long)r32*QP+d0*16+hi*8]);
  f32x16 o[2];o[0]=f32x16{};o[1]=f32x16{};float l_reg=0.f;f32x16 negm;
  #pragma unroll
  for(int r=0;r<16;++r)negm[r]=-mref;
  asm volatile("":"+v"(negm));
  #define CMASK(P0,P1,t) do{ if((t)==NT-1)cmask(P0,P1,2); }while(0)
  #define START(P0,P1) do{ _Pragma("unroll") for(int r=0;r<16;++r)P0[r]=__builtin_amdgcn_exp2f(P0[r]); }while(0)
  f32x16 pA0,pA1,pB0,pB1;
  int sl_prev=0,sl_cur=0,sl_next=SLOTB;
  #define ROT() do{sl_prev=sl_cur;sl_cur=sl_next;sl_next=(sl_next==(NS2-1)*SLOTB)?0:sl_next+SLOTB;}while(0)
  DMA_K(2,2*SLOTB);DMA_K(3,3*SLOTB);DMA_V(1,SLOTB);
  WAIT_BAR(5);
  qkt(pA0,pA1,Kbase,qr,negm,r32,hi);asm volatile("s_nop 15\n\ts_nop 7":"+v"(pA0),"+v"(pA1));CMASK(pA0,pA1,0);
  START(pA0,pA1);
  _Pragma("unroll") for(int r=0;r<16;++r)pA1[r]=__builtin_amdgcn_exp2f(pA1[r]);
  WAIT_BAR(0);
  ROT();
  kload8(kf,kp0+sl_cur);
  asm volatile("s_waitcnt lgkmcnt(0)\n\ts_barrier":::"memory");
  s16x4 vlo[8],vhi[8]; u32x4 pw0,pw1,pw2,pw3;
  #define PKW(P,B) cvtpk_s(P[B],P[B+1])
  #define PAF(k) __builtin_bit_cast(bf16x8,pw##k)
  #define VFR(i) (bf16x8){vlo[i][0],vlo[i][1],vlo[i][2],vlo[i][3],vhi[i][0],vhi[i][1],vhi[i][2],vhi[i][3]}
  #define PIN(x) asm volatile("":"+v"(x))
  #define MX3(a,b,c) __builtin_fmaxf(__builtin_fmaxf((a),(b)),(c))
  #define GAPA(MF,A0,A1,A2,A3,W0,W1,PW) do{ MF; sacc+=A0; sacc+=A1; sacc+=A2; sacc+=A3; PIN(sacc); W0; W1; PIN(PW); SBAR(); }while(0)
  #define EX(v) __builtin_amdgcn_exp2f(v)
  #define GAPB(MF,X,B) do{ MF; X[B]=EX(X[B]); X[B+1]=EX(X[B+1]); X[B+2]=EX(X[B+2]); X[B+3]=EX(X[B+3]); PIN(X); SBAR(); }while(0)
  #define VRD(i) do{ vlo[i]=vtr(vp_+(((i)>>2)*4096+((i)&3)*1024)); vhi[i]=vtr(vp_+(((i)>>2)*4096+((i)&3)*1024+512)); }while(0)
  #define KRD(G,j) do{ if(G){ kload2(kf,kp0+sl_next,j); SBAR(); } }while(0)
  #define STEP(C0,C1,P0,P1,t,GK,GV,GL) do{ SBAR(); \
    if(GK){DMA_K((t)+3,sl_prev);} if(GV){DMA_V((t)+1,sl_next);} \
    const lds_cptr vp_=vp0+sl_prev; \
    VRD(0); SBAR(); float sacc=(P0[0]+P0[1]); \
    GAPA(C0=__builtin_amdgcn_mfma_f32_32x32x16_bf16(kf[0],qr[0],negm,0,0,0), P0[2],P0[3],P0[4],P0[5],     pw0[0]=PKW(P0,0), pw0[1]=PKW(P0,2), pw0); \
    VRD(4); SBAR(); GAPA(C1=__builtin_amdgcn_mfma_f32_32x32x16_bf16(kf[1],qr[0],negm,0,0,0), P0[6],P0[7],P0[8],P0[9],     pw0[2]=PKW(P0,4), pw0[3]=PKW(P0,6), pw0); \
    VRD(1); SBAR(); GAPA(C0=__builtin_amdgcn_mfma_f32_32x32x16_bf16(kf[2],qr[1],C0,0,0,0),   P0[10],P0[11],P0[12],P0[13], pw1[0]=PKW(P0,8), pw1[1]=PKW(P0,10), pw1); \
    VRD(5); SBAR(); GAPA(C1=__builtin_amdgcn_mfma_f32_32x32x16_bf16(kf[3],qr[1],C1,0,0,0),   P0[14],P0[15],P1[0],P1[1],   pw1[2]=PKW(P0,12),pw1[3]=PKW(P0,14), pw1); \
    VRD(2); SBAR(); GAPA(C0=__builtin_amdgcn_mfma_f32_32x32x16_bf16(kf[4],qr[2],C0,0,0,0),   P1[2],P1[3],P1[4],P1[5],     pw2[0]=PKW(P1,0), pw2[1]=PKW(P1,2), pw2); \
    VRD(6); SBAR(); GAPA(C1=__builtin_amdgcn_mfma_f32_32x32x16_bf16(kf[5],qr[2],C1,0,0,0),   P1[6],P1[7],P1[8],P1[9],     pw2[2]=PKW(P1,4), pw2[3]=PKW(P1,6), pw2); \
    VRD(3); SBAR(); GAPA(C0=__builtin_amdgcn_mfma_f32_32x32x16_bf16(kf[6],qr[3],C0,0,0,0),   P1[10],P1[11],P1[12],P1[13], pw3[0]=PKW(P1,8), pw3[1]=PKW(P1,10), pw3); \
    VRD(7); SBAR(); GAPA(C1=__builtin_amdgcn_mfma_f32_32x32x16_bf16(kf[7],qr[3],C1,0,0,0),   P1[14],P1[15],0.f,0.f,       pw3[2]=PKW(P1,12),pw3[3]=PKW(P1,14), pw3); \
    l_reg+=sacc; \
    CMASK(C0,C1,t); \
    SBAR(); \
    GAPB(o[0]=__builtin_amdgcn_mfma_f32_32x32x16_bf16(PAF(0),VFR(0),o[0],0,0,0), C0,0); \
    GAPB(o[1]=__builtin_amdgcn_mfma_f32_32x32x16_bf16(PAF(0),VFR(4),o[1],0,0,0), C0,4); \
    KRD(GL,0); GAPB(o[0]=__builtin_amdgcn_mfma_f32_32x32x16_bf16(PAF(1),VFR(1),o[0],0,0,0), C0,8); \
    KRD(GL,1); GAPB(o[1]=__builtin_amdgcn_mfma_f32_32x32x16_bf16(PAF(1),VFR(5),o[1],0,0,0), C0,12); \
    KRD(GL,2); GAPB(o[0]=__builtin_amdgcn_mfma_f32_32x32x16_bf16(PAF(2),VFR(2),o[0],0,0,0), C1,0); \
    KRD(GL,3); GAPB(o[1]=__builtin_amdgcn_mfma_f32_32x32x16_bf16(PAF(2),VFR(6),o[1],0,0,0), C1,4); \
    GAPB(o[0]=__builtin_amdgcn_mfma_f32_32x32x16_bf16(PAF(3),VFR(3),o[0],0,0,0), C1,8); \
    GAPB(o[1]=__builtin_amdgcn_mfma_f32_32x32x16_bf16(PAF(3),VFR(7),o[1],0,0,0), C1,12); \
    }while(0)
  int t=1;
  #undef CMASK
  #define CMASK(P0,P1,t) do{}while(0)
  for(;t+5<NT;t+=2){
    STEP(pB0,pB1,pA0,pA1,t,true,true,true);     ROT();
    STEP(pA0,pA1,pB0,pB1,t+1,true,true,true);   WAIT_BAR(0); ROT();
  }
  #undef CMASK
  #define CMASK(P0,P1,t) do{ if((t)==NT-1)cmask(P0,P1,2); }while(0)
  for(;t+1<NT;t+=2){
    STEP(pB0,pB1,pA0,pA1,t,(t+3<NT),(t+1<NT),(t+1<NT));       ROT();
    STEP(pA0,pA1,pB0,pB1,t+1,(t+4<NT),(t+2<NT),(t+2<NT));     WAIT_BAR(0); ROT();
  }
  {
    pw0=(u32x4){PKW(pA0,0),PKW(pA0,2),PKW(pA0,4),PKW(pA0,6)};pw1=(u32x4){PKW(pA0,8),PKW(pA0,10),PKW(pA0,12),PKW(pA0,14)};pw2=(u32x4){PKW(pA1,0),PKW(pA1,2),PKW(pA1,4),PKW(pA1,6)};pw3=(u32x4){PKW(pA1,8),PKW(pA1,10),PKW(pA1,12),PKW(pA1,14)};
    { float sacc=pA0[0]+pA0[1]; _Pragma("unroll") for(int r=2;r<16;++r)sacc+=pA0[r]; _Pragma("unroll") for(int r=0;r<16;++r)sacc+=pA1[r]; l_reg+=sacc; }
    SBAR(); pv(o,vb0+sl_prev,PAF(0),PAF(1),PAF(2),PAF(3)); }
  #undef PKW
  #undef PAF
  #undef VFR
  #undef PIN
  #undef MX3
  #undef GAPA
  #undef GAPB
  #undef EX
  #undef VRD
  #undef KRD
  #undef STEP
  {auto rr=__builtin_amdgcn_permlane32_swap(__float_as_uint(l_reg),__float_as_uint(l_reg),false,false);l_reg=__uint_as_float(rr[0])+__uint_as_float(rr[1]);}
  if(hi==0)wsf[32+r32]=l_reg;asm volatile("s_waitcnt lgkmcnt(0)":::"memory");
  float rli[16];
  #pragma unroll
  for(int r=0;r<16;++r)rli[r]=__builtin_amdgcn_rcpf(wsf[32+crow(r,hi)]);
  bf16*Ow=O+(long)(q0+wid*QBLK)*QP+h*D;
  { bf16*stg=(bf16*)(shm+LDS_OST2)+wid*2048;
    #pragma unroll
    for(int r=0;r<16;++r){const int orow=crow(r,hi);
      #pragma unroll
      for(int d0=0;d0<2;++d0)stg[orow*64+d0*32+r32]=f2bf16(o[d0][r]*rli[r]);}
    asm volatile("s_waitcnt lgkmcnt(0)":::"memory");
    #pragma unroll
    for(int i=0;i<4;++i){const int row=i*8+(lane>>3),ch=lane&7; const u32x4 v=*(const u32x4*)(stg+row*64+ch*8); ATTN_STORE16(Ow+(long)row*QP+ch*8,v);} }
  asm volatile("s_waitcnt lgkmcnt(0)\n\ts_barrier":::"memory");
  #undef DMA_K
  #undef DMA_V
  #undef CMASK
  #undef START
  #undef ROT
}


constexpr int ATTN_LDS_BYTES=LDS_BYTES;
struct AttnTensors { const bf16* Q; const bf16* K; const bf16* V; bf16* O; const float* qgain; const float* kgain; };
template<int THRL=8> __device__ __forceinline__ void attn_phase(char*lds,const AttnTensors&T,int vcu,int G){
  float gq=__builtin_fabsf(T.qgain[threadIdx.x&63]),gk=__builtin_fabsf(T.kgain[threadIdx.x&63]);
  #pragma unroll
  for(int o=1;o<64;o<<=1){gq=__builtin_fmaxf(gq,__shfl_xor(gq,o));gk=__builtin_fmaxf(gk,__shfl_xor(gk,o));}
  const float mref=__uint_as_float(__builtin_amdgcn_readfirstlane(__float_as_uint(C2*64.0f*gq*gk*1.001f+0.01f)));
  const bool fixed=mref<48.0f;
  const bool bal=(G==256);
  for(int k=0;;++k){
    int h,qb;
    if(bal){ if(k>=2)break; h=vcu>>5; qb=(vcu&31)+32*k; }
    else { const int u=vcu+k*G; if(u>=512)break; h=u>>6; qb=u&63; }
    if(fixed) attn_unit_fixed2(mref,h,qb,T.Q,T.K,T.V,T.O,lds); else attn_unit<THRL>(h,qb,T.Q,T.K,T.V,T.O,lds);
  }
}
#undef SBAR
#undef WAIT_BAR
}

constexpr int NWAVES = 8;
#ifndef MK_N_LAUNCHES
#define MK_N_LAUNCHES 1
#endif
constexpr int N_PHASES = 11;
constexpr int N_LAUNCHES = MK_N_LAUNCHES;
static_assert(N_LAUNCHES == 1 || N_LAUNCHES == N_PHASES, "MK_N_LAUNCHES is 1 or 11");

constexpr int M = 16384, DM = 1024, NMETA = 16, DFF = 2816, NGU = 2 * DFF, NIN = 5376;
constexpr int HGW = 512;
constexpr int HROWS = M + 128;

constexpr size_t MiB = 1u << 20;
constexpr size_t WS_CTL = 0, CTL_ZERO_BYTES = 32768;
constexpr size_t WS_MISC = 1 * MiB;
constexpr size_t MISC_ROPER = 0, MISC_ROPEC = 32768, MISC_OMLF = 40960, MISC_OMLB = 43008, MISC_METAB = 45056, MISC_SSQ0M = 77824, MISC_ACTM = 78848, MISC_H1M = 168960, MISC_H1MB = 234496,
                 MISC_SSQM = 267264, MISC_DF = 271360, MISC_DB = 535552, MISC_END = 799744;
static_assert(MISC_END <= 2 * MiB, "misc");
constexpr size_t WS_SSQ0 = 3 * MiB, WS_SSQ1 = 4 * MiB, WS_SSQ2 = 5 * MiB;
constexpr size_t WS_W = 6 * MiB;
constexpr size_t W_GU1 = 0, W_D1 = 11534336, W_IN = 17301504, W_UP = 28311552, W_OUT = 30408704, W_GU2 = 32505856, W_D2 = 44040192, W_END = 49807360;
constexpr size_t WS_HB = WS_W + W_END;
constexpr size_t WS_Z = WS_HB + (size_t)M * DM * 2;
constexpr size_t Z_HQ = 0, Z_QO = 16908288, Z_HV = 33685504, Z_ZFF = 50593792, Z_ZFB = 67502080, Z_HG = 84410368, Z_KB = 101318656, Z_VB = 105545728, Z_GA = 109772800, Z_GB = 143327232, Z_END = 176881664;
constexpr size_t WS_END = WS_Z + Z_END;
static_assert(Z_QO == Z_HQ + (size_t)HROWS * HGW * 2 && Z_HV == Z_QO + (size_t)M * HGW * 2 && Z_ZFF == Z_HV + (size_t)HROWS * HGW * 2 && Z_KB == Z_HG + (size_t)HROWS * HGW * 2 && Z_GA == Z_VB + (size_t)HROWS * 128 * 2 &&
              Z_END == Z_GB + (size_t)M * DM * 2 && WS_END <= 268435456 && (size_t)M * DFF * 2 <= Z_END && (size_t)M * DM * 2 <= Z_ZFB - Z_HV, "d_ws map");
constexpr int CW_TMO = 0, CW_CODE = 1, CW_BAR = 4096;

constexpr int RING_OFF = 0, RING_BYTES = 131072;
constexpr int HL_QH = 0, HL_KH = 32768, HL_VT = 65536, HL_ST = 100352, HL_TOT = 135168, HL_ER = 143360, HL_SSQ = 143872, HL_END = 144896;
constexpr int HL_PITCH = 272;
constexpr int OX_PITCH = 132;
constexpr int RS_OFF = 144896;
constexpr int LDSCTL_OFF = 153088, MISC_OFF = LDSCTL_OFF + 320;
constexpr int LDS_BYTES = 154112;
static_assert(HL_END <= RS_OFF && RS_OFF + pg8::RS_UNITS * 1024 <= LDSCTL_OFF && (M / 256) * (NGU / 256) <= pg8::RS_UNITS * 256 && RING_BYTES <= RS_OFF && MISC_OFF + 128 <= LDS_BYTES && 128 * OX_PITCH * 4 <= HL_ST, "LDS map");

#define GAS __attribute__((address_space(1)))
#define LAS __attribute__((address_space(3)))
typedef unsigned short bf16;
typedef unsigned v4u __attribute__((ext_vector_type(4)));
typedef float f32x4 __attribute__((ext_vector_type(4)));
typedef float f32x2 __attribute__((ext_vector_type(2)));
typedef float f32x16 __attribute__((ext_vector_type(16)));
typedef short bf16x8 __attribute__((ext_vector_type(8)));
typedef short s16x4 __attribute__((ext_vector_type(4)));
typedef GAS unsigned gu32;
#define RLX_AGENT __ATOMIC_RELAXED, __HIP_MEMORY_SCOPE_AGENT
#define LDS_WAIT() asm volatile("s_waitcnt lgkmcnt(0)" ::: "memory")
#define VM_WAIT() asm volatile("s_waitcnt vmcnt(0)" ::: "memory")
__device__ __forceinline__ unsigned f2bf(float f) { unsigned u = __builtin_bit_cast(unsigned, f); return (u + 0x7fffu + ((u >> 16) & 1u)) >> 16; }
typedef float f32x2_hw __attribute__((ext_vector_type(2))); typedef __bf16 bf16x2_hw __attribute__((ext_vector_type(2)));
__device__ __forceinline__ unsigned pk2(float lo, float hi) { f32x2_hw v = {lo, hi}; bf16x2_hw b = __builtin_convertvector(v, bf16x2_hw); return __builtin_bit_cast(unsigned, b); }
__device__ __forceinline__ float bf2f(unsigned short b) { return __uint_as_float((unsigned)b << 16); }
__device__ __forceinline__ float wave_sum(float v) {
#pragma unroll
    for (int o = 1; o < 64; o <<= 1) v += __shfl_xor(v, o);
    return v;
}
#define XB_TMO      128
#define XB_SEEN(j)  (160 + (j))
#define XB_XCNT(j)  (256  + 64 * (j))
#define XB_XSUB(j)  (1280 + 64 * (j))
#define XB_XGEN(j)  (2304 + 64 * (j))
#define XB_TOP      3328
#define XB_TOPGEN   3392
#define XCD_BAR_WORDS 3456
#define XB_SPIN_CAP (1u << 18)
static_assert((size_t)(CW_BAR + XCD_BAR_WORDS) * 4 <= CTL_ZERO_BYTES, "barrier words inside the zeroed prefix");

__device__ __forceinline__ unsigned xb_ld(unsigned* p)              { return __hip_atomic_load(p, __ATOMIC_RELAXED, __HIP_MEMORY_SCOPE_AGENT); }
__device__ __forceinline__ unsigned xb_add(unsigned* p, unsigned v) { return __hip_atomic_fetch_add(p, v, __ATOMIC_RELAXED, __HIP_MEMORY_SCOPE_AGENT); }
__device__ __forceinline__ unsigned xb_xcc_id() { return (unsigned)__builtin_amdgcn_s_getreg((3 << 11) | 20) & 0xFu; }
#define XB_SPIN(cond, bar) do { unsigned _sp = 0; while (cond) { __builtin_amdgcn_s_sleep(1); \
    if ((++_sp & 255u) == 0u) { if (xb_ld(&(bar)[XB_TMO])) break; if (_sp > XB_SPIN_CAP) { atomicAdd(&(bar)[XB_TMO], 1u); break; } } } } while (0)

struct XcdBarrier {
    unsigned* bar; unsigned x;
    volatile LAS unsigned* st;
};

__device__ __forceinline__ XcdBarrier xcd_barrier_post(unsigned* bar, volatile LAS unsigned* st) {
    XcdBarrier b; b.bar = bar; b.x = xb_xcc_id(); b.st = st;
    if (threadIdx.x == 0) { (void)__hip_atomic_fetch_or(&bar[XB_SEEN(b.x)], 1u << (blockIdx.x & 7u), __ATOMIC_RELAXED, __HIP_MEMORY_SCOPE_AGENT); (void)xb_add(&bar[XB_XCNT(b.x)], 1u); }
    return b;
}
__device__ __forceinline__ void xcd_barrier_complete(unsigned* bar, unsigned x, unsigned& nloc, unsigned& nx) {
    const unsigned G = gridDim.x * gridDim.y * gridDim.z;
    unsigned sum, cnt, mine, sp = 0u;
    for (;;) {
        sum = 0u; cnt = 0u; mine = 0u;
#pragma unroll
        for (unsigned j = 0; j < 16; ++j) { const unsigned c = xb_ld(&bar[XB_XCNT(j)]); sum += c; cnt += (c > 0u) ? 1u : 0u; mine = (j == x) ? c : mine; }
        if (sum == G) break;
        __builtin_amdgcn_s_sleep(1);
        if ((++sp & 255u) == 0u) { if (xb_ld(&bar[XB_TMO])) break; if (sp > XB_SPIN_CAP) { atomicAdd(&bar[XB_TMO], 1u); break; } }
    }
    nloc = mine > 0u ? mine : 1u; nx = cnt > 0u ? cnt : 1u;
}

__device__ __forceinline__ void xcd_barrier(const XcdBarrier& b) {
    asm volatile("s_waitcnt vmcnt(0)" ::: "memory");
    __syncthreads();
    if (threadIdx.x == 0) {
        unsigned* bar = b.bar;
        __builtin_amdgcn_s_waitcnt(0);
        unsigned nloc = b.st[0], nx = b.st[1];
        if (nloc == 0u) { xcd_barrier_complete(bar, b.x, nloc, nx); b.st[0] = nloc; b.st[1] = nx; }
        __builtin_amdgcn_fence(__ATOMIC_ACQUIRE, "agent");
        const unsigned old = xb_add(&bar[XB_XSUB(b.x)], 1u);
        const unsigned gen = b.st[4], tg = b.st[5]; b.st[4] = gen + 1u; b.st[5] = tg + 1u;
        if (old + 1u == (gen + 1u) * nloc) {
            __builtin_amdgcn_fence(__ATOMIC_RELEASE, "agent");
            asm volatile("s_waitcnt vmcnt(0)" ::: "memory");
            const unsigned og = xb_add(&bar[XB_TOP], 1u);
            if (og + 1u == (tg + 1u) * nx) xb_add(&bar[XB_TOPGEN], 1u);
            else XB_SPIN(xb_ld(&bar[XB_TOPGEN]) == tg, bar);
            xb_add(&bar[XB_XGEN(b.x)], 1u);
            asm volatile("s_waitcnt vmcnt(0)" ::: "memory");
        } else {
            XB_SPIN(xb_ld(&bar[XB_XGEN(b.x)]) == gen, bar);
            asm volatile("s_waitcnt vmcnt(0)" ::: "memory");
        }
    }
    __syncthreads();
}

struct Frame {
    LAS unsigned char* lds;
    volatile LAS unsigned* MISC;
    gu32* ctl;
    int wave;
    int vcu, G;
    const float* in[20]; float* out; unsigned char* ws;
};
#define WSP(T, off) ((T*)(F.ws + (off)))

__device__ __forceinline__ void xcd_barrier_local(const XcdBarrier& b) {
    asm volatile("s_waitcnt vmcnt(0)" ::: "memory");
    __syncthreads();
    bool full = false;
    if (threadIdx.x == 0) {
        unsigned* bar = b.bar;
        __builtin_amdgcn_s_waitcnt(0);
        unsigned ok = b.st[2];
        if (ok == 0u) {
            const unsigned G = gridDim.x; unsigned good = (G % 8u == 0u && b.st[0] == G / 8u) ? 1u : 0u, all = 0u;
#pragma unroll
            for (unsigned j = 0; j < 16; ++j) { const unsigned m = xb_ld(&bar[XB_SEEN(j)]); if (m & (m - 1u)) good = 0u; if (all & m) good = 0u; all |= m; }
            if (all != 0xffu) good = 0u;
            ok = good ? 1u : 2u; b.st[2] = ok;
        }
        if (ok == 1u) {
            const unsigned nloc = b.st[0];
            __builtin_amdgcn_fence(__ATOMIC_ACQUIRE, "agent");
            const unsigned old = xb_add(&bar[XB_XSUB(b.x)], 1u);
            const unsigned gen = b.st[4]; b.st[4] = gen + 1u;
            if (old + 1u == (gen + 1u) * nloc) {
                xb_add(&bar[XB_XGEN(b.x)], 1u);
                asm volatile("s_waitcnt vmcnt(0)" ::: "memory");
            } else {
                XB_SPIN(xb_ld(&bar[XB_XGEN(b.x)]) == gen, bar);
                asm volatile("s_waitcnt vmcnt(0)" ::: "memory");
            }
        } else full = true;
    }
    full = __builtin_amdgcn_readfirstlane((int)full) != 0;
    if (threadIdx.x == 0) b.st[3] = full ? 1u : 0u;
    __syncthreads();
    if (b.st[3]) xcd_barrier(b);
}

__device__ __forceinline__ int win_rowmap(int n) {
    if (n >= 2560 && n < 3072) { const int cq = n - 2560, hd = cq >> 6, d = cq & 63; return 256 * (10 + (hd >> 2)) + 128 * (d >> 5) + 32 * (hd & 3) + (d & 31); }
    if (n >= 3072 && n < 3328) { const int c = n - 3072, hh = c >> 6, d = c & 63; return 3072 + 128 * (d >> 5) + 32 * hh + (d & 31); }
    if (n >= 3328) { const int c = n - 3328, z = c >> 10, cc = c & 1023; return 3328 + 256 * (cc >> 7) + 128 * z + (cc & 127); }
    return n;
}
template <int KIND>
__device__ __forceinline__ void p0_transpose_item(const float* W, int K, int N, bf16* WT, int row_off, const float* kscale, LAS float* scr, int item, int lane) {
    const int nblk = N / 32, kb = item / nblk, nb = item % nblk, k0 = 64 * kb, n0 = 32 * nb;
    constexpr int TP = 66;
    const int kr = lane >> 3, nq = lane & 7;
    f32x4 wv[8];
#pragma unroll
    for (int i = 0; i < 8; ++i) wv[i] = *(const GAS f32x4*)(W + (size_t)(k0 + 8 * i + kr) * N + n0 + 4 * nq);
#pragma unroll
    for (int i = 0; i < 8; ++i) { const int kk = 8 * i + kr; const float sc = kscale ? kscale[k0 + kk] : 1.0f; LAS float* d = scr + (4 * nq) * TP + kk;
        d[0] = wv[i][0] * sc; d[TP] = wv[i][1] * sc; d[2 * TP] = wv[i][2] * sc; d[3 * TP] = wv[i][3] * sc; }
    LDS_WAIT(); asm volatile("" ::: "memory");
    const int c = lane & 7;
#pragma unroll
    for (int j = 0; j < 4; ++j) { const int n = (lane >> 3) + 8 * j; const LAS f32x2* s2 = (const LAS f32x2*)(scr + n * TP + 8 * c);
        const f32x2 a = s2[0], b = s2[1], e = s2[2], f = s2[3];
        v4u o; o.x = pk2(a[0], a[1]); o.y = pk2(b[0], b[1]); o.z = pk2(e[0], e[1]); o.w = pk2(f[0], f[1]);
        const int nn = n0 + n; const int drow = (KIND == 0) ? row_off + nn : ((KIND == 1) ? 256 * (nn >> 7) + (nn & 127) + row_off : win_rowmap(nn));
        *(GAS v4u*)(WT + (size_t)drow * K + k0 + 8 * c) = o; }
    LDS_WAIT(); asm volatile("" ::: "memory");
}
__device__ __forceinline__ void row_to_bf16(int lane, const float* xrow, bf16* orow, float* ssq16) {
    const GAS f32x4* xr = (const GAS f32x4*)xrow + lane;
    f32x4 v[4]; float s = 0.f;
#pragma unroll
    for (int j = 0; j < 4; ++j) { v[j] = xr[64 * j]; s += (v[j].x * v[j].x + v[j].y * v[j].y) + (v[j].z * v[j].z + v[j].w * v[j].w); }
    s = wave_sum(s);
    GAS unsigned long long* o8 = (GAS unsigned long long*)orow + lane;
#pragma unroll
    for (int j = 0; j < 4; ++j) o8[64 * j] = (unsigned long long)pk2(v[j].x, v[j].y) | ((unsigned long long)pk2(v[j].z, v[j].w) << 32);
    if (lane < 16) ssq16[lane] = (lane == 0) ? s : 0.f;
}
__device__ __forceinline__ void sincos_d(double a, float& sn, float& cs) {
    const double TWO_PI = 6.283185307179586476925286766559;
    const double k = __builtin_rint(a / TWO_PI); const double x = a - k * TWO_PI;
    const double x2 = x * x; double ts = 1.0, tc = 1.0, ss = 1.0, cc = 1.0;
#pragma unroll
    for (int i = 1; i <= 13; ++i) { tc = -tc * x2 / (double)((2 * i - 1) * (2 * i)); ts = -ts * x2 / (double)((2 * i) * (2 * i + 1)); cc += tc; ss += ts; }
    sn = (float)(ss * x); cs = (float)cc;
}
constexpr int I_G = (DM / 64) * (DFF / 32), I_D = (DFF / 64) * (DM / 32), I_IN = (DM / 64) * (NIN / 32), I_U = (HGW / 64) * (DM / 32), I_O = (DM / 64) * (DM / 32);
constexpr int CV_FFN1 = 2 * I_G + I_D, CV_IN = CV_FFN1 + I_IN, CV_ALL = CV_IN + 2 * I_U + I_O + 2 * I_G + I_D;
__device__ __forceinline__ void convert_items(Frame& F, int it_lo, int it_hi, int wrank, int nw) {
    LAS float* scr = (LAS float*)(F.lds + RING_OFF + F.wave * 16384);
    const int lane = (int)threadIdx.x & 63;
    bf16* Wb = WSP(bf16, WS_W);
    for (int it = it_lo + wrank; it < it_hi; it += nw) {
        int r = it;
        if (r < I_G) { p0_transpose_item<1>(F.in[3], DM, DFF, Wb + W_GU1 / 2, 0, F.in[2], scr, r, lane); continue; } r -= I_G;
        if (r < I_G) { p0_transpose_item<1>(F.in[4], DM, DFF, Wb + W_GU1 / 2, 128, F.in[2], scr, r, lane); continue; } r -= I_G;
        if (r < I_D) { p0_transpose_item<0>(F.in[5], DFF, DM, Wb + W_D1 / 2, 0, nullptr, scr, r, lane); continue; } r -= I_D;
        if (r < I_IN) { p0_transpose_item<2>(F.in[7], DM, NIN, Wb + W_IN / 2, 0, F.in[6], scr, r, lane); continue; } r -= I_IN;
        if (r < I_U) { p0_transpose_item<0>(F.in[13], HGW, DM, Wb + W_UP / 2, 0, nullptr, scr, r, lane); continue; } r -= I_U;
        if (r < I_U) { p0_transpose_item<0>(F.in[14], HGW, DM, Wb + W_UP / 2, 1024, nullptr, scr, r, lane); continue; } r -= I_U;
        if (r < I_O) { p0_transpose_item<0>(F.in[15], DM, DM, Wb + W_OUT / 2, 0, nullptr, scr, r, lane); continue; } r -= I_O;
        if (r < I_G) { p0_transpose_item<1>(F.in[17], DM, DFF, Wb + W_GU2 / 2, 0, F.in[16], scr, r, lane); continue; } r -= I_G;
        if (r < I_G) { p0_transpose_item<1>(F.in[18], DM, DFF, Wb + W_GU2 / 2, 128, F.in[16], scr, r, lane); continue; } r -= I_G;
        p0_transpose_item<0>(F.in[19], DFF, DM, Wb + W_D2 / 2, 0, nullptr, scr, r, lane);
    }
}
__device__ __forceinline__ void convert_in_idle_slot(Frame& F, int nwg, int it_lo, int it_hi) {
    const int cut = nwg % F.G, c = (int)blockIdx.x;
    if (c < cut) return;
    convert_items(F, it_lo, it_hi, (c - cut) * NWAVES + F.wave, (F.G - cut) * NWAVES);
    __syncthreads();
}
__device__ __forceinline__ void stagger_short_share(Frame& F, int nwg, int sleeps) {
    const int cut = nwg % F.G; if (cut == 0 || (int)blockIdx.x < cut) return;
    for (int i = 0; i < sleeps; ++i) __builtin_amdgcn_s_sleep(127);
}
__device__ __forceinline__ void p0_prologue(Frame& F) {
    const int gw = F.vcu * NWAVES + F.wave, NGW = F.G * NWAVES;
    convert_items(F, 0, CV_FFN1, gw, NGW);
    {
        const int lane = (int)threadIdx.x & 63;
        for (int m0 = gw; m0 < M; m0 += 4 * NGW) {
            f32x4 v[4][4]; float sq[4];
#pragma unroll
            for (int q = 0; q < 4; ++q) { const int m = m0 + q * NGW; const GAS f32x4* xr = (const GAS f32x4*)(F.in[0] + (size_t)(m < M ? m : m0) * DM) + lane;
#pragma unroll
                for (int j = 0; j < 4; ++j) v[q][j] = xr[64 * j]; }
#pragma unroll
            for (int q = 0; q < 4; ++q) { float t = 0.f;
#pragma unroll
                for (int j = 0; j < 4; ++j) t += (v[q][j].x * v[q][j].x + v[q][j].y * v[q][j].y) + (v[q][j].z * v[q][j].z + v[q][j].w * v[q][j].w);
                sq[q] = wave_sum(t); }
#pragma unroll
            for (int q = 0; q < 4; ++q) { const int m = m0 + q * NGW; if (m < M) {
                bf16* orow = WSP(bf16, WS_HB) + (size_t)m * DM;
#pragma unroll
                for (int jp = 0; jp < 2; ++jp) {
                    const unsigned a0 = pk2(v[q][2 * jp].x, v[q][2 * jp].y), a1 = pk2(v[q][2 * jp].z, v[q][2 * jp].w), b0 = pk2(v[q][2 * jp + 1].x, v[q][2 * jp + 1].y), b1 = pk2(v[q][2 * jp + 1].z, v[q][2 * jp + 1].w);
                    const bool odd = lane & 1;
                    const unsigned s0 = odd ? a0 : b0, s1 = odd ? a1 : b1;
                    const unsigned r0 = (unsigned)__builtin_amdgcn_update_dpp(0, (int)s0, 0xB1, 0xf, 0xf, false), r1 = (unsigned)__builtin_amdgcn_update_dpp(0, (int)s1, 0xB1, 0xf, 0xf, false);
                    v4u o; o.x = odd ? r0 : a0; o.y = odd ? r1 : a1; o.z = odd ? b0 : r0; o.w = odd ? b1 : r1;
                    *(GAS v4u*)(orow + (2 * jp + (lane & 1)) * 256 + 8 * (lane >> 1)) = o;
                }
                if (lane < 16) (WSP(float, WS_SSQ0) + (size_t)m * 16)[lane] = (lane == 0) ? sq[q] : 0.f; } }
        }
    }
    if (gw < NMETA) row_to_bf16(((int)threadIdx.x & 63), F.in[1] + (size_t)gw * DM, WSP(bf16, WS_MISC + MISC_METAB) + (size_t)gw * DM, WSP(float, WS_MISC + MISC_SSQ0M) + gw * 16);
    const int gt = F.vcu * (NWAVES * 64) + (int)threadIdx.x;
    if (gt < 320 * 16) {
        const int pos = gt >> 4, j = gt & 15;
        const double inv = (double)exp2f(-(float)j * (13.287712379549449f / 16.0f));
        float sn, cs; sincos_d((double)(pos < 256 ? pos : pos - 256) * inv, sn, cs);
        f32x2* tab = (pos < 256) ? WSP(f32x2, WS_MISC + MISC_ROPER) + pos * 16 + j : WSP(f32x2, WS_MISC + MISC_ROPEC) + (pos - 256) * 16 + j;
        *tab = (f32x2){cs, sn};
    } else if (gt < 320 * 16 + 1024) {
        const int i = gt - 320 * 16, k = i & 511; const float* lb = (i < 512) ? F.in[8] : F.in[9];
        const float a0 = lb[k], a1 = lb[512 + k];
        (i < 512 ? WSP(float, WS_MISC + MISC_OMLF) : WSP(float, WS_MISC + MISC_OMLB))[k] = 1.0f / (1.0f + __expf(a0 - a1));
    }
}

template <int NG, int KS>
__device__ __forceinline__ void thin_job(const bf16* A, const bf16* Bt, const int (&brow)[NG], int K, LAS float* red, f32x4 (&acc)[NG], int wave, int lane) {
    const int kbeg = wave * KS * 32;
    const bf16* ap = A + (size_t)(lane & 15) * K + kbeg + 8 * (lane >> 4);
#pragma unroll
    for (int g = 0; g < NG; ++g) acc[g] = (f32x4){0.f, 0.f, 0.f, 0.f};
    bf16x8 af[KS];
#pragma unroll
    for (int s2 = 0; s2 < KS; ++s2) af[s2] = *(const GAS bf16x8*)(ap + 32 * s2);
#pragma unroll
    for (int g = 0; g < NG; ++g) {
        const bf16* bp = Bt + (size_t)(brow[g] + (lane & 15)) * K + kbeg + 8 * (lane >> 4);
        bf16x8 bfr[KS];
#pragma unroll
        for (int s2 = 0; s2 < KS; ++s2) bfr[s2] = *(const GAS bf16x8*)(bp + 32 * s2);
#pragma unroll
        for (int s2 = 0; s2 < KS; ++s2) acc[g] = __builtin_amdgcn_mfma_f32_16x16x32_bf16(af[s2], bfr[s2], acc[g], 0, 0, 0);
    }
#pragma unroll
    for (int g = 0; g < NG; ++g) *(LAS f32x4*)(red + ((wave * NG + g) * 64 + lane) * 4) = acc[g];
    __syncthreads();
    if (wave == 0) {
#pragma unroll
        for (int g = 0; g < NG; ++g) { f32x4 sum = acc[g];
#pragma unroll
            for (int w2 = 1; w2 < 8; ++w2) sum += *(const LAS f32x4*)(red + ((w2 * NG + g) * 64 + lane) * 4);
            acc[g] = sum; }
    }
    __syncthreads();
}
__device__ __forceinline__ int slack_first(int nwg, int G, int njobs) { const int cut = nwg % G; return (cut && G - cut >= njobs) ? cut : 0; }
__device__ __forceinline__ void meta_p1_job(Frame& F, int job) {
    const int j0 = 32 * job, j1 = j0 + 16, lane = (int)threadIdx.x & 63;
    const int brow[4] = {256 * (j0 >> 7) + (j0 & 127), 256 * (j0 >> 7) + (j0 & 127) + 128, 256 * (j1 >> 7) + (j1 & 127), 256 * (j1 >> 7) + (j1 & 127) + 128};
    f32x4 acc[4];
    thin_job<4, 4>(WSP(bf16, WS_MISC + MISC_METAB), WSP(bf16, WS_W + W_GU1), brow, DM, (LAS float*)(F.lds + RING_OFF), acc, F.wave, lane);
    if (F.wave != 0) return;
    const float* ssq = WSP(float, WS_MISC + MISC_SSQ0M); bf16* act = WSP(bf16, WS_MISC + MISC_ACTM);
#pragma unroll
    for (int r = 0; r < 4; ++r) { const int row = 4 * (lane >> 4) + r; const float rs = rsqrtf(ssq[row * 16] * (1.0f / 1024.0f) + pg8::RMS_EPS);
        act[(size_t)row * DFF + j0 + (lane & 15)] = (bf16)f2bf(pg8::fast_silu(acc[0][r] * rs) * (acc[1][r] * rs));
        act[(size_t)row * DFF + j1 + (lane & 15)] = (bf16)f2bf(pg8::fast_silu(acc[2][r] * rs) * (acc[3][r] * rs)); }
}
__device__ __forceinline__ void meta_p1(Frame& F) {
    const int nwg = (M / 256) * (NGU / 256), cut = nwg % F.G, ns = F.G - cut;
    if (cut && 2 * ns >= DFF / 32) {
#pragma unroll 1
        for (int job = (int)blockIdx.x - cut; job >= 0 && job < DFF / 32; job += ns) meta_p1_job(F, job);
        return;
    }
    const int job = (int)blockIdx.x - slack_first(nwg, F.G, DFF / 32); if (job < 0 || job >= DFF / 32) return;
    meta_p1_job(F, job);
}
__device__ __forceinline__ void meta_p2(Frame& F) {
    const int job = (int)blockIdx.x; if (job >= DM / 16) return;
    const int c0 = 16 * job, lane = (int)threadIdx.x & 63;
    const int brow[1] = {c0};
    f32x4 acc[1];
    thin_job<1, 11>(WSP(bf16, WS_MISC + MISC_ACTM), WSP(bf16, WS_W + W_D1), brow, DFF, (LAS float*)(F.lds + RING_OFF), acc, F.wave, lane);
    if (F.wave != 0) return;
    float* h1 = WSP(float, WS_MISC + MISC_H1M); bf16* h1b = WSP(bf16, WS_MISC + MISC_H1MB); float* ssqm = WSP(float, WS_MISC + MISC_SSQM);
#pragma unroll
    for (int r = 0; r < 4; ++r) { const int row = 4 * (lane >> 4) + r; const size_t o = (size_t)row * DM + c0 + (lane & 15);
        const float v = F.in[1][o] + 0.5f * acc[0][r]; h1[o] = v; h1b[o] = (bf16)f2bf(v);
        float sq = v * v; sq += __shfl_xor(sq, 1); sq += __shfl_xor(sq, 2); sq += __shfl_xor(sq, 4); sq += __shfl_xor(sq, 8);
        if ((lane & 15) == 0) ssqm[row * 64 + job] = sq; }
}
__device__ __forceinline__ void meta_p3(Frame& F) {
    const int lane = (int)threadIdx.x & 63;
    bf16* HV = WSP(bf16, WS_Z + Z_HV); bf16* ZFF = WSP(bf16, WS_Z + Z_ZFF); bf16* KB = WSP(bf16, WS_Z + Z_KB); bf16* VB = WSP(bf16, WS_Z + Z_VB);
    const int first3 = slack_first((M / 256) * (NIN / 256), F.G, 20); const bool grp0 = (F.G == 256) && (first3 > 0) && (first3 % 8 == 0) && (first3 + 8 * 20 < F.G);
    if ((int)blockIdx.x == (grp0 ? first3 + 8 * 20 : F.G - 1)) {
        const v4u zero = {0u, 0u, 0u, 0u};
        for (int p = (int)threadIdx.x; p < 112 * 512 / 8; p += NWAVES * 64) { ((GAS v4u*)HV)[p] = zero; ((GAS v4u*)ZFF)[p] = zero; }
        for (int p = (int)threadIdx.x; p < 112 * 128 / 8; p += NWAVES * 64) { ((GAS v4u*)(KB + (size_t)(M + 16) * 128))[p] = zero; ((GAS v4u*)(VB + (size_t)(M + 16) * 128))[p] = zero; }
    }
    int job = (int)blockIdx.x - first3; if (grp0) job = (job >= 0 && (job & 7) == 0) ? job >> 3 : -1;
    if (job < 0 || job >= 20) return;
    int brow[4];
    if (job < 16) {
#pragma unroll
        for (int g = 0; g < 4; ++g) brow[g] = (job < 8 ? 512 : 1024) + 64 * (job & 7) + 16 * g;
    } else {
#pragma unroll
        for (int g = 0; g < 4; ++g) brow[g] = 3072 + 128 * (g >> 1) + 32 * (job - 16) + 16 * (g & 1);
    }
    f32x4 x[4];
    thin_job<4, 4>(WSP(bf16, WS_MISC + MISC_H1MB), WSP(bf16, WS_W + W_IN), brow, DM, (LAS float*)(F.lds + RING_OFF), x, F.wave, lane);
    if (F.wave != 0) return;
    float rs4[4];
    { const f32x4* p = (const f32x4*)(WSP(float, WS_MISC + MISC_SSQM) + (lane >> 2) * 64 + (lane & 3) * 16);
      const f32x4 a = p[0], b = p[1], c = p[2], d = p[3];
      float sq = (((a[0] + a[1]) + (a[2] + a[3])) + ((b[0] + b[1]) + (b[2] + b[3]))) + (((c[0] + c[1]) + (c[2] + c[3])) + ((d[0] + d[1]) + (d[2] + d[3])));
      sq += __shfl_xor(sq, 1); sq += __shfl_xor(sq, 2);
      const float rsv = rsqrtf(sq * (1.0f / 1024.0f) + pg8::RMS_EPS);
#pragma unroll
      for (int r = 0; r < 4; ++r) rs4[r] = __shfl(rsv, 4 * (4 * (lane >> 4) + r)); }
    if (job < 16) {
        bf16* dst = (job < 8 ? HV : ZFF) + 64 * (job & 7);
#pragma unroll
        for (int r = 0; r < 4; ++r) { const int row = 4 * (lane >> 4) + r;
#pragma unroll
            for (int g = 0; g < 4; ++g) { float v = x[g][r] * rs4[r];
                if (job >= 8) v = __builtin_amdgcn_logf(1.0f - WSP(float, WS_MISC + MISC_OMLF)[64 * (job & 7) + 16 * g + (lane & 15)] * __builtin_amdgcn_rcpf(1.0f + __builtin_amdgcn_exp2f(v * 1.4426950408889634f)));
                dst[(size_t)(112 + row) * HGW + 16 * g + (lane & 15)] = (bf16)f2bf(v); } }
    } else {
        const int hh = job - 16;
#pragma unroll
        for (int r = 0; r < 4; ++r) {
            const int row = 4 * (lane >> 4) + r; float v[4]; float ss = 0.f;
#pragma unroll
            for (int g = 0; g < 4; ++g) { v[g] = x[g][r] * rs4[r]; ss += v[g] * v[g]; }
            if (hh < 2) { ss += __shfl_xor(ss, 1); ss += __shfl_xor(ss, 2); ss += __shfl_xor(ss, 4); ss += __shfl_xor(ss, 8);
                const float rn = rsqrtf(ss * (1.0f / 64.0f) + pg8::RMS_EPS);
#pragma unroll
                for (int g = 0; g < 4; ++g) v[g] *= rn * F.in[12][16 * g + (lane & 15)]; }
            bf16* dst = (hh < 2 ? KB : VB) + (size_t)(M + row) * 128 + 64 * (hh & 1);
#pragma unroll
            for (int g = 0; g < 4; ++g) dst[16 * g + (lane & 15)] = (bf16)f2bf(v[g]);
        }
    }
}

typedef LAS const char* lds_cptr;
typedef short v4i16_t __attribute__((ext_vector_type(4)));
__device__ __forceinline__ s16x4 vtr(lds_cptr p) { return __builtin_bit_cast(s16x4, __builtin_amdgcn_ds_read_tr16_b64_v4i16((LAS v4i16_t*)p)); }
__device__ __forceinline__ int crow(int r, int hi) { return (r & 3) + 8 * (r >> 2) + 4 * hi; }
__device__ __forceinline__ int hg_img_off(int tb, int k, int seg) { return tb * 8192 + (k ^ ((k >> 4) & 1)) * 64 + ((seg ^ (k >> 2)) & 3) * 16; }
__device__ __forceinline__ bf16x8 trfrag(lds_cptr img, int tb, int ks, int lane) {
    const int k0 = 16 * ks + 8 * (lane >> 5) + ((lane & 15) >> 2), seg = ((lane >> 4) & 1) * 2 + ((lane & 3) >> 1), sub = (lane & 1) * 8;
    const s16x4 lo = vtr(img + hg_img_off(tb, k0, seg) + sub), hi = vtr(img + hg_img_off(tb, k0 + 4, seg) + sub);
    return (bf16x8){lo[0], lo[1], lo[2], lo[3], hi[0], hi[1], hi[2], hi[3]};
}
__device__ __forceinline__ bf16* hg_slot(Frame& F, int dir, int j, int h) { return (bf16*)F.out + ((size_t)((dir * 128 + (j - 1)) * 4 + h) << 14); }

typedef unsigned u32x2g __attribute__((ext_vector_type(2)));
__device__ __forceinline__ void hg_load8(const bf16* base  , int sg, int cq, u32x2g (&r)[8]) {
    const bf16* p = base + (size_t)(8 * sg) * HGW + 4 * cq;
#pragma unroll
    for (int i = 0; i < 8; ++i) r[i] = *(const GAS u32x2g*)(p + (size_t)i * HGW);
}
__device__ __forceinline__ float hg_elem(const u32x2g (&r)[8], int i, int c) { const unsigned w = (c < 2) ? r[i].x : r[i].y; return (c & 1) ? __uint_as_float(w & 0xffff0000u) : __uint_as_float(w << 16); }
__device__ __forceinline__ unsigned hg_raw(const u32x2g (&r)[8], int i, int c) { const unsigned w = (c < 2) ? r[i].x : r[i].y; return (c & 1) ? (w >> 16) : (w & 0xffffu); }
__device__ __forceinline__ f32x4 hg_gates8(const u32x2g (&z)[8], float (&kk)[4][8], LAS float* tot, int sg, int cq) {
    f32x4 run = {0.f, 0.f, 0.f, 0.f};
#pragma unroll
    for (int c = 0; c < 4; ++c)
#pragma unroll
        for (int i = 0; i < 8; ++i) { const float g = hg_elem(z, i, c); run[c] += g; kk[c][i] = 1.0f - __builtin_amdgcn_exp2f(g); }
    *(LAS f32x4*)(tot + sg * 128 + 4 * cq) = run;
    return run;
}
__device__ __forceinline__ void hg_prefix(const LAS float* tot, const f32x4 own, int sg, int cq, int dir, f32x4& pre, f32x4& ref, f32x4& all) {
    f32x4 lo = {0.f, 0.f, 0.f, 0.f}, hi = lo, pf = lo;
#pragma unroll
    for (int s2 = 0; s2 < 16; ++s2) { const f32x4 v = *(const LAS f32x4*)(tot + s2 * 128 + 4 * cq); const float m = (s2 < sg) ? 1.0f : 0.0f;
        if (s2 < 8) lo += v; else hi += v;
        pf[0] = __builtin_fmaf(v[0], m, pf[0]); pf[1] = __builtin_fmaf(v[1], m, pf[1]); pf[2] = __builtin_fmaf(v[2], m, pf[2]); pf[3] = __builtin_fmaf(v[3], m, pf[3]); }
    all = lo + hi;
    if (dir) { pre = all - pf - own; ref = hi; } else { pre = pf; ref = lo; }
}
__device__ __forceinline__ v4u hg_pack8(const float (&x)[8], int dir) {
    v4u w;
    if (!dir) { w.x = pk2(x[0], x[1]); w.y = pk2(x[2], x[3]); w.z = pk2(x[4], x[5]); w.w = pk2(x[6], x[7]); }
    else { w.x = pk2(x[7], x[6]); w.y = pk2(x[5], x[4]); w.z = pk2(x[3], x[2]); w.w = pk2(x[1], x[0]); }
    return w;
}
__device__ __forceinline__ v4u hg_pack8raw(const u32x2g (&r)[8], int c, int  ) {
    const unsigned sel = (c & 1) ? 0x07060302u : 0x05040100u;
    v4u w;
#define HG_W(i) ((c < 2) ? r[i].x : r[i].y)
    w.x = __builtin_amdgcn_perm(HG_W(1), HG_W(0), sel); w.y = __builtin_amdgcn_perm(HG_W(3), HG_W(2), sel); w.z = __builtin_amdgcn_perm(HG_W(5), HG_W(4), sel); w.w = __builtin_amdgcn_perm(HG_W(7), HG_W(6), sel);
#undef HG_W
    return w;
}
template <int DIR> __device__ __forceinline__ void hg_pass2_state(const float (&kk)[8], int cc, float pre, float B, float own, float (&kx)[8]) {
    float G = __builtin_amdgcn_exp2f(B - pre - own);
#pragma unroll
    for (int ii = 7; ii >= 0; --ii) { const int i = DIR ? 7 - ii : ii; kx[i] = kk[i] * G; G = __builtin_fmaf(-G, kk[i], G); }
}
template <int DIR> __device__ __forceinline__ void hg_pass2_out(const float (&kk)[8], const u32x2g (&qr)[8], int cc, float pre, float rref, float own, float (&qx)[8], float (&kx)[8]) {
    const float e0 = pre - rref;
    float E = __builtin_amdgcn_exp2f(fminf(e0, 115.f)), Fv = __builtin_amdgcn_exp2f(fminf(-(e0 + own), 115.f));
#pragma unroll
    for (int ii = 0; ii < 8; ++ii) { const int i = DIR ? 7 - ii : ii; E = __builtin_fmaf(-E, kk[i], E); qx[i] = hg_elem(qr, i, cc) * E; }
#pragma unroll
    for (int ii = 7; ii >= 0; --ii) { const int i = DIR ? 7 - ii : ii; kx[i] = kk[i] * Fv; Fv = __builtin_fmaf(-Fv, kk[i], Fv); }
}
#define HG4_DECODE(s_, c_, h_, d_, nv_) int c_, h_, d_; bool nv_; \
        if ((s_) < 8) { c_ = (s_) >> 2; h_ = (s_) & 3; d_ = 0; nv_ = true; } \
        else if ((s_) < 1016) { const int q_ = (s_) - 8; c_ = 2 + (q_ >> 3); h_ = (q_ >> 1) & 3; d_ = q_ & 1; nv_ = (d_ == 0); } \
        else { c_ = 128; h_ = (s_) - 1016; d_ = 1; nv_ = true; }
#define HG4_ISSUE_LOADS(s_) do { HG4_DECODE(s_, cN_, hN_, dN_, nvN_); const size_t cb_ = ((size_t)128 * cN_) * HGW + hN_ * 128; \
        hg_load8(WSP(bf16, WS_Z + (dN_ ? Z_ZFB : Z_ZFF)) + cb_, sg, cq, zr); if (nvN_) hg_load8(WSP(bf16, WS_Z + Z_HV) + cb_, sg, cq, vr); } while (0)
__device__ __forceinline__ void hg_state_phase(Frame& F) {
    const int w = F.wave;
    LAS float* tot = (LAS float*)(F.lds + HL_TOT);
    if (F.vcu >= 255) return;
    u32x2g zr[8], vr[8];
    { const int tid = threadIdx.x, cq = tid & 31, sg = tid >> 5; HG4_ISSUE_LOADS(4 * F.vcu); }
#pragma unroll 1
    for (int blk = F.vcu; blk < 255; blk += F.G)
#pragma unroll 1
    for (int js = 0; js < 4; ++js) {
        const int st = 4 * blk + js;
        int tid_ = threadIdx.x; asm volatile("" : "+v"(tid_));
        const int tid = tid_, lane = tid & 63, r = lane & 31, hi = lane >> 5, cq = tid & 31, sg = tid >> 5;
        HG4_DECODE(st, c, h, dir, newv);
        float kk[4][8];
        const f32x4 own = hg_gates8(zr, kk, tot, sg, cq);
        if (newv) {
#pragma unroll
            for (int cc = 0; cc < 4; ++cc) *(LAS v4u*)(F.lds + HL_VT + (4 * cq + cc) * HL_PITCH + sg * 16) = hg_pack8raw(vr, cc, 0);
        }
        __syncthreads();
        f32x4 pre, ref, B; hg_prefix(tot, own, sg, cq, dir, pre, ref, B);
#pragma unroll
        for (int cc = 0; cc < 4; ++cc) {
            float kx[8];
            if (dir) hg_pass2_state<1>(kk[cc], cc, pre[cc], B[cc], own[cc], kx); else hg_pass2_state<0>(kk[cc], cc, pre[cc], B[cc], own[cc], kx);
            *(LAS v4u*)(F.lds + HL_QH + (4 * cq + cc) * HL_PITCH + sg * 16) = hg_pack8(kx, 0);
        }
        if (sg == 0) { f32x4 dd; dd[0] = __builtin_amdgcn_exp2f(B[0]); dd[1] = __builtin_amdgcn_exp2f(B[1]); dd[2] = __builtin_amdgcn_exp2f(B[2]); dd[3] = __builtin_amdgcn_exp2f(B[3]); *(f32x4*)(WSP(float, WS_MISC + (dir ? MISC_DB : MISC_DF)) + c * HGW + h * 128 + 4 * cq) = dd; }
        { const int sn = (js < 3) ? st + 1 : 4 * (blk + F.G); if (js < 3 || blk + F.G < 255) HG4_ISSUE_LOADS(sn); }
        __syncthreads();
        const int vb = w >> 1;
#pragma unroll
        for (int kbi = 0; kbi < 2; ++kbi) {
            const int kb = 2 * (w & 1) + kbi; f32x16 acc = {};
#pragma unroll
            for (int ks = 0; ks < 8; ++ks) {
                const bf16x8 a = *(const LAS bf16x8*)(F.lds + HL_VT + (32 * vb + r) * HL_PITCH + (16 * ks + 8 * hi) * 2);
                const bf16x8 bq = *(const LAS bf16x8*)(F.lds + HL_QH + (32 * kb + r) * HL_PITCH + (16 * ks + 8 * hi) * 2);
                acc = __builtin_amdgcn_mfma_f32_32x32x16_bf16(bq, a, acc, 0, 0, 0);
            }
            LAS unsigned char* ut = F.lds + HL_ST + (32 * vb + r) * HL_PITCH + (32 * kb + 4 * hi) * 2;
#pragma unroll
            for (int q4 = 0; q4 < 4; ++q4) { u32x2g w; w.x = pk2(acc[4 * q4], acc[4 * q4 + 1]); w.y = pk2(acc[4 * q4 + 2], acc[4 * q4 + 3]); *(LAS u32x2g*)(ut + 16 * q4) = w; }
        }
        __syncthreads();
        { bf16* slot = hg_slot(F, dir, dir ? c - 1 : c + 1, h);
#pragma unroll
          for (int j = 0; j < 4; ++j) { const int p = tid + 512 * j, v = p >> 4, k8 = (p & 15) * 8; *(GAS v4u*)(slot + (size_t)v * 128 + k8) = *(const LAS v4u*)(F.lds + HL_ST + v * HL_PITCH + k8 * 2); } }
    }
    __syncthreads();
}
#undef HG4_ISSUE_LOADS
#undef HG4_DECODE
__device__ __forceinline__ void hg_scan_phase(Frame& F) {
    LAS float* tab = (LAS float*)(F.lds + HL_ST);
    const int tid = (int)threadIdx.x;
#pragma unroll 1
    for (int su = F.vcu; su < 256; su += F.G) {
        const int dir = su >> 7, h = (su >> 5) & 3, vb = (su >> 1) & 15, kh = su & 1;
        { const float* D = WSP(float, WS_MISC + (dir ? MISC_DB : MISC_DF)) + h * 128 + 64 * kh;
          f32x4 fv[5];
#pragma unroll
          for (int q = 0; q < 5; ++q) { const int i = tid + q * (NWAVES * 64), ii = (i < 129 * 16) ? i : tid; fv[q] = *(const f32x4*)(D + (size_t)(ii >> 4) * HGW + 4 * (ii & 15)); }
#pragma unroll
          for (int q = 0; q < 5; ++q) { const int i = tid + q * (NWAVES * 64); if (i < 129 * 16) *(LAS f32x4*)(tab + (i >> 4) * 64 + 4 * (i & 15)) = fv[q]; } }
        __syncthreads();
        if (tid < 256) {
            const int v = 8 * vb + (tid >> 5), k = 64 * kh + 2 * (tid & 31);
            const int j0 = dir ? 127 : 1, step = dir ? -1 : 1;
            const long sstride = (long)step * (4 * 8192);
            unsigned* pb = (unsigned*)(hg_slot(F, dir, 1, h) + v * 128 + k) + (size_t)(j0 - 1) * (4 * 8192);
            const LAS float* trow = tab + 2 * (tid & 31) + j0 * 64;
            const int tstep = step * 64;
            const unsigned w0 = *pb; float s0 = pg8::bf_lo(w0), s1 = pg8::bf_hi(w0);
            unsigned wa[32], wb[32];
#define SC_LD(W, n0) do { _Pragma("unroll") for (int q = 0; q < 32; ++q) { const int idx = (n0) + q; if (idx < 126) W[q] = pb[(long)(idx + 1) * sstride]; else if (idx == 126) W[q] = pb[dir ? 0 : (long)(idx + 1) * sstride]; } } while (0)
#define SC_PR(W, n0) do { _Pragma("unroll") for (int q = 0; q < 32; ++q) { const int idx = (n0) + q; if (idx < 126 || (idx == 126 && !dir)) { const f32x2 d = *(const LAS f32x2*)(trow + idx * tstep); \
                s0 = d.x * s0 + pg8::bf_lo(W[q]); s1 = d.y * s1 + pg8::bf_hi(W[q]); pb[(long)(idx + 1) * sstride] = pk2(s0, s1); } } } while (0)
            SC_LD(wa, 0); SC_LD(wb, 32); SC_PR(wa, 0); SC_LD(wa, 64); SC_PR(wb, 32); SC_LD(wb, 96); SC_PR(wa, 64); SC_PR(wb, 96);
#undef SC_LD
#undef SC_PR
        }
        if (su + F.G < 256) __syncthreads();
    }
}
template <int CTRL> __device__ __forceinline__ float dpp_add(float v) { return v + __builtin_bit_cast(float, __builtin_amdgcn_update_dpp(0, __builtin_bit_cast(int, v), CTRL, 0xf, 0xf, false)); }
#define HG_ISSUE_LOADS(cN, hN, dirN) do { \
        const size_t cb_ = ((size_t)128 * (cN)) * HGW + (hN) * 128; \
        hg_load8(WSP(bf16, WS_Z + ((dirN) ? Z_ZFB : Z_ZFF)) + cb_, sg, cq, zr); \
        const bool hs_ = !((dirN) == 1 && (cN) == 128); const bf16* sl_ = hg_slot(F, (dirN), hs_ ? (cN) : 1, (hN)); \
        _Pragma("unroll") for (int j_ = 0; j_ < 4; ++j_) { const int p_ = tid + 512 * j_; sraw[j_] = *(const GAS v4u*)(sl_ + (size_t)(p_ >> 4) * 128 + (p_ & 15) * 8); } } while (0)
__device__ __forceinline__ void hg_out_phase(Frame& F, bf16* yabase) {
    const int w = F.wave, vh = w >> 2, tb = vh ? 3 - (w & 3) : (w & 3);
    LAS float* tot = (LAS float*)(F.lds + HL_TOT); LAS float* er = (LAS float*)(F.lds + HL_ER); LAS float* ssqx = (LAS float*)(F.lds + HL_SSQ); LAS float* ox = (LAS float*)(F.lds);
    const lds_cptr QH = (lds_cptr)(F.lds + HL_QH), KH = (lds_cptr)(F.lds + HL_KH);
    const int nun = (512 - F.vcu + F.G - 1) / F.G;
    const bool grp = false;
#define HG_UID(k) (grp ? 2 * F.vcu + (k) : F.vcu + (k) * F.G)
    if (nun <= 0) return;
    u32x2g zr[8]; v4u sraw[4];
    { const int tid = threadIdx.x, cq = tid & 31, sg = tid >> 5; { const int uid0 = HG_UID(0); HG_ISSUE_LOADS(1 + (uid0 >> 2), uid0 & 3, 0); } }
    f32x16 of0 = {}, of1 = {};
#pragma unroll 1
    for (int st = 0; st < 2 * nun; ++st) {
        int tid_ = threadIdx.x; asm volatile("" : "+v"(tid_));
        const int tid = tid_, lane = tid & 63, r = lane & 31, hi = lane >> 5, cq = tid & 31, sg = tid >> 5;
        const int uid = HG_UID(st >> 1), c = 1 + (uid >> 2), h = uid & 3, dir = st & 1;
        const bool hasS = !(dir == 1 && c == 128);
        u32x2g qr[8], vr[8];
        { const size_t cb = ((size_t)128 * c) * HGW + h * 128; hg_load8(WSP(bf16, WS_Z + Z_HQ) + cb, sg, cq, qr); if (dir == 0) hg_load8(WSP(bf16, WS_Z + Z_HV) + cb, sg, cq, vr); }
        float kk[4][8];
        const f32x4 own = hg_gates8(zr, kk, tot, sg, cq);
        if (dir == 0) {
#pragma unroll
            for (int cc = 0; cc < 4; ++cc) *(LAS v4u*)(F.lds + HL_VT + (4 * cq + cc) * HL_PITCH + sg * 16) = hg_pack8raw(vr, cc, 0);
        }
        __syncthreads();
        f32x4 pre, rref, ball; hg_prefix(tot, own, sg, cq, dir, pre, rref, ball);
#pragma unroll
        for (int cc = 0; cc < 4; ++cc) {
            float qx[8], kx[8];
            if (dir) hg_pass2_out<1>(kk[cc], qr, cc, pre[cc], rref[cc], own[cc], qx, kx); else hg_pass2_out<0>(kk[cc], qr, cc, pre[cc], rref[cc], own[cc], qx, kx);
            const int off = hg_img_off(sg >> 2, 4 * cq + cc, sg & 3);
            *(LAS v4u*)(F.lds + HL_QH + off) = hg_pack8(qx, 0); *(LAS v4u*)(F.lds + HL_KH + off) = hg_pack8(kx, 0);
        }
        if (sg == 0) { f32x4 ee; ee[0] = __builtin_amdgcn_exp2f(rref[0]); ee[1] = __builtin_amdgcn_exp2f(rref[1]); ee[2] = __builtin_amdgcn_exp2f(rref[2]); ee[3] = __builtin_amdgcn_exp2f(rref[3]); *(LAS f32x4*)(er + 4 * cq) = ee; }
        __syncthreads();
        if (hasS) {
#pragma unroll
            for (int j = 0; j < 4; ++j) { const int p = tid + 512 * j, v = p >> 4, k8 = (p & 15) * 8;
                const v4u sv = sraw[j];
                const f32x4 e0 = *(const LAS f32x4*)(er + k8), e1 = *(const LAS f32x4*)(er + k8 + 4); v4u o;
                o.x = pk2(pg8::bf_lo(sv.x) * e0[0], pg8::bf_hi(sv.x) * e0[1]); o.y = pk2(pg8::bf_lo(sv.y) * e0[2], pg8::bf_hi(sv.y) * e0[3]);
                o.z = pk2(pg8::bf_lo(sv.z) * e1[0], pg8::bf_hi(sv.z) * e1[1]); o.w = pk2(pg8::bf_lo(sv.w) * e1[2], pg8::bf_hi(sv.w) * e1[3]);
                *(LAS v4u*)(F.lds + HL_ST + v * HL_PITCH + k8 * 2) = o; }
        }
        if (st + 1 < 2 * nun) { const int uidn = HG_UID((st + 1) >> 1); HG_ISSUE_LOADS(1 + (uidn >> 2), uidn & 3, (st + 1) & 1); }
        __syncthreads();
        f32x16 o0 = {}, o1 = {};
        bf16x8 qf[8];
#pragma unroll
        for (int ks = 0; ks < 8; ++ks) qf[ks] = trfrag(QH, tb, ks, lane);
        if (hasS) {
#pragma unroll
            for (int ks = 0; ks < 8; ++ks) {
                const bf16x8 a = qf[ks];
                const bf16x8 b0 = *(const LAS bf16x8*)(F.lds + HL_ST + (64 * vh + r) * HL_PITCH + (16 * ks + 8 * hi) * 2);
                const bf16x8 b1 = *(const LAS bf16x8*)(F.lds + HL_ST + (64 * vh + 32 + r) * HL_PITCH + (16 * ks + 8 * hi) * 2);
                o0 = __builtin_amdgcn_mfma_f32_32x32x16_bf16(a, b0, o0, 0, 0, 0); o1 = __builtin_amdgcn_mfma_f32_32x32x16_bf16(a, b1, o1, 0, 0, 0);
            }
        }
#pragma unroll 1
        for (int ib = 0; ib <= (dir ? 3 - tb : tb); ++ib) {
            const int sb = dir ? tb + ib : ib;
            f32x16 ct = {};
#pragma unroll
            for (int ks = 0; ks < 8; ++ks) { const bf16x8 a = trfrag(KH, sb, ks, lane); ct = __builtin_amdgcn_mfma_f32_32x32x16_bf16(a, qf[ks], ct, 0, 0, 0); }
            if (sb == tb) {
                int rr = r - 4 * hi; asm volatile("" : "+v"(rr));
#pragma unroll
                for (int g = 0; g < 16; ++g) { const int cgv = (g & 3) + 8 * (g >> 2); if (dir ? (cgv < rr) : (cgv > rr)) ct[g] = 0.f; }
            }
            v4u pw[2];
#pragma unroll
            for (int s2 = 0; s2 < 2; ++s2) { pw[s2].x = pk2(ct[8 * s2], ct[8 * s2 + 1]); pw[s2].y = pk2(ct[8 * s2 + 2], ct[8 * s2 + 3]); pw[s2].z = pk2(ct[8 * s2 + 4], ct[8 * s2 + 5]); pw[s2].w = pk2(ct[8 * s2 + 6], ct[8 * s2 + 7]); }
#pragma unroll
            for (int s2 = 0; s2 < 2; ++s2) {
                const bf16x8 pa = __builtin_bit_cast(bf16x8, pw[s2]);
                const LAS unsigned char* v0 = F.lds + HL_VT + (64 * vh + r) * HL_PITCH + (32 * sb + 16 * s2 + 4 * hi) * 2; const LAS unsigned char* v1 = v0 + 32 * HL_PITCH;
                const s16x4 a0 = *(const LAS s16x4*)v0, a1 = *(const LAS s16x4*)(v0 + 16), c0 = *(const LAS s16x4*)v1, c1 = *(const LAS s16x4*)(v1 + 16);
                o0 = __builtin_amdgcn_mfma_f32_32x32x16_bf16(pa, (bf16x8){a0[0], a0[1], a0[2], a0[3], a1[0], a1[1], a1[2], a1[3]}, o0, 0, 0, 0);
                o1 = __builtin_amdgcn_mfma_f32_32x32x16_bf16(pa, (bf16x8){c0[0], c0[1], c0[2], c0[3], c1[0], c1[1], c1[2], c1[3]}, o1, 0, 0, 0);
            }
        }
        __syncthreads();
        if (dir == 0) { of0 = o0; of1 = o1; }
        else {
            int lane2 = lane; asm volatile("" : "+v"(lane2)); const int r2 = lane2 & 31, hi2 = lane2 >> 5;
            int tid2 = tid; asm volatile("" : "+v"(tid2));
            v4u hgr[4];
            { const bf16* hgp = WSP(bf16, WS_Z + Z_HG) + ((size_t)128 * c + (tid2 >> 2)) * HGW + h * 128 + 32 * (tid2 & 3);
#pragma unroll
              for (int j = 0; j < 4; ++j) hgr[j] = *(const GAS v4u*)(hgp + 8 * j); }
            const float* ow = F.in[10] + h * 128 + 64 * vh + r2; const float w0 = ow[0], w1 = ow[32];
            int tbase = 32 * tb + 4 * hi2; asm volatile("" : "+v"(tbase));
            { float sqv[16];
#pragma unroll
              for (int g = 0; g < 16; ++g) { of0[g] += o0[g]; of1[g] += o1[g]; sqv[g] = of0[g] * of0[g] + of1[g] * of1[g]; }
#pragma unroll
              for (int g = 0; g < 16; ++g) { float sq = sqv[g]; sq = dpp_add<0xB1>(sq); sq = dpp_add<0x4E>(sq); sq = dpp_add<0x141>(sq); sq = dpp_add<0x140>(sq); sqv[g] = sq; }
              if ((r2 & 15) == 0) {
#pragma unroll
                for (int g = 0; g < 16; ++g) { const int cg = (g & 3) + 8 * (g >> 2); ssqx[(tbase + cg) * 4 + 2 * vh + (r2 >> 4)] = sqv[g]; } } }
            __syncthreads();
            { const int yb = tbase * OX_PITCH + 64 * vh + r2;
#pragma unroll
              for (int g = 0; g < 16; ++g) { const int cg = (g & 3) + 8 * (g >> 2);
                const f32x4 pp = *(const LAS f32x4*)(ssqx + (tbase + cg) * 4);
                const float rn = __builtin_amdgcn_rsqf(((pp[0] + pp[1]) + (pp[2] + pp[3])) * (1.0f / 128.0f) + pg8::RMS_EPS);
                ox[yb + cg * OX_PITCH] = of0[g] * rn * w0; ox[yb + cg * OX_PITCH + 32] = of1[g] * rn * w1; } }
            __syncthreads();
            { const int t = tid2 >> 2, c0 = 32 * (tid2 & 3);
              bf16* ya = yabase + ((size_t)128 * c + t) * HGW + h * 128 + c0;
#pragma unroll
              for (int j = 0; j < 4; ++j) { const f32x4 y0 = *(const LAS f32x4*)(ox + t * OX_PITCH + c0 + 8 * j), y1 = *(const LAS f32x4*)(ox + t * OX_PITCH + c0 + 8 * j + 4); const v4u gq = hgr[j]; v4u o;
                  o.x = pk2(y0[0] * pg8::bf_lo(gq.x), y0[1] * pg8::bf_hi(gq.x)); o.y = pk2(y0[2] * pg8::bf_lo(gq.y), y0[3] * pg8::bf_hi(gq.y));
                  o.z = pk2(y1[0] * pg8::bf_lo(gq.z), y1[1] * pg8::bf_hi(gq.z)); o.w = pk2(y1[2] * pg8::bf_lo(gq.w), y1[3] * pg8::bf_hi(gq.w));
                  *(GAS v4u*)(ya + 8 * j) = o; } }
            __syncthreads();
        }
    }
}
#undef HG_ISSUE_LOADS
#undef HG_UID

struct Args { const float* in[20]; float* out; unsigned char* ws; int ph_lo, ph_hi; };
__global__ void __launch_bounds__(NWAVES * 64, 2) mk_fwd(Args args) {
    extern __shared__ __attribute__((aligned(16))) unsigned char lds[];
    Frame F;
    F.lds = (LAS unsigned char*)lds;
    F.MISC = (volatile LAS unsigned*)(F.lds + MISC_OFF);
    F.wave = __builtin_amdgcn_readfirstlane((int)threadIdx.x >> 6);
    F.G = gridDim.x; { const int bx = blockIdx.x; F.vcu = (F.G % 8 == 0) ? (bx % 8) * (F.G / 8) + bx / 8 : bx; }
    F.ws = args.ws; F.out = args.out;
#pragma unroll
    for (int i = 0; i < 20; ++i) F.in[i] = args.in[i];
    F.ctl = (gu32*)(F.ws + WS_CTL);
    for (int u = (int)threadIdx.x; u < (LDS_BYTES - LDSCTL_OFF) / 4; u += NWAVES * 64) ((LAS unsigned*)(F.lds + LDSCTL_OFF))[u] = 0u;
    __syncthreads();
    XcdBarrier bar; bar.bar = (unsigned*)(F.ctl + CW_BAR); bar.x = 0; bar.st = nullptr;
    if (N_LAUNCHES == 1) bar = xcd_barrier_post((unsigned*)(F.ctl + CW_BAR), F.MISC + 8);
    const int lo = args.ph_lo, hi = args.ph_hi;
    bf16* Wb = WSP(bf16, WS_W); bf16* HB = WSP(bf16, WS_HB); bf16* ACT = WSP(bf16, WS_Z); bf16* MIXED = WSP(bf16, WS_Z + Z_HV);

#ifndef PHMASK
#define PHMASK 0x7ff
#endif
#define IN(k) (((PHMASK >> (k)) & 1) && lo <= (k) && (k) < hi)
#define SEAM(k) do { if ((k) + 1 < hi) xcd_barrier(bar); } while (0)
#define SEAML(k) do { if ((k) + 1 < hi) xcd_barrier_local(bar); } while (0)
#define PH_GATEUP(W_off, SSQ_off, PM) do { \
        pg8::Gemm g{HB, Wb + (W_off) / 2, M, NGU, DM}; pg8::RsOrder S; S.init(M, NGU, F.G, (int)blockIdx.x); S.pmode = (PM); S.ssqp = WSP(float, SSQ_off); S.tab = (LAS float*)(F.lds + RS_OFF); S.prefill(); \
        pg8::EpiSwiglu E{ACT, (const LAS float*)(F.lds + RS_OFF), DFF}; \
        pg8::gemm_phase<pg8::EpiSwiglu, pg8::RsOrder, true, true>(F.lds + RING_OFF, g, S, E); } while (0)
#define PH_RES(Aptr, W_off, Kdim, BASE32, BASE16, OUT32, HBOUT, SSQOUT, SCALE, PM) do { \
        pg8::Gemm g{Aptr, Wb + (W_off) / 2, M, DM, Kdim}; pg8::StaticOrder S; S.init(M, DM, F.G, (int)blockIdx.x); S.pmode = (PM); \
        if (S.nwg <= F.G) { pg8::EpiResT E{BASE16, OUT32, HBOUT, SSQOUT, SCALE}; pg8::gemm_phase<pg8::EpiResT, pg8::StaticOrder, true, true>(F.lds + RING_OFF, g, S, E); }     \
        else { pg8::EpiRes E{BASE32, BASE16, OUT32, HBOUT, SSQOUT, SCALE}; pg8::gemm_phase<pg8::EpiRes, pg8::StaticOrder, true, true>(F.lds + RING_OFF, g, S, E); } } while (0)

#ifndef DUP_PHASE
#define DUP_PHASE -1
#endif
#define DUP(k) (DUP_PHASE == (k))
    const int PMODE = (F.G == 256) ? 1 : 0;
    if (IN(0)) { if (DUP(0)) { p0_prologue(F); xcd_barrier(bar); } p0_prologue(F); SEAM(0); }
    if (IN(1)) { if (DUP(1)) { meta_p1(F); PH_GATEUP(W_GU1, WS_SSQ0, 0); xcd_barrier(bar); } meta_p1(F); convert_in_idle_slot(F, (M / 256) * (NGU / 256), CV_FFN1, CV_IN); PH_GATEUP(W_GU1, WS_SSQ0, 0); SEAM(1); }
    if (IN(2)) { if (DUP(2)) { meta_p2(F); PH_RES(ACT, W_D1, DFF, (const float*)nullptr, HB, (float*)nullptr, HB, WSP(float, WS_SSQ1), 0.5f, 0); xcd_barrier(bar); } meta_p2(F); PH_RES(ACT, W_D1, DFF, (const float*)nullptr, HB, (float*)nullptr, HB, WSP(float, WS_SSQ1), 0.5f, 0); SEAM(2); }
#define PH_MIX() do { \
        meta_p3(F); \
        pg8::Gemm g{HB, Wb + W_IN / 2, M, NIN, DM}; pg8::RsOrder S; S.init(M, NIN, F.G, (int)blockIdx.x); S.ssqp = WSP(float, WS_SSQ1); S.tab = (LAS float*)(F.lds + RS_OFF); S.prefill(); \
        pg8::EpiMix E{(const LAS float*)(F.lds + RS_OFF), WSP(bf16, WS_Z + Z_HQ) + 128 * HGW, WSP(bf16, WS_Z + Z_HV) + 128 * HGW, WSP(bf16, WS_Z + Z_ZFF) + 128 * HGW, WSP(bf16, WS_Z + Z_ZFB) + 128 * HGW, WSP(bf16, WS_Z + Z_HG) + 128 * HGW, \
                      WSP(bf16, WS_Z + Z_QO), WSP(bf16, WS_Z + Z_KB), WSP(bf16, WS_Z + Z_VB), WSP(bf16, WS_Z + Z_GA), WSP(bf16, WS_Z + Z_GB), \
                      F.in[11], F.in[12], WSP(pg8::f32x2, WS_MISC + MISC_ROPER), WSP(pg8::f32x2, WS_MISC + MISC_ROPEC), attn_body::C2, WSP(float, WS_MISC + MISC_OMLF), WSP(float, WS_MISC + MISC_OMLB)}; \
        pg8::gemm_phase<pg8::EpiMix, pg8::RsOrder, true, true>(F.lds + RING_OFF, g, S, E); } while (0)
    if (IN(3)) { if (DUP(3)) { PH_MIX(); xcd_barrier(bar); } convert_in_idle_slot(F, (M / 256) * (NIN / 256), CV_IN, CV_ALL); PH_MIX(); if (F.G == 256) SEAML(3); else SEAM(3); }
    if (IN(4)) { if (DUP(4)) { hg_state_phase(F); xcd_barrier(bar); } hg_state_phase(F); SEAM(4); }
    if (IN(5)) {
        if (DUP(5)) { const attn_body::AttnTensors ATd{WSP(bf16, WS_Z + Z_QO), WSP(bf16, WS_Z + Z_KB), WSP(bf16, WS_Z + Z_VB), Wb, F.in[11], F.in[12]}; attn_body::attn_phase<8>((char*)lds + RING_OFF, ATd, F.vcu, F.G); xcd_barrier(bar); }
        hg_scan_phase(F);
        const attn_body::AttnTensors AT{WSP(bf16, WS_Z + Z_QO), WSP(bf16, WS_Z + Z_KB), WSP(bf16, WS_Z + Z_VB), WSP(bf16, WS_Z + Z_QO), F.in[11], F.in[12]};
        attn_body::attn_phase<8>((char*)lds + RING_OFF, AT, F.vcu, F.G);
        SEAM(5);
    }
    if (IN(6)) { if (DUP(6)) { hg_out_phase(F, Wb); xcd_barrier(bar); } hg_out_phase(F, WSP(bf16, WS_Z + Z_HQ)); if (PMODE) SEAML(6); else SEAM(6); }
    for (int rep7 = 0; rep7 < (DUP(7) ? 2 : 1); ++rep7)
    if (IN(7)) {
        if (rep7) xcd_barrier(bar);
        pg8::Gemm g{WSP(bf16, WS_Z + Z_HQ) + 128 * HGW, Wb + W_UP / 2, 2 * M, 2 * DM, HGW}; pg8::UpOrder S; S.init(F.G, (int)blockIdx.x); S.so.pmode = PMODE;
        pg8::EpiUp E{WSP(bf16, WS_Z + Z_GA), WSP(bf16, WS_Z + Z_GB), MIXED};
        pg8::gemm_phase<pg8::EpiUp, pg8::UpOrder, true, true>(F.lds + RING_OFF, g, S, E);
        SEAML(7);
    }
    if (IN(8)) { PH_RES(MIXED, W_OUT, DM, (const float*)nullptr, HB, (float*)nullptr, HB, WSP(float, WS_SSQ2), 1.0f, PMODE); SEAML(8); }
    if (IN(9)) { if (DUP(9)) { PH_GATEUP(W_GU2, WS_SSQ2, PMODE); xcd_barrier(bar); } stagger_short_share(F, (M / 256) * (NGU / 256), 3); PH_GATEUP(W_GU2, WS_SSQ2, PMODE); SEAML(9); }
    if (IN(10)) { PH_RES(ACT, W_D2, DFF, (const float*)nullptr, HB, F.out, (bf16*)nullptr, (float*)nullptr, 0.5f, PMODE);
    }
#undef IN
#undef SEAM
}

extern "C" void kernel_launch(void* const* d_in, const int* in_sizes, int n_in, void* d_out, int out_size, void* d_ws, size_t ws_size, hipStream_t stream) {
    static int grid = 0;
    if (grid == 0) {
        if (n_in != 20 || in_sizes[0] != M * DM || out_size != M * DM || ws_size < WS_END) { fprintf(stderr, "kernel_launch: built for 20 inputs, x/out of %d floats, >= %zu bytes of workspace; got n_in %d, in0 %d, out %d, ws %zu; nothing launched\n", M * DM, (size_t)WS_END, n_in, n_in > 0 ? in_sizes[0] : -1, out_size, ws_size); grid = -1; return; }
        int dev = 0, cus = 0, per_cu = 0;
        if (hipGetDevice(&dev) != hipSuccess || hipDeviceGetAttribute(&cus, hipDeviceAttributeMultiprocessorCount, dev) != hipSuccess) { fprintf(stderr, "kernel_launch: device query failed\n"); grid = -1; return; }
        if (hipFuncSetAttribute((const void*)mk_fwd, hipFuncAttributeMaxDynamicSharedMemorySize, LDS_BYTES) != hipSuccess) { fprintf(stderr, "kernel_launch: hipFuncSetAttribute failed\n"); grid = -1; return; }
        if (hipOccupancyMaxActiveBlocksPerMultiprocessor(&per_cu, (const void*)mk_fwd, NWAVES * 64, LDS_BYTES) != hipSuccess || per_cu < 1) { fprintf(stderr, "kernel_launch: occupancy query reports %d workgroups per CU\n", per_cu); per_cu = 1; }
        (void)hipGetLastError();
        if (cus < DFF / 16) { fprintf(stderr, "kernel_launch: %d CUs; the meta-token side path deals one job per workgroup and needs >= %d workgroups; nothing launched\n", cus, DFF / 16); grid = -1; return; }
        grid = cus;
    }
    if (grid < 0) return;
    if (hipMemsetAsync((char*)d_ws + WS_CTL, 0, CTL_ZERO_BYTES, stream) != hipSuccess) { fprintf(stderr, "kernel_launch: memset failed\n"); return; }
    Args a{};
    for (int i = 0; i < 20; ++i) a.in[i] = (const float*)d_in[i];
    a.out = (float*)d_out; a.ws = (unsigned char*)d_ws;
    for (int li = 0; li < N_LAUNCHES; ++li) {
        a.ph_lo = (N_LAUNCHES == 1) ? 0 : li; a.ph_hi = (N_LAUNCHES == 1) ? N_PHASES : li + 1;
        hipLaunchKernelGGL(mk_fwd, dim3(grid), dim3(NWAVES * 64), LDS_BYTES, stream, a);
        const hipError_t le = hipPeekAtLastError();
        if (le != hipSuccess) { fprintf(stderr, "kernel_launch: launch %d failed: %s\n", li, hipGetErrorName(le)); break; }
    }
}
```
